# Optimizing an MI355X kernel written in HIP

```python
import math
import functools
import jax
import jax.numpy as jnp
from jax import lax
import numpy as np

D_MODEL = 1024
BATCH = 2
SEQ = 8192
DEPTH = 2

GRID_W = 64
CTX_LEN = 256

HEAD_DIM = 64
GROUP_HEADS = 4
GROUP_WIDTH = GROUP_HEADS * HEAD_DIM
N_GROUPS = 4
MIX_WIDTH = N_GROUPS * GROUP_WIDTH

DA_HEADS = 4
DA_QK_DIM = 32
DA_V_DIM = 64
DA_BLOCK = 128

SWA_HEADS = 4
SWA_KV_HEADS = 2
SWA_DIM = 64
SWA_WINDOW = 128
SWA_BLOCK = SWA_WINDOW

NA_HEADS = 4
NA_DIM = 64
NA_WIN_ROWS = 8
NA_WIN_COLS = 16
NA_COL_BLOCK = 16
NA_BAND_COLS = 2 * NA_WIN_COLS

RET_HEADS = 4
RET_QK_DIM = 64
RET_V_DIM = 64
RET_CHUNK = 128

DA_COLS = DA_HEADS * (4 * DA_QK_DIM + DA_V_DIM)
SWA_COLS = (SWA_HEADS + 2 * SWA_KV_HEADS) * SWA_DIM
NA_COLS = 3 * NA_HEADS * NA_DIM
RET_COLS = RET_HEADS * (2 * RET_QK_DIM + 2 * RET_V_DIM)
IN_WIDTH = DA_COLS + SWA_COLS + NA_COLS + RET_COLS
IN_CUTS = (DA_COLS, DA_COLS + SWA_COLS, DA_COLS + SWA_COLS + NA_COLS)

ROPE_BASE = 10000.0
FFN_DIM = 2816
N_EXPERTS = 8
TOP_K = 2
EXPERT_DIM = 3584
NORM_EPS = 1e-6
NEG_INF = -1e30

kernel_name = 'hybrid_dit_parallel_heads_block'


def _rmsnorm(x, g=None):
    xf = x.astype(jnp.float32)
    y = xf * lax.rsqrt(jnp.mean(xf * xf, axis=-1, keepdims=True) + NORM_EPS)
    if g is not None:
        y = y * g.astype(jnp.float32)
    return y.astype(x.dtype)


def _rope_axis(x, pos):
    dh = x.shape[-1]
    half = dh // 2
    inv = ROPE_BASE ** (-jnp.arange(half, dtype=jnp.float32) * 2.0 / dh)
    ang = pos[:, None] * inv[None, :]
    shape = (pos.shape[0],) + (1,) * (x.ndim - 3) + (half,)
    cos = jnp.cos(ang).reshape(shape).astype(x.dtype)
    sin = jnp.sin(ang).reshape(shape).astype(x.dtype)
    x1, x2 = x[..., :half], x[..., half:]
    return jnp.concatenate([x1 * cos - x2 * sin, x1 * sin + x2 * cos], axis=-1)


def _rope2d(x, row, col):
    h = x.shape[-1] // 2
    return jnp.concatenate([_rope_axis(x[..., :h], row), _rope_axis(x[..., h:], col)], axis=-1)


def _diff_attention(p, pc, row, col, lq1, lk1, lq2, lk2, subln_g, lambda_init, with_ctx):
    B, S, _ = p.shape
    nq = DA_HEADS * 2 * DA_QK_DIM

    def split(t):
        n = t.shape[1]
        q = t[..., :nq].reshape(B, n, DA_HEADS, 2, DA_QK_DIM)
        k = t[..., nq:2 * nq].reshape(B, n, DA_HEADS, 2, DA_QK_DIM)
        v = t[..., 2 * nq:].reshape(B, n, DA_HEADS, DA_V_DIM)
        return q, k, v

    q, k, v = split(p)
    q = _rope2d(q, row, col)
    k = _rope2d(k, row, col)
    qc, kc, vc = split(pc)
    lam = (jnp.exp(jnp.sum(lq1 * lk1)) - jnp.exp(jnp.sum(lq2 * lk2))).astype(jnp.float32) + lambda_init
    scale = DA_QK_DIM ** -0.5

    def attend(qb, keys, vals):
        s = jnp.einsum('bqhtd,bkhtd->bhtqk', qb, keys) * scale
        pr = jax.nn.softmax(s, axis=-1)
        a = pr[:, :, 0] - lam * pr[:, :, 1]
        return jnp.einsum('bhqk,bkhd->bqhd', a, vals)

    k_all = jnp.concatenate([kc, k], axis=1)
    v_all = jnp.concatenate([vc, v], axis=1)
    nb = S // DA_BLOCK
    q_blocks = jnp.swapaxes(q.reshape(B, nb, DA_BLOCK, DA_HEADS, 2, DA_QK_DIM), 0, 1)
    o = lax.map(lambda qb: attend(qb, k_all, v_all), q_blocks)
    o = jnp.swapaxes(o, 0, 1).reshape(B, S, DA_HEADS, DA_V_DIM)

    def head_norm(t):
        return (_rmsnorm(t, subln_g) * (1.0 - lambda_init)).reshape(t.shape[0], t.shape[1], DA_HEADS * DA_V_DIM)

    y = head_norm(o)
    yc = head_norm(attend(qc, kc, vc)) if with_ctx else None
    return y, yc


def _sink_softmax(s, sink):
    m = jnp.maximum(jnp.max(s, axis=-1, keepdims=True), sink)
    e = jnp.exp(s - m)
    return e / (jnp.sum(e, axis=-1, keepdims=True) + jnp.exp(sink - m))


def _window_gqa(p, pc, row, col, sink, with_ctx):
    B, S, _ = p.shape
    G = SWA_HEADS // SWA_KV_HEADS
    nq = SWA_HEADS * SWA_DIM
    nk = SWA_KV_HEADS * SWA_DIM

    def split(t):
        n = t.shape[1]
        q = t[..., :nq].reshape(B, n, SWA_KV_HEADS, G, SWA_DIM)
        k = t[..., nq:nq + nk].reshape(B, n, SWA_KV_HEADS, SWA_DIM)
        v = t[..., nq + nk:].reshape(B, n, SWA_KV_HEADS, SWA_DIM)
        return q, k, v

    q, k, v = split(p)
    q = _rope2d(q, row, col)
    k = _rope2d(k, row, col)
    qc, kc, vc = split(pc)
    sink = sink.astype(jnp.float32).reshape(SWA_KV_HEADS, G, 1, 1)
    scale = SWA_DIM ** -0.5
    nb = S // SWA_BLOCK
    kq = 3 * SWA_BLOCK

    def band(t):
        tp = jnp.pad(t, ((0, 0), (SWA_WINDOW, SWA_WINDOW), (0, 0), (0, 0)))
        tp = tp.reshape(B, nb + 2, SWA_BLOCK, SWA_KV_HEADS, SWA_DIM)
        return jnp.concatenate([tp[:, :-2], tp[:, 1:-1], tp[:, 2:]], axis=2)

    kb, vb = band(k), band(v)
    blk = jnp.arange(nb)[:, None]
    qpos = blk * SWA_BLOCK + jnp.arange(SWA_BLOCK)[None, :]
    kpos = blk * SWA_BLOCK - SWA_WINDOW + jnp.arange(kq)[None, :]
    valid = ((kpos[:, None, :] >= 0) & (kpos[:, None, :] < S)
             & (jnp.abs(qpos[:, :, None] - kpos[:, None, :]) <= SWA_WINDOW))
    qg = q.reshape(B, nb, SWA_BLOCK, SWA_KV_HEADS, G, SWA_DIM)
    s_loc = jnp.einsum('bnqhgd,bnkhd->bnhgqk', qg, kb) * scale
    s_loc = jnp.where(valid[None, :, None, None], s_loc, NEG_INF)
    s_ctx = jnp.einsum('bnqhgd,bkhd->bnhgqk', qg, kc) * scale
    pr = _sink_softmax(jnp.concatenate([s_loc, s_ctx], axis=-1), sink)
    o = (jnp.einsum('bnhgqk,bnkhd->bnqhgd', pr[..., :kq], vb)
         + jnp.einsum('bnhgqk,bkhd->bnqhgd', pr[..., kq:], vc))
    y = o.reshape(B, S, nq)
    yc = None
    if with_ctx:
        sc = jnp.einsum('bqhgd,bkhd->bhgqk', qc, kc) * scale
        yc = jnp.einsum('bhgqk,bkhd->bqhgd', _sink_softmax(sc, sink), vc).reshape(B, qc.shape[1], nq)
    return y, yc


def _neighborhood_attention(p, pc, rpb, with_ctx):
    B, S, _ = p.shape
    rows = S // GRID_W
    wr = min(NA_WIN_ROWS, rows)
    ncb = GRID_W // NA_COL_BLOCK
    nd = NA_HEADS * NA_DIM

    def split(t):
        n = t.shape[1]
        return [t[..., i * nd:(i + 1) * nd].reshape(B, n, NA_HEADS, NA_DIM) for i in range(3)]

    q, k, v = split(p)
    qc, kc, vc = split(pc)
    r = jnp.arange(rows)
    row_idx = jnp.clip(r - wr // 2, 0, rows - wr)[:, None] + jnp.arange(wr)[None, :]
    band_idx = (jnp.clip(jnp.arange(ncb) * NA_COL_BLOCK - NA_WIN_COLS // 2, 0, GRID_W - NA_BAND_COLS)[:, None]
                + jnp.arange(NA_BAND_COLS)[None, :])
    nkeys = wr * NA_BAND_COLS
    tok_idx = (row_idx[:, None, :, None] * GRID_W + band_idx[None, :, None, :]).reshape(rows, ncb, nkeys)
    kb = jnp.take(k, tok_idx, axis=1)
    vb = jnp.take(v, tok_idx, axis=1)
    q_col = jnp.arange(ncb)[:, None] * NA_COL_BLOCK + jnp.arange(NA_COL_BLOCK)[None, :]
    col_start = jnp.clip(q_col - NA_WIN_COLS // 2, 0, GRID_W - NA_WIN_COLS)
    col_ok = ((band_idx[:, None, :] >= col_start[:, :, None])
              & (band_idx[:, None, :] < col_start[:, :, None] + NA_WIN_COLS))
    mask = jnp.broadcast_to(col_ok[:, :, None, :], (ncb, NA_COL_BLOCK, wr, NA_BAND_COLS)).reshape(ncb, NA_COL_BLOCK, nkeys)
    d_row = row_idx - r[:, None] + (NA_WIN_ROWS - 1)
    d_col = jnp.clip(band_idx[:, None, :] - q_col[:, :, None], 1 - NA_WIN_COLS, NA_WIN_COLS - 1) + (NA_WIN_COLS - 1)
    bias = rpb[:, d_row[:, None, None, :, None], d_col[None, :, :, None, :]]
    bias = jnp.transpose(bias.reshape(NA_HEADS, rows, ncb, NA_COL_BLOCK, nkeys), (1, 2, 0, 3, 4)).astype(jnp.float32)
    scale = NA_DIM ** -0.5
    qg = q.reshape(B, rows, ncb, NA_COL_BLOCK, NA_HEADS, NA_DIM)
    s_loc = jnp.einsum('brjqhd,brjkhd->brjhqk', qg, kb) * scale + bias
    s_loc = jnp.where(mask[None, None, :, None], s_loc, NEG_INF)
    s_ctx = jnp.einsum('brjqhd,bkhd->brjhqk', qg, kc) * scale
    pr = jax.nn.softmax(jnp.concatenate([s_loc, s_ctx], axis=-1), axis=-1)
    o = (jnp.einsum('brjhqk,brjkhd->brjqhd', pr[..., :nkeys], vb)
         + jnp.einsum('brjhqk,bkhd->brjqhd', pr[..., nkeys:], vc))
    y = o.reshape(B, S, nd)
    yc = None
    if with_ctx:
        sc = jax.nn.softmax(jnp.einsum('bqhd,bkhd->bhqk', qc, kc) * scale, axis=-1)
        yc = jnp.einsum('bhqk,bkhd->bqhd', sc, vc).reshape(B, qc.shape[1], nd)
    return y, yc


def _ret_scan(q, k, v, log_g, s0, diag):
    B, N, H, dk = q.shape
    dv = v.shape[-1]
    C = RET_CHUNK
    nc = N // C
    qc = q.reshape(B, nc, C, H, dk)
    kc = k.reshape(B, nc, C, H, dk)
    vc = v.reshape(B, nc, C, H, dv)
    i = jnp.arange(C, dtype=jnp.float32)
    dist = i[:, None] - i[None, :]
    keep = (dist >= 0) if diag else (dist > 0)
    decay = jnp.where(keep[None], jnp.exp(jnp.where(keep, dist, 0.0)[None] * log_g[:, None, None]), 0.0)
    att = jnp.einsum('bnihd,bnjhd->bnhij', qc, kc) * decay
    intra = jnp.einsum('bnhij,bnjhe->bnihe', att, vc)
    zeta = jnp.exp((C - 1 - i)[None, :] * log_g[:, None])
    u = jnp.einsum('bnjhd,bnjhe,hj->nbhde', kc, vc, zeta)
    g_chunk = jnp.exp(C * log_g)[None, :, None, None]

    def step(s, u_n):
        return g_chunk * s + u_n, s

    s_last, s_prev = lax.scan(step, s0, u)
    xi = jnp.exp((i + 1)[None, :] * log_g[:, None])
    cross = jnp.einsum('bnihd,hi,nbhde->bnihe', qc, xi, s_prev)
    return (intra + cross).reshape(B, N, H, dv), s_last


def _ret_state(k, v, log_g):
    n = k.shape[1]
    w = jnp.exp((n - 1 - jnp.arange(n, dtype=jnp.float32))[None, :] * log_g[:, None])
    return jnp.einsum('bjhd,bjhe,hj->bhde', k, v, w)


def _retention(p, pc, row, col, gam_f, gam_b, with_ctx):
    B, S, _ = p.shape
    nqk = RET_HEADS * RET_QK_DIM
    nv = RET_HEADS * RET_V_DIM

    def split(t):
        n = t.shape[1]
        q = t[..., :nqk].reshape(B, n, RET_HEADS, RET_QK_DIM)
        k = t[..., nqk:2 * nqk].reshape(B, n, RET_HEADS, RET_QK_DIM) * (RET_QK_DIM ** -0.5)
        v = t[..., 2 * nqk:2 * nqk + nv].reshape(B, n, RET_HEADS, RET_V_DIM)
        g = t[..., 2 * nqk + nv:]
        return q, k, v, g

    q, k, v, g = split(p)
    q = _rope2d(q, row, col)
    k = _rope2d(k, row, col)
    qc, kc, vc, gc = split(pc)
    log_f = jax.nn.log_sigmoid(gam_f.astype(jnp.float32))
    log_b = jax.nn.log_sigmoid(gam_b.astype(jnp.float32))
    flip = lambda t: jnp.flip(t, axis=1)
    if with_ctx:
        s0 = jnp.zeros((B, RET_HEADS, RET_QK_DIM, RET_V_DIM), jnp.float32)
        oc_f, s_f = _ret_scan(qc, kc, vc, log_f, s0, True)
        oc_b, s_b = _ret_scan(flip(qc), flip(kc), flip(vc), log_b, s0, False)
    else:
        s_f = _ret_state(kc, vc, log_f)
        s_b = _ret_state(flip(kc), flip(vc), log_b)
    o_f, _ = _ret_scan(q, k, v, log_f, s_f, True)
    o_b, _ = _ret_scan(flip(q), flip(k), flip(v), log_b, s_b, False)

    def gate_out(o, gate):
        return (_rmsnorm(o) * jax.nn.silu(gate).reshape(o.shape)).reshape(o.shape[0], o.shape[1], nv)

    y = gate_out(o_f + flip(o_b), g)
    yc = gate_out(oc_f + flip(oc_b), gc) if with_ctx else None
    return y, yc


def _swiglu_ffn(h, w_gate, w_up, w_down):
    return (jax.nn.silu(h @ w_gate) * (h @ w_up)) @ w_down


def _moe_ffn(h, router, w_gate, w_up, w_down):
    logits = jnp.einsum('bsd,de->bse', h, router).astype(jnp.float32)
    top_v, top_i = lax.top_k(logits, TOP_K)
    w = jax.nn.softmax(top_v, axis=-1)
    gates = jnp.sum(jax.nn.one_hot(top_i, N_EXPERTS, dtype=jnp.float32) * w[..., None], axis=-2)
    y = jnp.zeros_like(h)
    for e in range(N_EXPERTS):
        y = y + gates[..., e:e + 1].astype(h.dtype) * _swiglu_ffn(h, w_gate[e], w_up[e], w_down[e])
    return y


def _layer(x, xc, c, c_ctx, row, col, w_mod, b_mod, g_attn_pre, g_attn_post, g_ffn_pre, g_ffn_post,
           w_in, w_out, lq1, lk1, lq2, lk2, subln_g, sink, rpb, gam_f, gam_b, ffn, lambda_init, with_ctx):
    mod = jax.nn.silu(c) @ w_mod + b_mod
    mod_c = jax.nn.silu(c_ctx) @ w_mod + b_mod
    sh1, sc1, gt1, sh2, sc2, gt2 = jnp.split(mod[:, None, :], 6, axis=-1)
    csh1, csc1, cgt1, csh2, csc2, cgt2 = jnp.split(mod_c, 6, axis=-1)

    h = _rmsnorm(x, g_attn_pre) * (1 + sc1) + sh1
    hc = _rmsnorm(xc, g_attn_pre) * (1 + csc1) + csh1
    p = (h @ w_in).astype(jnp.float32)
    pc = (hc @ w_in).astype(jnp.float32)
    pa, pb, pn, pr = jnp.split(p, IN_CUTS, axis=-1)
    pca, pcb, pcn, pcr = jnp.split(pc, IN_CUTS, axis=-1)
    ya, yca = _diff_attention(pa, pca, row, col, lq1, lk1, lq2, lk2, subln_g, lambda_init, with_ctx)
    yb, ycb = _window_gqa(pb, pcb, row, col, sink, with_ctx)
    yn, ycn = _neighborhood_attention(pn, pcn, rpb, with_ctx)
    yr, ycr = _retention(pr, pcr, row, col, gam_f, gam_b, with_ctx)
    y = jnp.concatenate([ya, yb, yn, yr], axis=-1).astype(x.dtype) @ w_out
    x = x + gt1 * _rmsnorm(y, g_attn_post)

    h = _rmsnorm(x, g_ffn_pre) * (1 + sc2) + sh2
    x = x + gt2 * _rmsnorm(ffn(h), g_ffn_post)

    if with_ctx:
        yc = jnp.concatenate([yca, ycb, ycn, ycr], axis=-1).astype(xc.dtype) @ w_out
        xc = xc + cgt1 * _rmsnorm(yc, g_attn_post)
        hc = _rmsnorm(xc, g_ffn_pre) * (1 + csc2) + csh2
        xc = xc + cgt2 * _rmsnorm(ffn(hc), g_ffn_post)
    return x, xc


def setup_inputs(seed: int = 0) -> dict:
    key = jax.random.key(seed)
    ks = jax.random.split(key, 32)
    D = D_MODEL
    n_dense = (DEPTH + 1) // 2
    n_moe = DEPTH // 2

    def nrm(k, shape, s):
        return s * jax.random.normal(k, shape, jnp.float32)

    gam = 1.0 - 2.0 ** (-5.0 - jnp.arange(RET_HEADS, dtype=jnp.float32))
    gam_logit = jnp.log(gam) - jnp.log1p(-gam)
    return {
        'x': nrm(ks[0], (BATCH, SEQ, D), 1.0),
        'c': nrm(ks[1], (BATCH, D), 1.0),
        'ctx': nrm(ks[2], (BATCH, CTX_LEN, D), 1.0),
        'c_ctx': nrm(ks[3], (D,), 1.0),
        'w_mod': nrm(ks[4], (DEPTH, D, 6 * D), 0.5 * D ** -0.5),
        'b_mod': nrm(ks[5], (DEPTH, 6 * D), 0.02),
        'g_attn_pre': 1.0 + nrm(ks[6], (DEPTH, D), 0.02),
        'g_attn_post': 1.0 + nrm(ks[7], (DEPTH, D), 0.02),
        'g_ffn_pre': 1.0 + nrm(ks[8], (DEPTH, D), 0.02),
        'g_ffn_post': 1.0 + nrm(ks[9], (DEPTH, D), 0.02),
        'w_in': nrm(ks[10], (DEPTH, D, IN_WIDTH), D ** -0.5),
        'w_out': nrm(ks[11], (DEPTH, MIX_WIDTH, D), MIX_WIDTH ** -0.5),
        'da_lambda_q1': nrm(ks[12], (DEPTH, DA_QK_DIM), 0.1),
        'da_lambda_k1': nrm(ks[13], (DEPTH, DA_QK_DIM), 0.1),
        'da_lambda_q2': nrm(ks[14], (DEPTH, DA_QK_DIM), 0.1),
        'da_lambda_k2': nrm(ks[15], (DEPTH, DA_QK_DIM), 0.1),
        'da_subln': 1.0 + nrm(ks[16], (DEPTH, DA_V_DIM), 0.02),
        'swa_sink': nrm(ks[17], (DEPTH, SWA_HEADS), 0.5),
        'na_rpb': nrm(ks[18], (DEPTH, NA_HEADS, 2 * NA_WIN_ROWS - 1, 2 * NA_WIN_COLS - 1), 0.1),
        'ret_gamma_fwd': gam_logit[None, :] + nrm(ks[19], (DEPTH, RET_HEADS), 0.05),
        'ret_gamma_bwd': gam_logit[None, :] + nrm(ks[20], (DEPTH, RET_HEADS), 0.05),
        'ffn_w_gate': nrm(ks[21], (n_dense, D, FFN_DIM), D ** -0.5),
        'ffn_w_up': nrm(ks[22], (n_dense, D, FFN_DIM), D ** -0.5),
        'ffn_w_down': nrm(ks[23], (n_dense, FFN_DIM, D), FFN_DIM ** -0.5),
        'moe_router': nrm(ks[24], (n_moe, D, N_EXPERTS), D ** -0.5),
        'moe_w_gate': nrm(ks[25], (n_moe, N_EXPERTS, D, EXPERT_DIM), D ** -0.5),
        'moe_w_up': nrm(ks[26], (n_moe, N_EXPERTS, D, EXPERT_DIM), D ** -0.5),
        'moe_w_down': nrm(ks[27], (n_moe, N_EXPERTS, EXPERT_DIM, D), EXPERT_DIM ** -0.5),
    }


def reference(x, c, ctx, c_ctx, w_mod, b_mod, g_attn_pre, g_attn_post, g_ffn_pre, g_ffn_post, w_in, w_out,
              da_lambda_q1, da_lambda_k1, da_lambda_q2, da_lambda_k2, da_subln, swa_sink, na_rpb,
              ret_gamma_fwd, ret_gamma_bwd, ffn_w_gate, ffn_w_up, ffn_w_down,
              moe_router, moe_w_gate, moe_w_up, moe_w_down):
    S = x.shape[1]
    t = jnp.arange(S)
    row = (t // GRID_W).astype(jnp.float32)
    col = (t % GRID_W).astype(jnp.float32)
    xc = ctx
    for l in range(DEPTH):
        if l % 2 == 0:
            ffn = functools.partial(_swiglu_ffn, w_gate=ffn_w_gate[l // 2], w_up=ffn_w_up[l // 2],
                                    w_down=ffn_w_down[l // 2])
        else:
            ffn = functools.partial(_moe_ffn, router=moe_router[l // 2], w_gate=moe_w_gate[l // 2],
                                    w_up=moe_w_up[l // 2], w_down=moe_w_down[l // 2])
        lambda_init = 0.8 - 0.6 * math.exp(-0.3 * l)
        x, xc = _layer(x, xc, c, c_ctx, row, col, w_mod[l], b_mod[l], g_attn_pre[l], g_attn_post[l],
                       g_ffn_pre[l], g_ffn_post[l], w_in[l], w_out[l],
                       da_lambda_q1[l], da_lambda_k1[l], da_lambda_q2[l], da_lambda_k2[l], da_subln[l],
                       swa_sink[l], na_rpb[l], ret_gamma_fwd[l], ret_gamma_bwd[l], ffn, lambda_init,
                       l < DEPTH - 1)
    return x
```

```cpp
#include <hip/hip_runtime.h>
#include <stdint.h>
#include <stddef.h>
#include <stdio.h>

typedef unsigned short bf16_t;
typedef short bf16x8 __attribute__((ext_vector_type(8)));
typedef float f32x4 __attribute__((ext_vector_type(4)));
typedef unsigned u32x4 __attribute__((ext_vector_type(4)));
typedef unsigned u32x2 __attribute__((ext_vector_type(2)));
#define LAS __attribute__((address_space(3)))
#define DI __device__ __forceinline__
typedef LAS float lfloat;
typedef float f32x16 __attribute__((ext_vector_type(16)));
#define MFMA32(a, b, c) __builtin_amdgcn_mfma_f32_32x32x16_bf16((a), (b), (c), 0, 0, 0)

constexpr int D = 1024, SEQ = 8192, NB = 2, CTXL = 256;
constexpr int TX = NB * SEQ;
constexpr int TC = NB * CTXL;
constexpr int T = TX + TC;
constexpr int INW = 3072, FF = 2816, NE = 8, ED = 3584;
constexpr int NCH = 66;
constexpr float EPS = 1e-6f;
constexpr int MOE_ROWS = 34816;
constexpr int PASS_TILES = 64, PASS_ROWS = PASS_TILES * 256;
constexpr int PASS1_ROWS = MOE_ROWS - PASS_ROWS;
constexpr int NTHREADS = 512, NWAVES = 8;

constexpr int DA_Q = 0, DA_K = 256, DA_V = 512;
constexpr int SW_Q = 768, SW_K = 1024, SW_V = 1152;
constexpr int NA_Q = 1280, NA_K = 1536, NA_V = 1792;
constexpr int RT_Q = 2048, RT_K = 2304, RT_V = 2560, RT_G = 2816;

constexpr size_t al256(size_t x) { return (x + 255) & ~(size_t)255; }
constexpr size_t OFF_BAR = 0;
constexpr size_t OFF_CNT = 16384;
constexpr size_t CTL_ZERO_BYTES = 32768;
constexpr size_t OFF_MOD = 32768;
constexpr size_t OFF_ROPE = al256(OFF_MOD + 2 * 3 * 6144 * 4);
constexpr size_t OFF_TLIST = al256(OFF_ROPE + 128 * 24 * 8);
constexpr size_t OFF_TOKE = OFF_TLIST + 8 * 16384 * 4;
constexpr size_t OFF_TOKJ = OFF_TOKE + 16384 * 2 * 4;
constexpr size_t OFF_TOKW = OFF_TOKJ + 16384 * 2 * 4;
constexpr size_t OFF_XC = OFF_TOKW + 16384 * 2 * 4;
constexpr size_t OFF_WIN = OFF_XC + (size_t)TC * D * 4;
constexpr size_t OFF_WOUT = OFF_WIN + (size_t)2 * INW * D * 2;
constexpr size_t OFF_WGU = OFF_WOUT + (size_t)2 * D * D * 2;
constexpr size_t OFF_WD = OFF_WGU + (size_t)2 * FF * D * 2;
constexpr size_t OFF_MGU = OFF_WD + (size_t)D * FF * 2;
constexpr size_t OFF_MD = OFF_MGU + (size_t)NE * 2 * ED * D * 2;
constexpr size_t OFF_H8 = OFF_MD + (size_t)NE * D * ED;
constexpr size_t OFF_H = OFF_MD + (size_t)NE * D * ED * 2;
constexpr size_t OFF_A = OFF_H + (size_t)T * D * 2;
constexpr size_t A_P = 0;
constexpr size_t A_U = A_P + (size_t)T * INW * 2;
constexpr size_t A_S = A_U + (size_t)NB * 4 * 2 * NCH * 4096 * 4;
constexpr size_t A_VT = A_S + (size_t)NB * 4 * 2 * NCH * 4096 * 4;
constexpr int NKEY = CTXL + SEQ;
constexpr int VH_DA = 0, VH_SW = 4, VH_NA = 6, VH_RT = 10, NVH = 14;
constexpr size_t A_END = A_VT + (size_t)NB * NVH * 64 * NKEY * 2;
constexpr size_t A_ACT = 0;
constexpr size_t SZ_A = A_END > (size_t)MOE_ROWS * ED ? A_END : (size_t)MOE_ROWS * ED;
static_assert((size_t)TX * D <= (size_t)NE * D * ED, "H8 fits behind MD8");
constexpr float ACT8_SCALE = 8.f;
constexpr float W8_SCALE = 64.f, W8_INV = 1.f / 64.f;
constexpr size_t OFF_B = OFF_A + al256(SZ_A);
constexpr size_t SZ_B = (size_t)MOE_ROWS * D * 2 > (size_t)T * D * 4 ? (size_t)MOE_ROWS * D * 2 : (size_t)T * D * 4;
constexpr size_t OFF_XS = OFF_B + al256(SZ_B);
constexpr size_t WS_NEED = OFF_XS + (size_t)T * D * 2;
constexpr int WOUT_SPLIT = 4, FFD_SPLIT = 11;
constexpr size_t B_SLAB_Y = (size_t)36 << 20;
constexpr size_t B_SLAB_F = B_SLAB_Y + (size_t)WOUT_SPLIT * TC * D * 4;
static_assert(B_SLAB_F + (size_t)FFD_SPLIT * TC * D * 4 <= SZ_B, "slabs fit");

constexpr int RING_BYTES = 131072, LDSCTL_OFF = RING_BYTES, LDS_BYTES = 147456;

struct Params {
    const float *x, *c, *ctx, *c_ctx, *w_mod, *b_mod, *g_attn_pre, *g_attn_post, *g_ffn_pre, *g_ffn_post, *w_in, *w_out;
    const float *lq1, *lk1, *lq2, *lk2, *subln, *sink, *rpb, *gam_f, *gam_b, *ffn_wg, *ffn_wu, *ffn_wd, *router, *moe_wg, *moe_wu, *moe_wd;
    float* out;
    unsigned char* ws;
};

DI float bf2f(bf16_t v) { return __uint_as_float(((unsigned)v) << 16); }
DI bf16_t f2bf(float f) { unsigned u = __float_as_uint(f); u += 0x7fffu + ((u >> 16) & 1u); return (bf16_t)(u >> 16); }
typedef __bf16 v2bf_t __attribute__((ext_vector_type(2)));
typedef float v2f_t __attribute__((ext_vector_type(2)));
DI unsigned pk2(float lo, float hi) { const v2f_t x = {lo, hi}; return __builtin_bit_cast(unsigned, __builtin_convertvector(x, v2bf_t)); }
DI float silu_f(float v) { return v / (1.f + __expf(-v)); }
DI int lane_id_fresh() { int ln; asm volatile("v_mbcnt_lo_u32_b32 %0, -1, 0\n\tv_mbcnt_hi_u32_b32 %0, -1, %0" : "=v"(ln)); return ln; }
DI float shx(float v, int mask, int lane) { return __int_as_float(__builtin_amdgcn_ds_bpermute((lane ^ mask) << 2, __float_as_int(v))); }
DI float wave_sum(float v, int lane) {
#pragma unroll
    for (int o = 1; o < 64; o <<= 1) v += shx(v, o, lane);
    return v;
}

DI const float* xin0_row(const Params& p, int row) { return row < TX ? p.x + (size_t)row * D : p.ctx + (size_t)(row - TX) * D; }
DI const float* mod_row(const Params& p, int layer, int row) {
    const int v = row < TX ? (row >> 13) : 2;
    return (const float*)(p.ws + OFF_MOD) + (size_t)(layer * 3 + v) * 6144;
}
#define XB_TMO      128
#define XB_XCNT(j)  (256  + 64 * (j))
#define XB_XSUB(j)  (1280 + 64 * (j))
#define XB_XGEN(j)  (2304 + 64 * (j))
#define XB_TOP      3328
#define XB_TOPGEN   3392
#define XCD_BAR_WORDS 3456
#define XB_SPIN_CAP (1u << 23)

__device__ __forceinline__ unsigned xb_ld(unsigned* p)              { return __hip_atomic_load(p, __ATOMIC_RELAXED, __HIP_MEMORY_SCOPE_AGENT); }
__device__ __forceinline__ unsigned xb_add(unsigned* p, unsigned v) { return __hip_atomic_fetch_add(p, v, __ATOMIC_RELAXED, __HIP_MEMORY_SCOPE_AGENT); }
__device__ __forceinline__ unsigned xb_xcc_id() { return (unsigned)__builtin_amdgcn_s_getreg((3 << 11) | 20) & 0xFu; }
#define XB_SPIN(cond, bar) do { unsigned _sp = 0; while (cond) { __builtin_amdgcn_s_sleep(1); \
    if ((++_sp & 255u) == 0u) { if (xb_ld(&(bar)[XB_TMO])) break; if (_sp > XB_SPIN_CAP) { atomicAdd(&(bar)[XB_TMO], 1u); break; } } } } while (0)

struct XcdBarrier {
    unsigned* bar; unsigned x;
    volatile LAS unsigned* st;
};

__device__ __forceinline__ XcdBarrier xcd_barrier_post(unsigned* bar, volatile LAS unsigned* st) {
    XcdBarrier b; b.bar = bar; b.x = xb_xcc_id(); b.st = st;
    if (threadIdx.x == 0) (void)xb_add(&bar[XB_XCNT(b.x)], 1u);
    return b;
}
__device__ __forceinline__ void xcd_barrier_complete(unsigned* bar, unsigned x, unsigned& nloc, unsigned& nx) {
    const unsigned G = gridDim.x * gridDim.y * gridDim.z;
    unsigned sum, cnt, mine, sp = 0u;
    for (;;) {
        sum = 0u; cnt = 0u; mine = 0u;
#pragma unroll
        for (unsigned j = 0; j < 16; ++j) { const unsigned c = xb_ld(&bar[XB_XCNT(j)]); sum += c; cnt += (c > 0u) ? 1u : 0u; mine = (j == x) ? c : mine; }
        if (sum == G) break;
        __builtin_amdgcn_s_sleep(1);
        if ((++sp & 255u) == 0u) { if (xb_ld(&bar[XB_TMO])) break; if (sp > XB_SPIN_CAP) { atomicAdd(&bar[XB_TMO], 1u); break; } }
    }
    nloc = mine > 0u ? mine : 1u; nx = cnt > 0u ? cnt : 1u;
}

__device__ __forceinline__ void xcd_barrier(const XcdBarrier& b) {
    asm volatile("s_waitcnt vmcnt(0)" ::: "memory");
    __syncthreads();
    if (threadIdx.x == 0) {
        unsigned* bar = b.bar;
        __builtin_amdgcn_s_waitcnt(0);
        unsigned nloc = b.st[0], nx = b.st[1];
        if (nloc == 0u) { xcd_barrier_complete(bar, b.x, nloc, nx); b.st[0] = nloc; b.st[1] = nx; }
        const unsigned old = xb_add(&bar[XB_XSUB(b.x)], 1u);
        const unsigned gen = old / nloc;
        if (old + 1u == (gen + 1u) * nloc) {
            __builtin_amdgcn_fence(__ATOMIC_RELEASE, "agent");
            asm volatile("s_waitcnt vmcnt(0)" ::: "memory");
            const unsigned og = xb_add(&bar[XB_TOP], 1u);
            const unsigned tg = og / nx;
            if (og + 1u == (tg + 1u) * nx) xb_add(&bar[XB_TOPGEN], 1u);
            else XB_SPIN(xb_ld(&bar[XB_TOPGEN]) == tg, bar);
            __builtin_amdgcn_fence(__ATOMIC_ACQUIRE, "agent");
            xb_add(&bar[XB_XGEN(b.x)], 1u);
            asm volatile("s_waitcnt vmcnt(0)" ::: "memory");
        } else {
            XB_SPIN(xb_ld(&bar[XB_XGEN(b.x)]) == gen, bar);
            __builtin_amdgcn_fence(__ATOMIC_ACQUIRE, "agent");
            asm volatile("s_waitcnt vmcnt(0)" ::: "memory");
        }
    }
    __syncthreads();
}
namespace pg8 {
typedef int v4i_t __attribute__((ext_vector_type(4)));
typedef int v8i_t __attribute__((ext_vector_type(8)));
constexpr int BM = 256, BK = 64, HALF = 128, HTB = HALF * BK * 2  , STAGE_BYTES = 8 * HTB, NXCD = 8, WGM = 8;
__host__ __device__ __forceinline__ int lds_byte(int r, int c) { const int st = (r >> 4) * 2 + (c >> 5), rr = r & 15, cc = c & 31, ob = rr * 64 + cc * 2; return st * 1024 + (ob ^ (((ob >> 9) & 1) << 5)); }
__host__ __device__ __forceinline__ void stage_rc(int b, int& R, int& C) { const int st = b / 1024, sb = b % 1024, swz = sb ^ (((sb >> 9) & 1) << 5); R = (st >> 1) * 16 + swz / 64; C = (st & 1) * 32 + (swz % 64) / 2; }
__host__ __device__ __forceinline__ int perm32(int rho) { const int n = rho >> 4, i = rho & 15; return 8 * (i >> 2) + 4 * n + (i & 3); }

struct Unit { int pm, pn, e, j0, kt0, nkt, slice; };
struct Gemm { const bf16_t* A; const bf16_t* Bt; int K; };

struct StaticOrder {
    int nM, nN, nwg, G, c, nkt;
    __device__ void init(int M, int N, int K, int G_, int c_) { nM = M / BM; nN = N / BM; nwg = nM * nN; G = G_; c = c_; nkt = K / BK; }
    __device__ bool next(int i, Unit& u) const {
        const long L = (long)i * G + c; if (L >= nwg) return false;
        int wgid = (int)L; { const int q = nwg / NXCD, r = nwg % NXCD, xcd = wgid % NXCD, off = wgid / NXCD; wgid = (xcd < r ? xcd * (q + 1) : r * (q + 1) + (xcd - r) * q) + off; }
        const int nig = WGM * nN, gid = wgid / nig, fm = gid * WGM, gsz = (nM - fm) < WGM ? (nM - fm) : WGM;
        u.pm = fm + ((wgid % nig) % gsz); u.pn = (wgid % nig) / gsz; u.e = 0; u.j0 = 0; u.kt0 = 0; u.nkt = nkt; u.slice = -1; return true;
    }
    __device__ __forceinline__ int arow(const Unit&, int) const { return 0; }
};
struct SplitOrder {
    StaticOrder main; int nExtra, S, nN, nktS;
    __device__ void init(int Mmain, int Mextra, int N, int K, int S_, int G_, int c_) { main.init(Mmain, N, K, G_, c_); nExtra = Mextra / BM; S = S_; nN = N / BM; nktS = (K / BK) / S_; }
    __device__ bool next(int i, Unit& u) const {
        const long L = (long)i * main.G + main.c;
        if (L < main.nwg) return main.next(i, u);
        const int idx = (int)(L - main.nwg); if (idx >= nExtra * nN * S) return false;
        const int sl = idx % S, r = idx / S;
        u.pm = main.nM + r / nN; u.pn = r % nN; u.e = 0; u.j0 = 0; u.kt0 = sl * nktS; u.nkt = nktS; u.slice = sl; return true;
    }
    __device__ __forceinline__ int arow(const Unit&, int) const { return 0; }
};

struct MoeOrder {
    int G, c, nN, t0, ntp, S, nktS; int tc[NE]; int cnt[NE]; const int* tlist;
    __device__ void init(const unsigned* cntp, const int* tl, int nN_, int nkt_, int G_, int c_) {
        G = G_; c = c_; nN = nN_; tlist = tl; S = 1; nktS = nkt_; int tot = 0;
#pragma unroll
        for (int e = 0; e < NE; ++e) { cnt[e] = (int)cntp[e]; tc[e] = (cnt[e] + 255) >> 8; tot += tc[e]; }
        t0 = 0; ntp = tot;
    }
    __device__ bool next(int i, Unit& u) const {
        const int L0 = i * G + c; if (L0 >= ntp * nN * S) return false;
        const int sl = L0 % S, L = L0 / S;
        const int g = L / (8 * nN), r = L - g * 8 * nN, gsz = (ntp - 8 * g) < 8 ? (ntp - 8 * g) : 8;
        const int pml = 8 * g + r % gsz, pnl = r / gsz, gt = t0 + pml;
        int e = 0, base = 0, run = 0; bool found = false;
#pragma unroll
        for (int k = 0; k < NE; ++k) { if (!found && gt < run + tc[k]) { e = k; base = run; found = true; } run += tc[k]; }
        u.pm = pml; u.pn = e * nN + pnl; u.e = e; u.j0 = (gt - base) * 256; u.kt0 = sl * nktS; u.nkt = nktS; u.slice = S > 1 ? sl : -1; return true;
    }
    __device__ __forceinline__ int arow(const Unit& u, int r) const {
        int j = u.j0 + r; int ce = 0;
#pragma unroll
        for (int k = 0; k < NE; ++k) ce = (u.e == k) ? cnt[k] : ce;
        if (j > ce - 1) j = ce - 1;
        return tlist[u.e * 16384 + j];
    }
};

struct EpiBf16 {
    bf16_t* O; int ldc; int row_off; int pn_mod; float* slab; int slab_row0, slab_rows; float scale;
    DI void operator()(const f32x4 (&acc)[2][2][4][2], const Unit& u, int wr, int wc, int fr, int fq) const {
        const int pn = pn_mod ? u.pn % pn_mod : u.pn;
        const int row0 = row_off + u.pm * BM + wr * 64 + fr, col0 = pn * BM + wc * 32 + 8 * fq;
        if (u.slice >= 0) {
#pragma unroll
            for (int ai = 0; ai < 2; ++ai)
#pragma unroll
                for (int m = 0; m < 4; ++m) { float* rowp = slab + ((size_t)u.slice * slab_rows + (row0 - slab_row0 + ai * HALF + m * 16)) * ldc + col0;
#pragma unroll
                    for (int bj = 0; bj < 2; ++bj) { *(f32x4*)(rowp + bj * HALF) = acc[ai][bj][m][0] * scale; *(f32x4*)(rowp + bj * HALF + 4) = acc[ai][bj][m][1] * scale; } }
            return;
        }
#pragma unroll
        for (int ai = 0; ai < 2; ++ai)
#pragma unroll
            for (int m = 0; m < 4; ++m) { bf16_t* rowp = O + (size_t)(row0 + ai * HALF + m * 16) * ldc + col0;
#pragma unroll
                for (int bj = 0; bj < 2; ++bj) { const f32x4 v0 = acc[ai][bj][m][0] * scale, v1 = acc[ai][bj][m][1] * scale;
                    u32x4 w; w.x = pk2(v0[0], v0[1]); w.y = pk2(v0[2], v0[3]); w.z = pk2(v1[0], v1[1]); w.w = pk2(v1[2], v1[3]);
                    *(u32x4*)(rowp + bj * HALF) = w; } }
    }
};
DI float clamp8(float x) { return fminf(fmaxf(x, -448.f), 448.f); }
DI unsigned pk4_fp8(float a, float b, float c_, float d) { int w = 0; w = __builtin_amdgcn_cvt_pk_fp8_f32(a, b, w, false); w = __builtin_amdgcn_cvt_pk_fp8_f32(c_, d, w, true); return (unsigned)w; }
struct EpiSwiglu8 {
    unsigned char* O; int ldc; int pn_mod; float sc, asc;
    DI void operator()(const f32x4 (&acc)[2][2][4][2], const Unit& u, int wr, int wc, int fr, int fq) const {
        const int pn = pn_mod ? u.pn % pn_mod : u.pn;
        const int row0 = u.pm * BM + wr * 64 + fr, col0 = pn * HALF + wc * 32 + 8 * fq;
        const float k1 = -sc * 1.4426950408889634f, k2 = sc * sc * asc;
#pragma unroll
        for (int ai = 0; ai < 2; ++ai)
#pragma unroll
            for (int m = 0; m < 4; ++m) {
                float o[8];
#pragma unroll
                for (int n = 0; n < 2; ++n)
#pragma unroll
                    for (int k = 0; k < 4; ++k) { const float ag = acc[ai][0][m][n][k], au = acc[ai][1][m][n][k];
                        const float r = __builtin_amdgcn_rcpf(1.f + __builtin_amdgcn_exp2f(ag * k1));
                        o[n * 4 + k] = __builtin_amdgcn_fmed3f((ag * k2) * au * r, -448.f, 448.f); }
                u32x2 w; w.x = pk4_fp8(o[0], o[1], o[2], o[3]); w.y = pk4_fp8(o[4], o[5], o[6], o[7]);
                *(u32x2*)(O + (size_t)(row0 + ai * HALF + m * 16) * ldc + col0) = w; }
    }
};
struct EpiBf16S {
    bf16_t* O; int ldc; int pn_mod; float scale;
    DI void operator()(const f32x4 (&acc)[2][2][4][2], const Unit& u, int wr, int wc, int fr, int fq) const {
        const int pn = pn_mod ? u.pn % pn_mod : u.pn;
        const int row0 = u.pm * BM + wr * 64 + fr, col0 = pn * BM + wc * 32 + 8 * fq;
#pragma unroll
        for (int ai = 0; ai < 2; ++ai)
#pragma unroll
            for (int m = 0; m < 4; ++m) { bf16_t* rowp = O + (size_t)(row0 + ai * HALF + m * 16) * ldc + col0;
#pragma unroll
                for (int bj = 0; bj < 2; ++bj) { const f32x4 v0 = acc[ai][bj][m][0] * scale, v1 = acc[ai][bj][m][1] * scale;
                    u32x4 w; w.x = pk2(v0[0], v0[1]); w.y = pk2(v0[2], v0[3]); w.z = pk2(v1[0], v1[1]); w.w = pk2(v1[2], v1[3]);
                    *(u32x4*)(rowp + bj * HALF) = w; } }
    }
};
struct EpiF32 {
    float* O; int ldc;
    DI void operator()(const f32x4 (&acc)[2][2][4][2], const Unit& u, int wr, int wc, int fr, int fq) const {
        const int row0 = u.pm * BM + wr * 64 + fr, col0 = u.pn * BM + wc * 32 + 8 * fq;
#pragma unroll
        for (int ai = 0; ai < 2; ++ai)
#pragma unroll
            for (int m = 0; m < 4; ++m) { float* rowp = O + (size_t)(row0 + ai * HALF + m * 16) * ldc + col0;
#pragma unroll
                for (int bj = 0; bj < 2; ++bj) { *(f32x4*)(rowp + bj * HALF) = acc[ai][bj][m][0]; *(f32x4*)(rowp + bj * HALF + 4) = acc[ai][bj][m][1]; } }
    }
};
struct EpiSwiglu {
    bf16_t* O; int ldc; int pn_mod;
    DI void operator()(const f32x4 (&acc)[2][2][4][2], const Unit& u, int wr, int wc, int fr, int fq) const {
        const int pn = pn_mod ? u.pn % pn_mod : u.pn;
        const int row0 = u.pm * BM + wr * 64 + fr, col0 = pn * HALF + wc * 32 + 8 * fq;
#pragma unroll
        for (int ai = 0; ai < 2; ++ai)
#pragma unroll
            for (int m = 0; m < 4; ++m) {
                float o[8];
#pragma unroll
                for (int n = 0; n < 2; ++n)
#pragma unroll
                    for (int k = 0; k < 4; ++k) { const float g = acc[ai][0][m][n][k], up = acc[ai][1][m][n][k]; o[n * 4 + k] = g * __builtin_amdgcn_rcpf(1.f + __expf(-g)) * up; }
                u32x4 w; w.x = pk2(o[0], o[1]); w.y = pk2(o[2], o[3]); w.z = pk2(o[4], o[5]); w.w = pk2(o[6], o[7]);
                *(u32x4*)(O + (size_t)(row0 + ai * HALF + m * 16) * ldc + col0) = w; }
    }
};


__host__ __device__ __forceinline__ int win_col_pos(int c) {
    if (c < 512) { const int g = (c >> 2) & 3; return (c & ~12) | ((g == 1 ? 2 : g == 2 ? 1 : g) << 2); }
    if ((c >= 768 && c < 1152) || (c >= 2048 && c < 2560)) { const int g = (c >> 2) & 7; return (c & ~28) | ((g < 4 ? 2 * g : 2 * (g - 4) + 1) << 2); }
    return c;
}
constexpr float DA_QSCALE = 0.17677669529663687f * 1.4426950408889634f, FA_QSCALE = 0.125f * 1.4426950408889634f;
struct EpiWin {
    bf16_t* P; bf16_t* VT; const float2* tab;
    DI void operator()(const f32x4 (&acc)[2][2][4][2], const Unit& u, int wr, int wc, int fr, int fq) const {
        const int lane = fq * 16 + fr;
        const bool xrows = u.pm < TX / BM;
#pragma unroll
        for (int bj = 0; bj < 2; ++bj) {
            const int cg = u.pn * BM + bj * HALF + wc * 32;
            int cls = 0;
            if (cg < 512) cls = 1;
            else if (cg < 768) cls = 0;
            else if (cg < 1152) cls = 2;
            else if (cg >= 2048 && cg < 2560) cls = 2;
            if (!xrows) cls = 0;
#pragma unroll
            for (int ai = 0; ai < 2; ++ai)
#pragma unroll
                for (int m = 0; m < 4; ++m) {
                    const int r = u.pm * BM + ai * HALF + wr * 64 + m * 16 + fr;
                    f32x4 v0 = acc[ai][bj][m][0], v1 = acc[ai][bj][m][1];
                    if (cg < 256) { v0 *= DA_QSCALE; v1 *= DA_QSCALE; }
                    else if ((cg >= 768 && cg < 1024) || (cg >= 1280 && cg < 1536)) { v0 *= FA_QSCALE; v1 *= FA_QSCALE; }
                    if (cls != 0) {
                        const int s = r & (SEQ - 1);
                        const int ax = cls == 1 ? (fq >> 1) : ((cg >> 5) & 1);
                        const int pos = ax ? (s & 63) : (s >> 6);
                        const float2* tb = tab + pos * 24 + (cls == 1 ? 4 * (fq & 1) : 8 + 4 * fq);
                        const f32x4 c01 = *(const f32x4*)(tb), c23 = *(const f32x4*)(tb + 2);
                        const f32x4 cs = (f32x4){c01[0], c01[2], c23[0], c23[2]}, sn = (f32x4){c01[1], c01[3], c23[1], c23[3]};
                        const f32x4 a = v0, b = v1;
                        v0 = a * cs - b * sn; v1 = b * cs + a * sn;
                    }
                    u32x4 w; w.x = pk2(v0[0], v0[1]); w.y = pk2(v0[2], v0[3]); w.z = pk2(v1[0], v1[1]); w.w = pk2(v1[2], v1[3]);
                    *(u32x4*)(P + (size_t)r * INW + cg + 8 * fq) = w;
                }
        }
    }
};

template <class Epi, class Sched, bool ALIGN_EPI, bool GATHER, bool FP8 = false>
DI void gemm_phase(LAS unsigned char* lds, const Gemm g, const Sched& S, const Epi& E, int wave_in) {
    int wv_ = wave_in; asm volatile("" : "+s"(wv_)); const int tid = lane_id_fresh() + 64 * wv_;
    const int wid = __builtin_amdgcn_readfirstlane(tid >> 6), lane = tid & 63, wr = wid >> 2, wc = wid & 3, fr = lane & 15, fq = lane >> 4;
    const int K = FP8 ? g.K / 2 : g.K;
    unsigned voffB[2]; int RA[2], CA[2];
#pragma unroll
    for (int i = 0; i < 2; ++i) { int R, C; stage_rc(tid * 16 + i * 8192, R, C); const int Rb = (R & ~31) + perm32(R & 31);
        RA[i] = R; CA[i] = C; voffB[i] = (unsigned)(Rb * K + C) * 2u; }
    const size_t kstep = (size_t)(BK * 2);
    const size_t hstep = (size_t)HALF * K * 2;
    const size_t tstep = 2 * hstep;
    const unsigned ldsw = (unsigned)wid * 1024u;
    const int aoff = lds_byte(wr * 64 + fr, fq * 8), boff = lds_byte(wc * 32 + fr, fq * 8);
#define PG8_SA(b, h) (((b) * 2 + (h)) * HTB)
#define PG8_SB(b, h) ((4 + (b) * 2 + (h)) * HTB)
#define PG8_STAGE(bufoff, gbase, voff) do { _Pragma("unroll") for (int _i = 0; _i < 2; ++_i) \
        __builtin_amdgcn_global_load_lds((const unsigned*)((const char*)(gbase) + (voff)[_i]), (LAS unsigned*)(lds + (bufoff) + ldsw + _i * 8192), 16, 0, 0); } while (0)
#define PG8_LDA(dst, b, h) do { _Pragma("unroll") for (int m = 0; m < 4; ++m) { \
        if constexpr (FP8) dst##8[m] = __builtin_shufflevector(*(const LAS v4i_t*)(lds + PG8_SA(b, h) + aoff + m * 2048), *(const LAS v4i_t*)(lds + PG8_SA(b, h) + aoff + m * 2048 + 1024), 0, 1, 2, 3, 4, 5, 6, 7); \
        else { _Pragma("unroll") for (int k = 0; k < 2; ++k) dst[m][k] = *(const LAS bf16x8*)(lds + PG8_SA(b, h) + aoff + m * 2048 + k * 1024); } } } while (0)
#define PG8_LDB(dst, b, h) do { _Pragma("unroll") for (int n = 0; n < 2; ++n) { \
        if constexpr (FP8) dst##8[n] = __builtin_shufflevector(*(const LAS v4i_t*)(lds + PG8_SB(b, h) + boff + n * 2048), *(const LAS v4i_t*)(lds + PG8_SB(b, h) + boff + n * 2048 + 1024), 0, 1, 2, 3, 4, 5, 6, 7); \
        else { _Pragma("unroll") for (int k = 0; k < 2; ++k) dst[n][k] = *(const LAS bf16x8*)(lds + PG8_SB(b, h) + boff + n * 2048 + k * 1024); } } } while (0)
#define PG8_MMA(ai, bj, At, Bt) do { __builtin_amdgcn_s_setprio(1); _Pragma("unroll") for (int m = 0; m < 4; ++m) _Pragma("unroll") for (int n = 0; n < 2; ++n) { \
        if constexpr (FP8) asm volatile("v_mfma_f32_16x16x128_f8f6f4 %0, %1, %2, %0" : "+v"(acc[ai][bj][m][n]) : "v"(Bt##8[n]), "v"(At##8[m]));   \
        else { _Pragma("unroll") for (int k = 0; k < 2; ++k) acc[ai][bj][m][n] = __builtin_amdgcn_mfma_f32_16x16x32_bf16(Bt[n][k], At[m][k], acc[ai][bj][m][n], 0, 0, 0); } } \
        __builtin_amdgcn_s_setprio(0); } while (0)
#define PG8_WAIT_V(n) asm volatile("s_waitcnt vmcnt(" #n ")" ::: "memory")
#define PG8_WAIT_L(n) asm volatile("s_waitcnt lgkmcnt(" #n ")" ::: "memory")
#define PG8_BAR __builtin_amdgcn_s_barrier()
#define PG8_SCHED __builtin_amdgcn_sched_barrier(0)
#define PG8_SETV(V, u) do { _Pragma("unroll") for (int _h = 0; _h < 2; ++_h) _Pragma("unroll") for (int _i = 0; _i < 2; ++_i) \
        V[_h][_i] = GATHER ? (unsigned)S.arow(u, _h * HALF + RA[_i]) * (unsigned)(K * 2) + (unsigned)(CA[_i] * 2) : (unsigned)(_h * (int)hstep) + (unsigned)(RA[_i] * K + CA[_i]) * 2u; } while (0)
    Unit cur, nxt; int ui = 0;
    if (!S.next(0, cur)) return;
    f32x4 acc[2][2][4][2];
#pragma unroll
    for (int a = 0; a < 2; ++a)
#pragma unroll
        for (int b = 0; b < 2; ++b)
#pragma unroll
            for (int m = 0; m < 4; ++m)
#pragma unroll
                for (int n = 0; n < 2; ++n) acc[a][b][m][n] = (f32x4){0.f, 0.f, 0.f, 0.f};
    bf16x8 At[4][2], B0[2][2], B1[2][2];
    v8i_t At8[4], B08[2], B18[2];
    unsigned vA[2][2], vN[2][2];
    PG8_SETV(vA, cur);
    if (GATHER) PG8_WAIT_V(0);
    int nt = cur.nkt;
    const char* cA = (GATHER ? (const char*)g.A : (const char*)g.A + (size_t)cur.pm * tstep) + (size_t)cur.kt0 * kstep; const char* cB = (const char*)g.Bt + (size_t)cur.pn * tstep + (size_t)cur.kt0 * kstep;
    PG8_STAGE(PG8_SB(0, 0), cB, voffB); PG8_STAGE(PG8_SB(0, 1), cB + hstep, voffB); PG8_STAGE(PG8_SA(0, 0), cA, vA[0]); PG8_STAGE(PG8_SA(0, 1), cA, vA[1]);
    if (wr == 1) PG8_BAR;
    PG8_WAIT_V(2); PG8_BAR;
    PG8_STAGE(PG8_SB(1, 0), cB + kstep, voffB); PG8_STAGE(PG8_SA(1, 0), cA + kstep, vA[0]); PG8_STAGE(PG8_SB(1, 1), cB + hstep + kstep, voffB);
    PG8_WAIT_V(6); PG8_BAR;
    for (;;) {
        const bool has_next = S.next(ui + 1, nxt);
        if constexpr (GATHER) {
            if (has_next) { PG8_SETV(vN, nxt); }
            else {
#pragma unroll
                for (int h = 0; h < 2; ++h)
#pragma unroll
                    for (int i = 0; i < 2; ++i) vN[h][i] = vA[h][i]; }
        }
        const char* nA = has_next ? (GATHER ? (const char*)g.A : (const char*)g.A + (size_t)nxt.pm * tstep) + (size_t)nxt.kt0 * kstep : cA; const char* nB = has_next ? (const char*)g.Bt + (size_t)nxt.pn * tstep + (size_t)nxt.kt0 * kstep : cB;
        for (int t = 0; t < nt; t += 2) {
            const bool last = (t == nt - 2);
            const char* a1 = cA + (size_t)(t + 1) * kstep;
            const char* a2 = last ? nA : cA + (size_t)(t + 2) * kstep; const char* b2 = last ? nB : cB + (size_t)(t + 2) * kstep;
            const char* a3 = a2 + kstep; const char* b3 = b2 + kstep;
            unsigned w0[2], w1[2];
#pragma unroll
            for (int i = 0; i < 2; ++i) { w0[i] = (GATHER && last) ? vN[0][i] : vA[0][i]; w1[i] = (GATHER && last) ? vN[1][i] : vA[1][i]; }
            PG8_LDB(B0, 0, 0); PG8_LDB(B1, 0, 1); PG8_SCHED; PG8_LDA(At, 0, 0); PG8_STAGE(PG8_SA(1, 1), a1, vA[1]);
            PG8_WAIT_V(8); PG8_WAIT_L(0); PG8_BAR; PG8_MMA(0, 0, At, B0); PG8_MMA(0, 1, At, B1); PG8_BAR; PG8_SCHED;
            PG8_LDA(At, 0, 1); PG8_STAGE(PG8_SB(0, 0), b2, voffB); PG8_STAGE(PG8_SB(0, 1), b2 + hstep, voffB); PG8_STAGE(PG8_SA(0, 0), a2, w0);
            PG8_WAIT_V(8); PG8_WAIT_L(0); PG8_BAR; PG8_MMA(1, 0, At, B0); PG8_MMA(1, 1, At, B1); PG8_BAR; PG8_SCHED;
            PG8_LDB(B0, 1, 0); PG8_LDB(B1, 1, 1); PG8_SCHED; PG8_LDA(At, 1, 0); PG8_STAGE(PG8_SA(0, 1), a2, w1);
            PG8_WAIT_V(8); PG8_WAIT_L(0); PG8_BAR; PG8_MMA(0, 0, At, B0); PG8_MMA(0, 1, At, B1); PG8_BAR; PG8_SCHED;
            PG8_LDA(At, 1, 1); PG8_STAGE(PG8_SB(1, 0), b3, voffB); PG8_STAGE(PG8_SB(1, 1), b3 + hstep, voffB); PG8_STAGE(PG8_SA(1, 0), a3, w0);
            PG8_WAIT_V(8); PG8_WAIT_L(0); PG8_BAR; PG8_MMA(1, 0, At, B0); PG8_MMA(1, 1, At, B1); PG8_BAR; PG8_SCHED;
        }
        if constexpr (ALIGN_EPI) { if (wr == 0) PG8_BAR; }
        if constexpr (FP8) asm volatile("s_nop 15\n\ts_nop 15" ::: "memory");
        E(acc, cur, wr, wc, fr, fq);
        if (!has_next) break;
#pragma unroll
        for (int a = 0; a < 2; ++a)
#pragma unroll
            for (int b = 0; b < 2; ++b)
#pragma unroll
                for (int m = 0; m < 4; ++m)
#pragma unroll
                    for (int n = 0; n < 2; ++n) acc[a][b][m][n] = (f32x4){0.f, 0.f, 0.f, 0.f};
        cur = nxt; cA = nA; cB = nB; ++ui; nt = cur.nkt;
        if constexpr (GATHER) {
#pragma unroll
            for (int h = 0; h < 2; ++h)
#pragma unroll
                for (int i = 0; i < 2; ++i) vA[h][i] = vN[h][i]; }
        if constexpr (ALIGN_EPI) { if (wr == 1) PG8_BAR; }
    }
    PG8_WAIT_V(0);
    if constexpr (!ALIGN_EPI) { if (wr == 0) PG8_BAR; }
    PG8_BAR;
#undef PG8_SA
#undef PG8_SB
#undef PG8_STAGE
#undef PG8_LDA
#undef PG8_LDB
#undef PG8_MMA
#undef PG8_WAIT_V
#undef PG8_WAIT_L
#undef PG8_BAR
#undef PG8_SCHED
#undef PG8_SETV
}
}
DI f32x4 ld_bf4(const bf16_t* p) { const u32x2 a = *(const u32x2*)p; f32x4 r; r.x = __uint_as_float(a.x << 16); r.y = __uint_as_float(a.x & 0xffff0000u); r.z = __uint_as_float(a.y << 16); r.w = __uint_as_float(a.y & 0xffff0000u); return r; }
struct Cx { LAS unsigned char* lds; int tid, lane, wave, vcu, G; };
DI Cx fresh(const Cx& c0) { Cx c; int g = c0.G, v = c0.vcu, w = c0.wave; asm volatile("" : "+s"(g), "+s"(v), "+s"(w));
    const int ln = lane_id_fresh();
    c.lds = c0.lds; c.wave = w; c.lane = ln; c.tid = w * 64 + ln; c.vcu = v; c.G = g; return c; }

template <bool WINPERM = false>
DI void tcvt_item(const float* W, int K, int N, bf16_t* WT, int rstride, int roff, LAS float* scr, int item, int lane) {
    const int nblk = N / 32, kb = item / nblk, nb = item % nblk, k0 = 64 * kb, n0 = 32 * nb;
#pragma unroll 8
    for (int i = 0; i < 32; ++i) { const int kk = 2 * i + (lane >> 5); scr[kk * 33 + (lane & 31)] = W[(size_t)(k0 + kk) * N + n0 + (lane & 31)]; }
    asm volatile("s_waitcnt lgkmcnt(0)" ::: "memory");
    const int c = lane & 7;
#pragma unroll
    for (int j = 0; j < 4; ++j) { const int n = (lane >> 3) + 8 * j; const LAS float* s = scr + (8 * c) * 33 + n;
        u32x4 o; o.x = pk2(s[0 * 33], s[1 * 33]); o.y = pk2(s[2 * 33], s[3 * 33]); o.z = pk2(s[4 * 33], s[5 * 33]); o.w = pk2(s[6 * 33], s[7 * 33]);
        const int ncol = WINPERM ? pg8::win_col_pos(n0 + n) : n0 + n, drow = (ncol >> 7) * rstride + roff + (ncol & 127);
        *(u32x4*)(WT + (size_t)drow * K + k0 + 8 * c) = o; }
    asm volatile("s_waitcnt lgkmcnt(0)" ::: "memory");
}
DI void tcvt_item8(const float* W, int K, int N, unsigned char* WT, int rstride, int roff, LAS float* scr, int item, int lane) {
    const int nblk = N / 32, kb = item / nblk, nb = item % nblk, k0 = 64 * kb, n0 = 32 * nb;
#pragma unroll 8
    for (int i = 0; i < 32; ++i) { const int kk = 2 * i + (lane >> 5); scr[kk * 33 + (lane & 31)] = W[(size_t)(k0 + kk) * N + n0 + (lane & 31)]; }
    asm volatile("s_waitcnt lgkmcnt(0)" ::: "memory");
    const int c = lane & 7;
#pragma unroll
    for (int j = 0; j < 4; ++j) { const int n = (lane >> 3) + 8 * j; const LAS float* s = scr + (8 * c) * 33 + n;
        u32x2 o; o.x = pg8::pk4_fp8(s[0 * 33] * W8_SCALE, s[1 * 33] * W8_SCALE, s[2 * 33] * W8_SCALE, s[3 * 33] * W8_SCALE); o.y = pg8::pk4_fp8(s[4 * 33] * W8_SCALE, s[5 * 33] * W8_SCALE, s[6 * 33] * W8_SCALE, s[7 * 33] * W8_SCALE);
        const int ncol = n0 + n, drow = (ncol >> 7) * rstride + roff + (ncol & 127);
        *(u32x2*)(WT + (size_t)drow * K + k0 + 8 * c) = o; }
    asm volatile("s_waitcnt lgkmcnt(0)" ::: "memory");
}
constexpr int I_IN = 16 * 96, I_OUT = 16 * 32, I_FG = 16 * 88, I_FD = 44 * 32, I_MG = 16 * 112, I_MD = 56 * 32, MOE_ITEMS = 16 * I_MG + 8 * I_MD;
constexpr int BG_N = 6;
constexpr int bg_cu0(int w) { return w == 0 ? 24 : w == 1 ? 32 : w == 2 ? 172 : w == 3 ? 24 : w == 4 ? 168 : 128; }
constexpr int bg_pw(int w) { return w == 0 ? 5 : w == 1 ? 2 : w == 2 ? 8 : w == 3 ? 5 : 2; }
constexpr int bg_count(int w) { return (256 - bg_cu0(w)) * NWAVES * bg_pw(w); }
constexpr int bg_base(int w) { return w >= BG_N ? MOE_ITEMS : bg_base(w + 1) - bg_count(w); }
DI void moe_item(const Params& p, LAS float* scr, int r, int lane) {
    unsigned char* ws = p.ws;
    if (r < 16 * I_MG) { const int q = r / I_MG, u = q >> 3, e = q & 7;
        tcvt_item8((u ? p.moe_wu : p.moe_wg) + (size_t)e * D * ED, D, ED, ws + OFF_MGU + (size_t)e * 2 * ED * D, 256, u * 128, scr, r % I_MG, lane); return; }
    r -= 16 * I_MG;
    { const int e = r / I_MD; tcvt_item8(p.moe_wd + (size_t)e * ED * D, ED, D, ws + OFF_MD + (size_t)e * D * ED, 128, 0, scr, r % I_MD, lane); }
}
template <int W>
DI void bg_convert(const Params& p, const Cx& c0) {
    constexpr int CU0 = bg_cu0(W), PW = bg_pw(W), BASE = bg_base(W);
    if (c0.G != 256) return;
    const int bid = (int)blockIdx.x;
    if (bid < CU0) return;
    const Cx c = fresh(c0);
    LAS float* scr = (LAS float*)(c.lds + c.wave * 16384);
    const int first = BASE + ((bid - CU0) * NWAVES + c.wave) * PW;
    for (int k = 0; k < PW; ++k) moe_item(p, scr, first + k, c.lane);
}
DI void phase_convert(const Params& p, const Cx& c0) {
    const Cx c = fresh(c0);
    LAS float* scr = (LAS float*)(c.lds + c.wave * 16384);
    unsigned char* ws = p.ws;
    const int gw = c.vcu * NWAVES + c.wave, NGW = c.G * NWAVES;
    constexpr int NFIX = 2 * I_IN + 2 * I_OUT + 2 * I_FG + I_FD;
    constexpr int MOE_PRO = bg_base(0);
    const int NITEMS = NFIX + (c.G == 256 ? MOE_PRO : MOE_ITEMS);
    for (int it = gw; it < NITEMS; it += NGW) {
        int r = it;
        if (r < 2 * I_IN) { const int l = r / I_IN; tcvt_item<true>(p.w_in + (size_t)l * D * INW, D, INW, (bf16_t*)(ws + OFF_WIN) + (size_t)l * INW * D, 128, 0, scr, r % I_IN, c.lane); continue; } r -= 2 * I_IN;
        if (r < 2 * I_OUT) { const int l = r / I_OUT; tcvt_item(p.w_out + (size_t)l * D * D, D, D, (bf16_t*)(ws + OFF_WOUT) + (size_t)l * D * D, 128, 0, scr, r % I_OUT, c.lane); continue; } r -= 2 * I_OUT;
        if (r < 2 * I_FG) { const int u = r / I_FG; tcvt_item(u ? p.ffn_wu : p.ffn_wg, D, FF, (bf16_t*)(ws + OFF_WGU), 256, u * 128, scr, r % I_FG, c.lane); continue; } r -= 2 * I_FG;
        if (r < I_FD) { tcvt_item8(p.ffn_wd, FF, D, ws + OFF_WD, 128, 0, scr, r, c.lane); continue; } r -= I_FD;
        moe_item(p, scr, r, c.lane);
    }
}
DI void phase_mod(const Params& p, const Cx& c0) {
    const Cx c = fresh(c0);
    for (int i = c.vcu * NTHREADS + c.tid; i < 128 * 24; i += c.G * NTHREADS) {
        const int pos = i / 24, e = i % 24;
        const float inv = e < 8 ? powf(10000.f, -(float)e * 2.0f / 16.0f) : powf(10000.f, -(float)(e - 8) * 2.0f / 32.0f);
        float sn, cs; sincosf((float)pos * inv, &sn, &cs);
        ((float2*)(p.ws + OFF_ROPE))[i] = make_float2(cs, sn);
    }
    LAS float* red = (LAS float*)(c.lds);
    LAS float* sl = red + 8 * 48 * 3;
    __syncthreads();
    for (int i = c.tid; i < 3 * 1024; i += NTHREADS) sl[i] = silu_f(i < 1024 ? p.c[i] : i < 2048 ? p.c[i] : p.c_ctx[i - 2048]);
    for (int cb = c.vcu; cb < 256; cb += c.G) {
        __syncthreads();
        if (c.tid < 384) {
            const int cl = c.tid % 48, kg = c.tid / 48, gc = cb * 48 + cl, layer = gc / 6144, col = gc % 6144;
            const float* w = p.w_mod + (size_t)layer * D * 6144 + col;
            float a0 = 0.f, a1 = 0.f, a2 = 0.f;
#pragma unroll 16
            for (int k = kg * 128; k < kg * 128 + 128; ++k) { const float wv = w[(size_t)k * 6144]; a0 += sl[k] * wv; a1 += sl[1024 + k] * wv; a2 += sl[2048 + k] * wv; }
            red[(kg * 48 + cl) * 3 + 0] = a0; red[(kg * 48 + cl) * 3 + 1] = a1; red[(kg * 48 + cl) * 3 + 2] = a2;
        }
        __syncthreads();
        if (c.tid < 144) {
            const int cl = c.tid % 48, v = c.tid / 48, gc = cb * 48 + cl, layer = gc / 6144, col = gc % 6144;
            float s = p.b_mod[layer * 6144 + col];
#pragma unroll
            for (int kg = 0; kg < 8; ++kg) s += red[(kg * 48 + cl) * 3 + v];
            ((float*)(p.ws + OFF_MOD))[(size_t)(layer * 3 + v) * 6144 + col] = s;
        }
    }
    __syncthreads();
}
DI void phase_norm1(const Params& p, const Cx& c0, int layer) {
    const Cx c = fresh(c0);
    const int gw = c.vcu * NWAVES + c.wave, NGW = c.G * NWAVES;
    f32x4 v[4], vn[4];
    if (gw < T) { const f32x4* xr = (const f32x4*)xin0_row(p, gw) + c.lane;
#pragma unroll
        for (int j = 0; j < 4; ++j) v[j] = xr[64 * j]; }
    for (int row = gw; row < T; row += NGW) {
        if (row + NGW < T) { const f32x4* xn = (const f32x4*)xin0_row(p, row + NGW) + c.lane;
#pragma unroll
            for (int j = 0; j < 4; ++j) vn[j] = xn[64 * j]; }
        float s = 0.f;
#pragma unroll
        for (int j = 0; j < 4; ++j) s += (v[j].x * v[j].x + v[j].y * v[j].y) + (v[j].z * v[j].z + v[j].w * v[j].w);
        const float r = rsqrtf(wave_sum(s, c.lane) * (1.f / D) + EPS);
        const float* mod = mod_row(p, layer, row);
        const float* g = p.g_attn_pre + layer * D;
        bf16_t* h = (bf16_t*)(p.ws + OFF_H) + (size_t)row * D;
#pragma unroll
        for (int j = 0; j < 4; ++j) { const int idx = (c.lane + 64 * j) * 4;
            const f32x4 gg = *(const f32x4*)(g + idx), sh = *(const f32x4*)(mod + idx), sc = *(const f32x4*)(mod + 1024 + idx);
            const f32x4 o = v[j] * r * gg * (sc + 1.f) + sh;
            uint2 w; w.x = pk2(o.x, o.y); w.y = pk2(o.z, o.w); *(uint2*)(h + idx) = w; }
#pragma unroll
        for (int j = 0; j < 4; ++j) v[j] = vn[j];
    }
}
DI int ret_row(int b, int n) { return n < 2 ? TX + b * CTXL + n * 128 : b * SEQ + (n - 2) * 128; }
DI float logsig(float g) { return -log1pf(expf(-g)); }

DI void phase_post_attn(const Params& p, const Cx& c0, int layer) {
    const Cx c = fresh(c0);
    const int gw = c.vcu * NWAVES + c.wave, NGW = c.G * NWAVES, rows = layer == 0 ? T : TX;
    constexpr int RT_MAXSEL = 512;
    LAS int* rsel = (LAS int*)(c.lds + c.wave * (RT_MAXSEL * 16 + 64));
    int nsel = 0;
    f32x4 y[4], x1[4], yn[4], xn[4];
    auto load_row = [&](int row, f32x4 (&yy)[4], f32x4 (&xx)[4]) {
        const bf16_t* yr = (const bf16_t*)(p.ws + OFF_B) + (size_t)row * D + c.lane * 4;
        const f32x4* xr = (const f32x4*)xin0_row(p, row) + c.lane;
        const bf16_t* xsr = (const bf16_t*)(p.ws + OFF_XS) + (size_t)row * D;
#pragma unroll
        for (int j = 0; j < 4; ++j) {
            if (layer == 0 && row >= TX) { const float* sl = (const float*)(p.ws + OFF_B + B_SLAB_Y) + (size_t)(row - TX) * D + (c.lane + 64 * j) * 4;
                yy[j] = *(const f32x4*)sl;
#pragma unroll
                for (int k = 1; k < WOUT_SPLIT; ++k) yy[j] = yy[j] + *(const f32x4*)(sl + (size_t)k * TC * D); }
            else yy[j] = ld_bf4(yr + 256 * j);
            xx[j] = layer == 0 ? xr[64 * j] : ld_bf4(xsr + (c.lane + 64 * j) * 4); }
    };
    if (gw < rows) load_row(gw, y, x1);
    for (int row = gw; row < rows; row += NGW) {
        if (row + NGW < rows) load_row(row + NGW, yn, xn);
        bf16_t* xs = (bf16_t*)(p.ws + OFF_XS) + (size_t)row * D;
        float s = 0.f;
#pragma unroll
        for (int j = 0; j < 4; ++j) s += (y[j].x * y[j].x + y[j].y * y[j].y) + (y[j].z * y[j].z + y[j].w * y[j].w);
        const float r = rsqrtf(wave_sum(s, c.lane) * (1.f / D) + EPS);
        const float* mod = mod_row(p, layer, row);
        float s2 = 0.f;
#pragma unroll
        for (int j = 0; j < 4; ++j) { const int idx = (c.lane + 64 * j) * 4;
            const f32x4 gp = *(const f32x4*)(p.g_attn_post + layer * D + idx), gt = *(const f32x4*)(mod + 2048 + idx);
            x1[j] = x1[j] + gt * (y[j] * r * gp);
            { u32x2 w; w.x = pk2(x1[j].x, x1[j].y); w.y = pk2(x1[j].z, x1[j].w); *(u32x2*)(xs + idx) = w; }
            s2 += (x1[j].x * x1[j].x + x1[j].y * x1[j].y) + (x1[j].z * x1[j].z + x1[j].w * x1[j].w); }
        const float r2 = rsqrtf(wave_sum(s2, c.lane) * (1.f / D) + EPS);
        bf16_t* h = (bf16_t*)(p.ws + OFF_H) + (size_t)row * D;
        float l8[8];
#pragma unroll
        for (int e = 0; e < 8; ++e) l8[e] = 0.f;
#pragma unroll
        for (int j = 0; j < 4; ++j) { const int idx = (c.lane + 64 * j) * 4;
            const f32x4 g2 = *(const f32x4*)(p.g_ffn_pre + layer * D + idx), sh = *(const f32x4*)(mod + 3072 + idx), sc = *(const f32x4*)(mod + 4096 + idx);
            const f32x4 hv = x1[j] * r2 * g2 * (sc + 1.f) + sh;
            if (layer == 0) { uint2 w; w.x = pk2(hv.x, hv.y); w.y = pk2(hv.z, hv.w); *(uint2*)(h + idx) = w; }
            else *(unsigned*)(p.ws + OFF_H8 + (size_t)row * D + idx) = pg8::pk4_fp8(pg8::clamp8(hv.x), pg8::clamp8(hv.y), pg8::clamp8(hv.z), pg8::clamp8(hv.w));
            if (layer == 1) {
#pragma unroll
                for (int i = 0; i < 4; ++i) { const f32x4 ra = *(const f32x4*)(p.router + (size_t)(idx + i) * 8), rb = *(const f32x4*)(p.router + (size_t)(idx + i) * 8 + 4);
                    const float hh = hv[i];
                    l8[0] += hh * ra.x; l8[1] += hh * ra.y; l8[2] += hh * ra.z; l8[3] += hh * ra.w; l8[4] += hh * rb.x; l8[5] += hh * rb.y; l8[6] += hh * rb.z; l8[7] += hh * rb.w; }
            } }
        if (layer == 1) {
#pragma unroll
            for (int e = 0; e < 8; ++e) l8[e] = wave_sum(l8[e], c.lane);
            if (c.lane == 0) {
                int i0 = 0; float v0 = l8[0];
#pragma unroll
                for (int e = 1; e < 8; ++e) if (l8[e] > v0) { v0 = l8[e]; i0 = e; }
                int i1 = -1; float v1 = -3.0e38f;
#pragma unroll
                for (int e = 0; e < 8; ++e) if (e != i0 && l8[e] > v1) { v1 = l8[e]; i1 = e; }
                const float e1 = expf(v1 - v0); const float w0 = 1.f / (1.f + e1), w1 = e1 / (1.f + e1);
                if (nsel < RT_MAXSEL) { rsel[nsel * 4] = row; rsel[nsel * 4 + 1] = i0 | (i1 << 8); rsel[nsel * 4 + 2] = __float_as_int(w0); rsel[nsel * 4 + 3] = __float_as_int(w1); }
            }
            ++nsel;
        }
#pragma unroll
        for (int j = 0; j < 4; ++j) { y[j] = yn[j]; x1[j] = xn[j]; }
    }
    if (layer == 1) {
        asm volatile("s_waitcnt lgkmcnt(0)" ::: "memory");
        unsigned* cnt = (unsigned*)(p.ws + OFF_CNT);
        int* tl = (int*)(p.ws + OFF_TLIST); int* te = (int*)(p.ws + OFF_TOKE); int* tj = (int*)(p.ws + OFF_TOKJ); float* tw = (float*)(p.ws + OFF_TOKW);
        LAS int* rbase = rsel + RT_MAXSEL * 4;
        if (c.lane < 8) { int n = 0;
            for (int k = 0; k < nsel; ++k) { const int ee = rsel[k * 4 + 1]; n += ((ee & 255) == c.lane) + ((ee >> 8) == c.lane); }
            rbase[c.lane] = n > 0 ? (int)atomicAdd(&cnt[c.lane], (unsigned)n) : 0; }
        asm volatile("s_waitcnt vmcnt(0) lgkmcnt(0)" ::: "memory");
        if (c.lane == 0) {
            for (int k = 0; k < nsel; ++k) { const int row = rsel[k * 4], ee = rsel[k * 4 + 1], i0 = ee & 255, i1 = ee >> 8;
                const int j0 = rbase[i0]; rbase[i0] = j0 + 1; const int j1 = rbase[i1]; rbase[i1] = j1 + 1;
                tl[i0 * 16384 + j0] = row; tl[i1 * 16384 + j1] = row;
                te[row * 2] = i0; te[row * 2 + 1] = i1; tj[row * 2] = j0; tj[row * 2 + 1] = j1; tw[row * 2] = __int_as_float(rsel[k * 4 + 2]); tw[row * 2 + 1] = __int_as_float(rsel[k * 4 + 3]); }
        }
    }
}
DI void phase_post_ffn(const Params& p, const Cx& c0, int layer) {
    const Cx c = fresh(c0);
    const int gw = c.vcu * NWAVES + c.wave, NGW = c.G * NWAVES, rows = layer == 0 ? T : TX;
    int off[8];
    if (layer == 1) { const unsigned* cnt = (const unsigned*)(p.ws + OFF_CNT); int a = 0;
#pragma unroll
        for (int e = 0; e < 8; ++e) { off[e] = a; a += ((int)cnt[e] + 255) & ~255; } }
    f32x4 f[4], xr1[4], fn[4], xn[4];
    u32x2 ea[4], eb_[4], ean[4], ebn[4]; float mw0 = 0.f, mw1 = 0.f, mw0n = 0.f, mw1n = 0.f; int ms0 = 0, ms1 = 0; float mq0 = 0.f, mq1 = 0.f;
    auto load_meta = [&](int row) {
        const int* te = (const int*)(p.ws + OFF_TOKE); const int* tj = (const int*)(p.ws + OFF_TOKJ); const float* tw = (const float*)(p.ws + OFF_TOKW);
        const int e0 = te[row * 2], e1 = te[row * 2 + 1];
        int s0 = 0, s1 = 0;
#pragma unroll
        for (int e = 0; e < 8; ++e) { if (e0 == e) s0 = off[e]; if (e1 == e) s1 = off[e]; }
        ms0 = s0 + tj[row * 2]; ms1 = s1 + tj[row * 2 + 1]; mq0 = tw[row * 2]; mq1 = tw[row * 2 + 1];
    };
    auto load_row1 = [&](int row, u32x2 (&a)[4], u32x2 (&b)[4], float& w0, float& w1, f32x4 (&xx)[4]) {
        const bf16_t* xsr = (const bf16_t*)(p.ws + OFF_XS) + (size_t)row * D;
        const bf16_t* O = (const bf16_t*)(p.ws + OFF_B);
#pragma unroll
        for (int j = 0; j < 4; ++j) { const int idx = (c.lane + 64 * j) * 4; xx[j] = ld_bf4(xsr + idx); a[j] = *(const u32x2*)(O + (size_t)ms0 * D + idx); b[j] = *(const u32x2*)(O + (size_t)ms1 * D + idx); }
        w0 = mq0; w1 = mq1;
    };
    auto load_row = [&](int row, f32x4 (&f)[4], f32x4 (&xx)[4]) {
        const bf16_t* xsr = (const bf16_t*)(p.ws + OFF_XS) + (size_t)row * D;
#pragma unroll
        for (int j = 0; j < 4; ++j) xx[j] = ld_bf4(xsr + (c.lane + 64 * j) * 4);
        if (layer == 0) {
            const bf16_t* fr = (const bf16_t*)(p.ws + OFF_B) + (size_t)row * D + c.lane * 4;
#pragma unroll
            for (int j = 0; j < 4; ++j) {
                if (row >= TX) { const float* sl = (const float*)(p.ws + OFF_B + B_SLAB_F) + (size_t)(row - TX) * D + (c.lane + 64 * j) * 4;
                    f[j] = *(const f32x4*)sl;
#pragma unroll
                    for (int k = 1; k < FFD_SPLIT; ++k) f[j] = f[j] + *(const f32x4*)(sl + (size_t)k * TC * D); }
                else f[j] = ld_bf4(fr + 256 * j); }
        } else {
            const int* te = (const int*)(p.ws + OFF_TOKE); const int* tj = (const int*)(p.ws + OFF_TOKJ); const float* tw = (const float*)(p.ws + OFF_TOKW);
            const int e0 = te[row * 2], e1 = te[row * 2 + 1];
            int s0 = 0, s1 = 0;
#pragma unroll
            for (int e = 0; e < 8; ++e) { if (e0 == e) s0 = off[e]; if (e1 == e) s1 = off[e]; }
            s0 += tj[row * 2]; s1 += tj[row * 2 + 1];
            const float w0 = tw[row * 2], w1 = tw[row * 2 + 1];
            const bf16_t* O = (const bf16_t*)(p.ws + OFF_B);
#pragma unroll
            for (int j = 0; j < 4; ++j) { const int idx = (c.lane + 64 * j) * 4;
                const f32x4 a = ld_bf4(O + (size_t)s0 * D + idx), bq = ld_bf4(O + (size_t)s1 * D + idx);
                f[j] = a * w0 + bq * w1; }
        }
    };
    if (layer == 0) { if (gw < rows) load_row(gw, f, xr1); }
    else if (gw < rows) { load_meta(gw); load_row1(gw, ea, eb_, mw0, mw1, xr1); if (gw + NGW < rows) load_meta(gw + NGW); }
    for (int row = gw; row < rows; row += NGW) {
        if (layer == 0) { if (row + NGW < rows) load_row(row + NGW, fn, xn); }
        else {
            if (row + NGW < rows) load_row1(row + NGW, ean, ebn, mw0n, mw1n, xn);
            if (row + 2 * NGW < rows) load_meta(row + 2 * NGW);
#pragma unroll
            for (int j = 0; j < 4; ++j) { const u32x2 a = ea[j], b = eb_[j];
                f[j] = (f32x4){__uint_as_float(a.x << 16), __uint_as_float(a.x & 0xffff0000u), __uint_as_float(a.y << 16), __uint_as_float(a.y & 0xffff0000u)} * mw0
                     + (f32x4){__uint_as_float(b.x << 16), __uint_as_float(b.x & 0xffff0000u), __uint_as_float(b.y << 16), __uint_as_float(b.y & 0xffff0000u)} * mw1; }
        }
        float s = 0.f;
#pragma unroll
        for (int j = 0; j < 4; ++j) s += (f[j].x * f[j].x + f[j].y * f[j].y) + (f[j].z * f[j].z + f[j].w * f[j].w);
        const float r = rsqrtf(wave_sum(s, c.lane) * (1.f / D) + EPS);
        const float* mod = mod_row(p, layer, row);
        bf16_t* xs = (bf16_t*)(p.ws + OFF_XS) + (size_t)row * D;
        float s3 = 0.f;
#pragma unroll
        for (int j = 0; j < 4; ++j) { const int idx = (c.lane + 64 * j) * 4;
            const f32x4 g = *(const f32x4*)(p.g_ffn_post + layer * D + idx), gt = *(const f32x4*)(mod + 5120 + idx), x1 = xr1[j];
            f[j] = x1 + gt * (f[j] * r * g);
            if (layer == 0) { u32x2 w; w.x = pk2(f[j].x, f[j].y); w.y = pk2(f[j].z, f[j].w); *(u32x2*)(xs + idx) = w; } else *(f32x4*)(p.out + (size_t)row * D + idx) = f[j];
            s3 += (f[j].x * f[j].x + f[j].y * f[j].y) + (f[j].z * f[j].z + f[j].w * f[j].w); }
        if (layer == 0) {
            const float r3 = rsqrtf(wave_sum(s3, c.lane) * (1.f / D) + EPS);
            const float* mod1 = mod_row(p, 1, row);
            bf16_t* h = (bf16_t*)(p.ws + OFF_H) + (size_t)row * D;
#pragma unroll
            for (int j = 0; j < 4; ++j) { const int idx = (c.lane + 64 * j) * 4;
                const f32x4 gg = *(const f32x4*)(p.g_attn_pre + D + idx), sh = *(const f32x4*)(mod1 + idx), sc = *(const f32x4*)(mod1 + 1024 + idx);
                const f32x4 o = f[j] * r3 * gg * (sc + 1.f) + sh;
                u32x2 w; w.x = pk2(o.x, o.y); w.y = pk2(o.z, o.w); *(u32x2*)(h + idx) = w; }
        }
#pragma unroll
        for (int j = 0; j < 4; ++j) { xr1[j] = xn[j]; if (layer == 0) f[j] = fn[j]; else { ea[j] = ean[j]; eb_[j] = ebn[j]; } }
        mw0 = mw0n; mw1 = mw1n;
    }
}
DI int key_row(int b, int u) { return u < CTXL ? TX + b * CTXL + u : b * SEQ + u - CTXL; }
DI void phase_ret_u_mfma(const Params& p, const Cx& c0, int layer) {
    const Cx c = fresh(c0);
    const int lane = c.lane, wave = c.wave, l31 = lane & 31, hi = lane >> 5;
    const bf16_t* P = (const bf16_t*)(p.ws + OFF_A + A_P);
    float* U = (float*)(p.ws + OFF_A + A_U);
    LAS bf16_t* VL = (LAS bf16_t*)c.lds + 3 * 64 * 136;
    LAS bf16_t* KT = (LAS bf16_t*)c.lds;
    const int nunits = NB * 4 * (NCH / 3);
    const float LOG2E = 1.4426950408889634f;
    for (int unit = c.vcu; unit < nunits; unit += c.G) {
        const int n3 = unit % (NCH / 3), h = (unit / (NCH / 3)) & 3, b = unit / ((NCH / 3) * 4);
        __syncthreads();
#pragma unroll
        for (int cc = 0; cc < 3; ++cc) { const int row0 = ret_row(b, 3 * n3 + cc);
#pragma unroll
            for (int ps = 0; ps < 2; ++ps) { const int j = ps * 64 + (c.tid >> 3), ch = c.tid & 7;
                const u32x4 v = *(const u32x4*)(P + (size_t)(row0 + j) * INW + RT_K + h * 64 + ch * 8);
#pragma unroll
                for (int e = 0; e < 4; ++e) { KT[cc * 64 * 136 + (ch * 8 + 2 * e) * 136 + j] = (bf16_t)(v[e] & 0xffffu); KT[cc * 64 * 136 + (ch * 8 + 2 * e + 1) * 136 + j] = (bf16_t)(v[e] >> 16); }
                const u32x4 vv = *(const u32x4*)(P + (size_t)(row0 + j) * INW + RT_V + h * 64 + ch * 8);
#pragma unroll
                for (int e = 0; e < 4; ++e) { VL[cc * 64 * 136 + (ch * 8 + 2 * e) * 136 + j] = (bf16_t)(vv[e] & 0xffffu); VL[cc * 64 * 136 + (ch * 8 + 2 * e + 1) * 136 + j] = (bf16_t)(vv[e] >> 16); } } }
        __syncthreads();
        const int eb = wave & 1, db = (wave >> 1) & 1, dir = wave >> 2;
        const float lg2 = logsig(dir ? p.gam_b[layer * 4 + h] : p.gam_f[layer * 4 + h]) * LOG2E;
#pragma unroll
        for (int cc = 0; cc < 3; ++cc) { const int n = 3 * n3 + cc;
            const LAS bf16_t* vrow = VL + cc * 64 * 136 + (eb * 32 + l31) * 136 + hi * 8;
            f32x16 acc;
#pragma unroll
            for (int r = 0; r < 16; ++r) acc[r] = 0.f;
#pragma unroll
            for (int s = 0; s < 8; ++s) {
                const bf16x8 af = *(const LAS bf16x8*)(vrow + s * 16);
                const u32x4 kv = *(const LAS u32x4*)(KT + cc * 64 * 136 + (db * 32 + l31) * 136 + s * 16 + hi * 8);
                u32x4 kw;
#pragma unroll
                for (int e = 0; e < 4; ++e) { const int j = s * 16 + hi * 8 + 2 * e;
                    const float w0 = __builtin_amdgcn_exp2f((float)(dir ? j : 127 - j) * lg2), w1 = __builtin_amdgcn_exp2f((float)(dir ? j + 1 : 126 - j) * lg2);
                    kw[e] = pk2(__uint_as_float(kv[e] << 16) * w0, __uint_as_float(kv[e] & 0xffff0000u) * w1); }
                acc = MFMA32(af, __builtin_bit_cast(bf16x8, kw), acc);
            }
            float* Uo = U + ((size_t)((b * 4 + h) * 2 + dir) * NCH + n) * 4096 + db * 32 + l31;
#pragma unroll
            for (int r = 0; r < 16; ++r) Uo[(eb * 32 + (r & 3) + 8 * (r >> 2) + 4 * hi) * 64] = acc[r] * 0.125f;
        }
    }
    __syncthreads();
}
DI void phase_ret_scan2(const Params& p, const Cx& c0, int layer) {
    const Cx c = fresh(c0);
    const float* U = (const float*)(p.ws + OFF_A + A_U);
    bf16_t* S = (bf16_t*)(p.ws + OFF_A + A_S);
    for (int gid = c.vcu * NTHREADS + c.tid; gid < NB * 4 * 2 * 4096; gid += c.G * NTHREADS) {
        const int de = gid & 4095, dir = (gid >> 12) & 1, h = (gid >> 13) & 3;
        const size_t base = (size_t)(gid >> 12) * NCH * 4096 + de;
        const float lg = logsig(dir ? p.gam_b[layer * 4 + h] : p.gam_f[layer * 4 + h]);
        const float gch = expf(128.f * lg);
        float s = 0.f;
#pragma unroll
        for (int i0 = 0; i0 < NCH; i0 += 33) {
            float u[33];
#pragma unroll
            for (int k = 0; k < 33; ++k) { const int i = i0 + k, n = dir == 0 ? i : (i < 2 ? 1 - i : 67 - i); u[k] = U[base + (size_t)n * 4096]; }
#pragma unroll
            for (int k = 0; k < 33; ++k) { const int i = i0 + k, n = dir == 0 ? i : (i < 2 ? 1 - i : 67 - i); S[base + (size_t)n * 4096] = f2bf(s); s = gch * s + u[k]; }
        }
    }
}
constexpr int RO_KP = 144, RO_VP = 272, RO_K = 0, RO_V = 128 * RO_KP, RO_S = RO_V + 64 * RO_VP, RO_HALF = RO_S + 128 * RO_KP;
template <bool CTXU>
DI void phase_ret_out_mfma(const Params& p, const Cx& c0, int layer, int n0, int first_blk = 0) {
    const Cx c = fresh(c0);
    const int lane = c.lane, l31 = lane & 31, hi = lane >> 5, half = c.wave >> 2, ht = (c.wave & 3) * 64 + lane;
    const bf16_t* P = (const bf16_t*)(p.ws + OFF_A + A_P);
    const bf16_t* ST = (const bf16_t*)(p.ws + OFF_A + A_S);
    bf16_t* YC = (bf16_t*)(p.ws + OFF_H);
    const float* U = (const float*)(p.ws + OFF_A + A_U);
    const int nn = CTXU ? 2 : NCH - n0, nunits = NB * 4 * nn * 4, NGW = c.G * NWAVES;
    const int gw = (c.vcu >= first_blk ? c.vcu - first_blk : c.vcu - first_blk + c.G) * NWAVES + c.wave;
    const float LOG2E = 1.4426950408889634f;
    LAS unsigned char* img = c.lds + half * RO_HALF;
    __syncthreads();
    for (int unit = gw; unit < nunits; unit += NGW) {
        const int ib = unit & 3, n = n0 + (unit >> 2) % nn, h = ((unit >> 2) / nn) & 3, b = (unit >> 2) / (nn * 4);
        const int row0 = ret_row(b, n), u0 = n < 2 ? n * 128 : CTXL + (n - 2) * 128;
        const int iq = ib * 32 + l31, qrow = row0 + iq;
        const float lf2 = logsig(p.gam_f[layer * 4 + h]) * LOG2E, lb2 = logsig(p.gam_b[layer * 4 + h]) * LOG2E;
        u32x4 kr[4], vr[4], sr[4];
#pragma unroll
        for (int i = 0; i < 4; ++i) { const int pc = ht + 256 * i;
            kr[i] = *(const u32x4*)(P + (size_t)(row0 + (pc >> 3)) * INW + RT_K + h * 64 + (pc & 7) * 8);
            vr[i] = *(const u32x4*)(P + (size_t)(row0 + (pc >> 3)) * INW + RT_V + h * 64 + (pc & 7) * 8);
            const int dir = pc >> 9, e = (pc >> 3) & 63, ch = pc & 7;
            if (CTXU) {
                if (dir == 0 ? n == 1 : n == 0) { const float* ur = U + ((size_t)((b * 4 + h) * 2 + dir) * NCH + (1 - n)) * 4096 + e * 64 + ch * 8; const f32x4 ua = *(const f32x4*)ur, ub = *(const f32x4*)(ur + 4);
                    sr[i].x = (unsigned)f2bf(ua[0]) | ((unsigned)f2bf(ua[1]) << 16); sr[i].y = (unsigned)f2bf(ua[2]) | ((unsigned)f2bf(ua[3]) << 16);
                    sr[i].z = (unsigned)f2bf(ub[0]) | ((unsigned)f2bf(ub[1]) << 16); sr[i].w = (unsigned)f2bf(ub[2]) | ((unsigned)f2bf(ub[3]) << 16); }
                else sr[i] = (u32x4){0u, 0u, 0u, 0u};
            } else sr[i] = *(const u32x4*)(ST + ((size_t)((b * 4 + h) * 2 + dir) * NCH + n) * 4096 + e * 64 + ch * 8);
        }
        bf16x8 qf[4];
#pragma unroll
        for (int ks = 0; ks < 4; ++ks) qf[ks] = *(const bf16x8*)(P + (size_t)qrow * INW + RT_Q + h * 64 + ks * 16 + hi * 8);
#pragma unroll
        for (int i = 0; i < 4; ++i) { const int pc = ht + 256 * i;
            *(LAS u32x4*)(img + RO_K + (pc >> 3) * RO_KP + (pc & 7) * 16) = kr[i];
            { LAS bf16_t* vd = (LAS bf16_t*)(img + RO_V) + ((pc & 7) * 8) * (RO_VP / 2) + (pc >> 3);
#pragma unroll
              for (int e = 0; e < 4; ++e) { vd[(2 * e) * (RO_VP / 2)] = (bf16_t)(vr[i][e] & 0xffffu); vd[(2 * e + 1) * (RO_VP / 2)] = (bf16_t)(vr[i][e] >> 16); } }
            *(LAS u32x4*)(img + RO_S + (pc >> 3) * RO_KP + (pc & 7) * 16) = sr[i]; }
        __syncthreads();
        bf16x8 pf[8];
#pragma unroll
        for (int jb = 0; jb < 4; ++jb) {
            f32x16 S;
#pragma unroll
            for (int r = 0; r < 16; ++r) S[r] = 0.f;
#pragma unroll
            for (int ks = 0; ks < 4; ++ks) { const bf16x8 kf = *(const LAS bf16x8*)(img + RO_K + (jb * 32 + l31) * RO_KP + ks * 32 + hi * 16); S = MFMA32(kf, qf[ks], S); }
#pragma unroll
            for (int r = 0; r < 16; ++r) { const int j = jb * 32 + (r & 3) + 8 * (r >> 2) + 4 * hi, dd = iq - j;
                S[r] *= 0.125f * __builtin_amdgcn_exp2f(dd >= 0 ? (float)dd * lf2 : (float)(-dd) * lb2); }
#pragma unroll
            for (int s = 0; s < 2; ++s) { u32x4 w; w.x = pk2(S[8 * s], S[8 * s + 1]); w.y = pk2(S[8 * s + 2], S[8 * s + 3]); w.z = pk2(S[8 * s + 4], S[8 * s + 5]); w.w = pk2(S[8 * s + 6], S[8 * s + 7]);
                pf[jb * 2 + s] = __builtin_bit_cast(bf16x8, w); }
        }
        const float xif = __builtin_amdgcn_exp2f((float)(iq + 1) * lf2), xib = __builtin_amdgcn_exp2f((float)(128 - iq) * lb2);
        f32x16 O[2];
#pragma unroll
        for (int eb = 0; eb < 2; ++eb) {
#pragma unroll
            for (int r = 0; r < 16; ++r) O[eb][r] = 0.f;
#pragma unroll
            for (int k8 = 0; k8 < 8; ++k8) { const LAS unsigned char* vp = img + RO_V + (eb * 32 + l31) * RO_VP + k8 * 32 + hi * 8;
                const u32x2 x0 = *(const LAS u32x2*)vp, x1 = *(const LAS u32x2*)(vp + 16);
                u32x4 wv; wv.x = x0.x; wv.y = x0.y; wv.z = x1.x; wv.w = x1.y;
                O[eb] = MFMA32(__builtin_bit_cast(bf16x8, wv), pf[k8], O[eb]); }
#pragma unroll
            for (int dir = 0; dir < 2; ++dir) {
                f32x16 C;
#pragma unroll
                for (int r = 0; r < 16; ++r) C[r] = 0.f;
#pragma unroll
                for (int ks = 0; ks < 4; ++ks) C = MFMA32(*(const LAS bf16x8*)(img + RO_S + (dir * 64 + eb * 32 + l31) * RO_KP + ks * 32 + hi * 16), qf[ks], C);
                const float xi = dir ? xib : xif;
#pragma unroll
                for (int r = 0; r < 16; ++r) O[eb][r] += xi * C[r];
            }
        }
        float ss = 0.f;
#pragma unroll
        for (int eb = 0; eb < 2; ++eb)
#pragma unroll
            for (int r = 0; r < 16; ++r) ss += O[eb][r] * O[eb][r];
        ss += shx(ss, 32, lane);
        const float rr = rsqrtf(ss * (1.f / 64.f) + EPS);
#pragma unroll
        for (int eb = 0; eb < 2; ++eb)
#pragma unroll
            for (int g = 0; g < 4; ++g) { const int e0 = eb * 32 + 8 * g + 4 * hi;
                const u32x2 gt = *(const u32x2*)(P + (size_t)qrow * INW + RT_G + h * 64 + e0);
                const float g0 = __uint_as_float(gt.x << 16), g1 = __uint_as_float(gt.x & 0xffff0000u), g2 = __uint_as_float(gt.y << 16), g3 = __uint_as_float(gt.y & 0xffff0000u);
                u32x2 w; w.x = pk2(O[eb][4 * g] * rr * silu_f(g0), O[eb][4 * g + 1] * rr * silu_f(g1)); w.y = pk2(O[eb][4 * g + 2] * rr * silu_f(g2), O[eb][4 * g + 3] * rr * silu_f(g3));
                *(u32x2*)(YC + (size_t)qrow * D + 768 + h * 64 + e0) = w; }
        __syncthreads();
    }
}
namespace da2 {
typedef short s16x4 __attribute__((ext_vector_type(4)));
typedef LAS const char* lcp;
constexpr int NSLOT = 3, SLOTB = 8192;
constexpr int L_K = 0, L_V = NSLOT * SLOTB, L_WS = 2 * NSLOT * SLOTB, L_ST = L_WS + 8 * 64 * 4;
constexpr int ST_P = 65, ST_W = 32 * ST_P;
DI int crow(int r, int hi) { return (r & 3) + 8 * (r >> 2) + 4 * hi; }
DI void glds16(const void* gsrc, unsigned lds_dst) { unsigned keep;
    asm volatile("s_mov_b32 %0, m0\n\ts_mov_b32 m0, %2\n\ts_nop 0\n\tglobal_load_lds_dwordx4 %1, off\n\ts_mov_b32 m0, %0" : "=&s"(keep) : "v"(gsrc), "s"(lds_dst) : "memory"); }
DI float max3f(float a, float b, float c) { float r; asm("v_max3_f32 %0, %1, %2, %3" : "=v"(r) : "v"(a), "v"(b), "v"(c)); return r; }
DI float max2f(float a, float b) { float r; asm("v_max_f32_e32 %0, %1, %2" : "=v"(r) : "v"(a), "v"(b)); return r; }
DI float fadd_s(float a, float b) { float r; asm("v_add_f32_e32 %0, %1, %2" : "=v"(r) : "v"(a), "v"(b)); return r; }
DI float fsub_s(float a, float b) { float r; asm("v_sub_f32_e32 %0, %1, %2" : "=v"(r) : "v"(a), "v"(b)); return r; }
#define SBAR() __builtin_amdgcn_sched_barrier(0)
#define WAIT_BAR(N) asm volatile("s_waitcnt vmcnt(" #N ") lgkmcnt(0)\n\ts_barrier" ::: "memory")
DI s16x4 vtr(lcp p) { return __builtin_bit_cast(s16x4, __builtin_amdgcn_ds_read_tr16_b64_v4i16((LAS s16x4*)p)); }
DI float rowmax(const f32x16& p0, const f32x16& p1) {
    float a = max3f(p0[0], p0[1], p1[0]), b = max3f(p0[2], p0[3], p1[1]); a = max3f(a, p1[2], p1[3]);
#pragma unroll
    for (int r = 4; r < 16; r += 4) { a = max3f(a, p0[r], p0[r + 1]); b = max3f(b, p0[r + 2], p0[r + 3]); a = max3f(a, p1[r], p1[r + 1]); b = max3f(b, p1[r + 2], p1[r + 3]); }
    const float m = max2f(a, b);
    auto rr = __builtin_amdgcn_permlane32_swap(__float_as_uint(m), __float_as_uint(m), false, false);
    return max2f(__uint_as_float(rr[0]), __uint_as_float(rr[1]));
}
DI void pv(f32x16* o, int vb, bf16x8 pa0, bf16x8 pa1, bf16x8 pa2, bf16x8 pa3) {
#pragma unroll
    for (int d0 = 0; d0 < 2; ++d0) { s16x4 lo[4], hi[4];
#pragma unroll
        for (int ks = 0; ks < 4; ++ks) {
            asm volatile("ds_read_b64_tr_b16 %0,%1 offset:%c2" : "=&v"(lo[ks]) : "v"(vb), "i"(d0 * 4096 + ks * 1024) : "memory");
            asm volatile("ds_read_b64_tr_b16 %0,%1 offset:%c2" : "=&v"(hi[ks]) : "v"(vb), "i"(d0 * 4096 + ks * 1024 + 512) : "memory"); }
        asm volatile("s_waitcnt lgkmcnt(0)" ::: "memory"); SBAR();
#define PK(k) (bf16x8){lo[k][0], lo[k][1], lo[k][2], lo[k][3], hi[k][0], hi[k][1], hi[k][2], hi[k][3]}
        o[d0] = MFMA32(pa0, PK(0), o[d0]);
        o[d0] = MFMA32(pa1, PK(1), o[d0]);
        o[d0] = MFMA32(pa2, PK(2), o[d0]);
        o[d0] = MFMA32(pa3, PK(3), o[d0]);
#undef PK
    }
}
DI int tile_row(int b, int t) { return t < CTXL / 64 ? TX + b * CTXL + 64 * t : b * SEQ + 64 * (t - CTXL / 64); }

template <int THRL>
DI void unit(const Params& p, const Cx& c, int layer, int b, int h, int qrow0, int NT, float lam, float lam_init) {
    const int lane = c.lane, r32 = lane & 31, hi = lane >> 5; const int wid = __builtin_amdgcn_readfirstlane(c.wave);
    const int mp = wid >> 2, qblk = wid & 3;
    const bf16_t* P = (const bf16_t*)(p.ws + OFF_A + A_P);
    bf16_t* YC = (bf16_t*)(p.ws + OFF_H);
    const unsigned lds0 = (unsigned)(uintptr_t)c.lds;
    LAS float* wsf = (LAS float*)(c.lds + L_WS) + wid * 64;
    const bf16_t* ksrc = P + (size_t)lane * INW + DA_K + h * 64 + wid * 8;
    const bf16_t* vsrc = P + (size_t)(16 * (wid & 3) + (lane >> 2)) * INW + DA_V + h * 64 + (wid >> 2) * 32 + (lane & 3) * 8;
    const unsigned kdst = lds0 + L_K + wid * 1024, vdst = lds0 + L_V + wid * 1024;
#define DMA_K(t, slot) glds16(ksrc + (size_t)tile_row(b, (t)) * INW, (unsigned)__builtin_amdgcn_readfirstlane(kdst + (slot)))
#define DMA_V(t, slot) glds16(vsrc + (size_t)tile_row(b, (t)) * INW, (unsigned)__builtin_amdgcn_readfirstlane(vdst + (slot)))
    const int vb0 = (int)(lds0 + L_V) + ((lane >> 4) & 1) * 32 + (lane & 3) * 8 + (4 * hi + ((lane & 15) >> 2)) * 64;
    bf16x8 kf[4];
    const lcp shm3 = (lcp)c.lds; const lcp kp0 = shm3 + L_K + mp * 4096 + hi * 1024 + r32 * 16;
    const lcp vp0 = shm3 + L_V + ((lane >> 4) & 1) * 32 + (lane & 3) * 8 + (4 * hi + ((lane & 15) >> 2)) * 64;
    asm volatile("s_waitcnt vmcnt(0)" ::: "memory");
    DMA_K(0, 0); DMA_V(0, 0); DMA_K(1, SLOTB);
    bf16x8 qr[2];
    { const bf16_t* Qw = P + (size_t)(qrow0 + qblk * 32 + r32) * INW + DA_Q + h * 64 + mp * 32 + hi * 8;
      qr[0] = *(const bf16x8*)(Qw); qr[1] = *(const bf16x8*)(Qw + 16); }
    float mhat = 0.f; f32x16 o[2], lacc;
#pragma unroll
    for (int r = 0; r < 16; ++r) { o[0][r] = 0.f; o[1][r] = 0.f; lacc[r] = 0.f; }
    bf16x8 ones;
#pragma unroll
    for (int j = 0; j < 8; ++j) ones[j] = (short)0x3F80;
    asm volatile("" : "+v"(ones));
    f32x16 negm;
#pragma unroll
    for (int r = 0; r < 16; ++r) negm[r] = 0.f;
    asm volatile("" : "+v"(negm));
    bool resc = false;
#define START(P0, P1) do { const float rm = rowmax(P0, P1); resc = false; \
    { const float dl = rm; mhat = fadd_s(mhat, dl); \
      _Pragma("unroll") for (int r = 0; r < 16; ++r) { P0[r] = fsub_s(P0[r], dl); P1[r] = fsub_s(P1[r], dl); } \
      _Pragma("unroll") for (int r = 0; r < 16; ++r) negm[r] = -mhat; asm volatile("" : "+v"(negm)); } \
    _Pragma("unroll") for (int r = 0; r < 16; ++r) P0[r] = __builtin_amdgcn_exp2f(P0[r]); } while (0)
#define RESC() do { if (resc) { asm volatile("s_waitcnt lgkmcnt(0)" ::: "memory"); \
      _Pragma("unroll") for (int r = 0; r < 16; ++r) { const float f_ = wsf[crow(r, hi)]; o[0][r] *= f_; o[1][r] *= f_; lacc[r] *= f_; } } } while (0)
    f32x16 pA0, pA1, pB0, pB1;
    int sl_prev = 0, sl_cur = 0, sl_next = SLOTB;
#define ROT() do { sl_prev = sl_cur; sl_cur = sl_next; sl_next = (sl_next == (NSLOT - 1) * SLOTB) ? 0 : sl_next + SLOTB; } while (0)
    DMA_K(2, 2 * SLOTB);
    WAIT_BAR(3);
    {
        const lcp kb = kp0;
        const bf16x8 b0 = *(const LAS bf16x8*)(kb), b1 = *(const LAS bf16x8*)(kb + 512), b2 = *(const LAS bf16x8*)(kb + 2048), b3 = *(const LAS bf16x8*)(kb + 2560);
        pA0 = MFMA32(b0, qr[0], negm); pA1 = MFMA32(b1, qr[0], negm); pA0 = MFMA32(b2, qr[1], pA0); pA1 = MFMA32(b3, qr[1], pA1);
        asm volatile("s_nop 15\n\ts_nop 7" : "+v"(pA0), "+v"(pA1));
    }
    START(pA0, pA1);
#pragma unroll
    for (int r = 0; r < 16; ++r) pA1[r] = __builtin_amdgcn_exp2f(pA1[r]);
    WAIT_BAR(0);
    DMA_K(3, 0); DMA_V(1, SLOTB);
    ROT();
#define KLOAD4(kp_) do { kf[0] = *(const LAS bf16x8*)(kp_); kf[1] = *(const LAS bf16x8*)((kp_) + 512); kf[2] = *(const LAS bf16x8*)((kp_) + 2048); kf[3] = *(const LAS bf16x8*)((kp_) + 2560); } while (0)
    KLOAD4(kp0 + sl_cur);
    WAIT_BAR(2);
    s16x4 vlo[8], vhi[8]; u32x4 pw0, pw1, pw2, pw3;
#define PKW(P_, B_) pk2(P_[B_], P_[B_ + 1])
#define PAF(k) __builtin_bit_cast(bf16x8, pw##k)
#define VFR(i) (bf16x8){vlo[i][0], vlo[i][1], vlo[i][2], vlo[i][3], vhi[i][0], vhi[i][1], vhi[i][2], vhi[i][3]}
#define PIN(x) asm volatile("" : "+v"(x))
#define MX3(a, b, c_) __builtin_fmaxf(__builtin_fmaxf((a), (b)), (c_))
#define GAPA(MF, PW, PS, B_) do { MF; PW[0] = PKW(PS, B_); PW[1] = PKW(PS, B_ + 2); PW[2] = PKW(PS, B_ + 4); PW[3] = PKW(PS, B_ + 6); PIN(PW); SBAR(); } while (0)
#define EX(v) __builtin_amdgcn_exp2f(v)
#define GAPB(MF, X, B_) do { MF; X[B_] = EX(X[B_]); X[B_ + 1] = EX(X[B_ + 1]); X[B_ + 2] = EX(X[B_ + 2]); X[B_ + 3] = EX(X[B_ + 3]); PIN(X); SBAR(); } while (0)
#define VRD(i) do { vlo[i] = vtr(vp_ + (((i) >> 2) * 4096 + ((i) & 3) * 1024)); vhi[i] = vtr(vp_ + (((i) >> 2) * 4096 + ((i) & 3) * 1024 + 512)); } while (0)
#define KRD(G_, j) do { if (G_) { const lcp kn_ = kp0 + sl_next; kf[2 * (j)] = *(const LAS bf16x8*)(kn_ + (j) * 2048); kf[2 * (j) + 1] = *(const LAS bf16x8*)(kn_ + (j) * 2048 + 512); SBAR(); } } while (0)
#define STEP(C0, C1, P0, P1, t, GK, GV, GL) do { SBAR(); \
    const lcp vp_ = vp0 + sl_prev; \
    VRD(0); VRD(4); SBAR(); GAPA(C0 = MFMA32(kf[0], qr[0], negm), pw0, P0, 0); \
    VRD(1); VRD(5); SBAR(); GAPA(C1 = MFMA32(kf[1], qr[0], negm), pw1, P0, 8); \
    VRD(2); VRD(6); SBAR(); GAPA(C0 = MFMA32(kf[2], qr[1], C0), pw2, P1, 0); \
    VRD(3); VRD(7); SBAR(); GAPA(C1 = MFMA32(kf[3], qr[1], C1), pw3, P1, 8); \
    if (GK) { DMA_K((t) + 3, sl_cur); } if (GV) { DMA_V((t) + 1, sl_next); } \
    { float a, b_; \
      lacc = MFMA32(PAF(0), ones, lacc); a = MX3(C0[0], C0[1], C0[2]); a = MX3(a, C0[3], C0[4]); a = MX3(a, C0[5], C0[6]); a = MX3(a, C0[7], C0[8]); a = MX3(a, C0[9], C0[10]); PIN(a); SBAR(); \
      lacc = MFMA32(PAF(1), ones, lacc); a = MX3(a, C0[11], C0[12]); a = MX3(a, C0[13], C0[14]); b_ = MX3(C0[15], C1[0], C1[1]); b_ = MX3(b_, C1[2], C1[3]); b_ = MX3(b_, C1[4], C1[5]); PIN(a); PIN(b_); SBAR(); \
      lacc = MFMA32(PAF(2), ones, lacc); b_ = MX3(b_, C1[6], C1[7]); b_ = MX3(b_, C1[8], C1[9]); b_ = MX3(b_, C1[10], C1[11]); b_ = MX3(b_, C1[12], C1[13]); b_ = MX3(b_, C1[14], C1[15]); PIN(b_); SBAR(); \
      lacc = MFMA32(PAF(3), ones, lacc); \
      float rm = __builtin_fmaxf(a, b_); { auto rr = __builtin_amdgcn_permlane32_swap(__float_as_uint(rm), __float_as_uint(rm), false, false); rm = __builtin_fmaxf(__uint_as_float(rr[0]), __uint_as_float(rr[1])); } \
      resc = false; \
      if (__builtin_expect(__builtin_amdgcn_ballot_w64(rm > (float)THRL) != 0ull, 0)) { const float dl = __builtin_fmaxf(rm, 0.f); mhat += dl; \
        _Pragma("unroll") for (int r = 0; r < 16; ++r) { C0[r] -= dl; C1[r] -= dl; } \
        _Pragma("unroll") for (int r = 0; r < 16; ++r) negm[r] = -mhat; asm volatile("" : "+v"(negm)); \
        const float f = __builtin_amdgcn_exp2f(-dl); if (hi == 0) wsf[r32] = f; resc = true; } } \
    SBAR(); \
    GAPB(o[0] = MFMA32(PAF(0), VFR(0), o[0]), C0, 0); \
    GAPB(o[1] = MFMA32(PAF(0), VFR(4), o[1]), C0, 4); \
    KRD(GL, 0); GAPB(o[0] = MFMA32(PAF(1), VFR(1), o[0]), C0, 8); \
    KRD(GL, 1); GAPB(o[1] = MFMA32(PAF(1), VFR(5), o[1]), C0, 12); \
    GAPB(o[0] = MFMA32(PAF(2), VFR(2), o[0]), C1, 0); \
    GAPB(o[1] = MFMA32(PAF(2), VFR(6), o[1]), C1, 4); \
    GAPB(o[0] = MFMA32(PAF(3), VFR(3), o[0]), C1, 8); \
    GAPB(o[1] = MFMA32(PAF(3), VFR(7), o[1]), C1, 12); \
    } while (0)
    int t = 1;
    for (; t + 5 < NT; t += 2) {
        STEP(pB0, pB1, pA0, pA1, t, true, true, true);       WAIT_BAR(2); RESC(); ROT();
        STEP(pA0, pA1, pB0, pB1, t + 1, true, true, true);   WAIT_BAR(2); RESC(); ROT();
    }
#define ENDW(tt) do { if ((tt) + 3 < NT) { WAIT_BAR(2); } else if ((tt) + 2 < NT) { WAIT_BAR(1); } else { WAIT_BAR(0); } } while (0)
    for (; t + 1 < NT; t += 2) {
        STEP(pB0, pB1, pA0, pA1, t, (t + 3 < NT), (t + 1 < NT), (t + 1 < NT));         ENDW(t);     RESC(); ROT();
        STEP(pA0, pA1, pB0, pB1, t + 1, (t + 4 < NT), (t + 2 < NT), (t + 2 < NT));     ENDW(t + 1); RESC(); ROT();
    }
    STEP(pB0, pB1, pA0, pA1, NT - 1, false, false, false); RESC();
    { pw0 = (u32x4){PKW(pB0, 0), PKW(pB0, 2), PKW(pB0, 4), PKW(pB0, 6)}; pw1 = (u32x4){PKW(pB0, 8), PKW(pB0, 10), PKW(pB0, 12), PKW(pB0, 14)};
      pw2 = (u32x4){PKW(pB1, 0), PKW(pB1, 2), PKW(pB1, 4), PKW(pB1, 6)}; pw3 = (u32x4){PKW(pB1, 8), PKW(pB1, 10), PKW(pB1, 12), PKW(pB1, 14)};
      SBAR(); lacc = MFMA32(PAF(0), ones, lacc); lacc = MFMA32(PAF(1), ones, lacc); lacc = MFMA32(PAF(2), ones, lacc); lacc = MFMA32(PAF(3), ones, lacc);
      pv(o, vb0 + sl_cur, PAF(0), PAF(1), PAF(2), PAF(3)); }
#undef PKW
#undef PAF
#undef VFR
#undef PIN
#undef MX3
#undef GAPA
#undef GAPB
#undef EX
#undef VRD
#undef KRD
#undef STEP
#undef ENDW
#undef KLOAD4
    const float osc = mp ? lam : 1.f;
    LAS float* stg = (LAS float*)(c.lds + L_ST) + wid * ST_W;
#pragma unroll
    for (int r = 0; r < 16; ++r) { const float rl = __builtin_amdgcn_rcpf(lacc[r]) * osc; const int orow = crow(r, hi);
        stg[orow * ST_P + r32] = o[0][r] * rl; stg[orow * ST_P + 32 + r32] = o[1][r] * rl; }
    __syncthreads();
    if (mp == 0) {
        const LAS float* s0 = stg + r32 * ST_P + 32 * hi; const LAS float* s1 = s0 + 4 * ST_W;
        float df[32]; float ss = 0.f;
#pragma unroll
        for (int j = 0; j < 32; ++j) { df[j] = s0[j] - s1[j]; ss += df[j] * df[j]; }
        { auto rr = __builtin_amdgcn_permlane32_swap(__float_as_uint(ss), __float_as_uint(ss), false, false); ss = __uint_as_float(rr[0]) + __uint_as_float(rr[1]); }
        const float rn = rsqrtf(ss * (1.f / 64.f) + EPS) * (1.f - lam_init);
        const float* sg = p.subln + layer * 64 + 32 * hi;
        bf16_t* yo = YC + (size_t)(qrow0 + qblk * 32 + r32) * D + h * 64 + 32 * hi;
#pragma unroll
        for (int g = 0; g < 4; ++g) { const f32x4 ga = *(const f32x4*)(sg + 8 * g), gb = *(const f32x4*)(sg + 8 * g + 4);
            u32x4 w; w.x = pk2(df[8 * g] * rn * ga[0], df[8 * g + 1] * rn * ga[1]); w.y = pk2(df[8 * g + 2] * rn * ga[2], df[8 * g + 3] * rn * ga[3]);
            w.z = pk2(df[8 * g + 4] * rn * gb[0], df[8 * g + 5] * rn * gb[1]); w.w = pk2(df[8 * g + 6] * rn * gb[2], df[8 * g + 7] * rn * gb[3]);
            *(u32x4*)(yo + 8 * g) = w; }
    }
    asm volatile("s_waitcnt lgkmcnt(0)\n\ts_barrier" ::: "memory");
#undef DMA_K
#undef DMA_V
#undef START
#undef RESC
#undef ROT
}
#undef SBAR
#undef WAIT_BAR
}

DI void phase_da2(const Params& p, const Cx& c0, int layer, int ctxq, int first_blk = 0) {
    const Cx c = fresh(c0);
    float s1 = 0.f, s2 = 0.f;
    for (int i = 0; i < 32; ++i) { s1 += p.lq1[layer * 32 + i] * p.lk1[layer * 32 + i]; s2 += p.lq2[layer * 32 + i] * p.lk2[layer * 32 + i]; }
    const float lam_init = 0.8f - 0.6f * expf(-0.3f * (float)layer);
    const float lam = expf(s1) - expf(s2) + lam_init;
    const int nunits = ctxq ? NB * 4 * 2 : NB * 4 * 64;
    __syncthreads();
    for (int unit = c.vcu >= first_blk ? c.vcu - first_blk : c.vcu - first_blk + c.G; unit < nunits; unit += c.G) {
        int b, h, qrow0, NT;
        if (ctxq) { b = unit >> 3; h = (unit >> 1) & 3; qrow0 = TX + b * CTXL + (unit & 1) * 128; NT = CTXL / 64; }
        else { b = unit >> 8; h = (unit >> 6) & 3; qrow0 = b * SEQ + (unit & 63) * 128; NT = NKEY / 64; }
        da2::unit<8>(p, c, layer, b, h, qrow0, NT, lam, lam_init);
    }
    __syncthreads();
}
namespace da2 {
#define SBAR() __builtin_amdgcn_sched_barrier(0)
#define WAIT_BAR(N) asm volatile("s_waitcnt vmcnt(" #N ") lgkmcnt(0)\n\ts_barrier" ::: "memory")
constexpr int F_OST = L_WS + 8 * 64 * 4;
constexpr int F_TAB = F_OST + 8 * 4096;
DI void glds16s(const void* sbase, unsigned voff, unsigned lds_dst) { unsigned keep;
    asm volatile("s_mov_b32 %0, m0\n\ts_mov_b32 m0, %3\n\ts_nop 0\n\tglobal_load_lds_dwordx4 %1, %2\n\ts_mov_b32 m0, %0" : "=&s"(keep) : "v"(voff), "s"(sbase), "s"(lds_dst) : "memory"); }
template <int MODE>
DI void fmask(f32x16& C0, f32x16& C1, int tl, int loc0, int qw0, const LAS float* tab) {
    const int ln = lane_id_fresh(), hi = ln >> 5, qpos = qw0 + (ln & 31), gc = qpos & 63, cstart = min(max(gc - 8, 0), 48);
    bool need, masked; int kpos0 = 0, dr = 0;
    if (MODE == 1) { kpos0 = loc0 + 64 * tl; need = (kpos0 + 63 >= qw0 - 128) && (kpos0 <= qw0 + 31 + 128); masked = !((kpos0 >= qw0 + 31 - 128) && (kpos0 + 63 <= qw0 + 128)); }
    else { const int kr = loc0 + tl, wr = qw0 >> 6, ws_ = min(max(wr - 4, 0), 120); need = (kr >= ws_) && (kr < ws_ + 8); masked = true; dr = kr - wr + 7; }
    if (!need) {
#pragma unroll
        for (int r = 0; r < 16; ++r) { C0[r] = -INFINITY; C1[r] = -INFINITY; }
    } else if (masked) {
#pragma unroll
        for (int r = 0; r < 16; ++r) {
#pragma unroll
            for (int kb = 0; kb < 2; ++kb) { const int kidx = kb * 32 + (r & 3) + 8 * (r >> 2) + 4 * hi; float bias;
                if (MODE == 1) { const int dd = qpos - (kpos0 + kidx); bias = (dd <= 128 && dd >= -128) ? 0.f : -INFINITY; }
                else { const bool ok = kidx >= cstart && kidx < cstart + 16; const int dc = min(max(kidx - gc, -15), 15) + 15; bias = ok ? tab[dr * 31 + dc] : -INFINITY; }
                if (kb == 0) C0[r] += bias; else C1[r] += bias; } }
    }
}

template <int MODE, int THRL>
DI void unit64(const Params& p, const Cx& c, int layer, int b, int h, int qb, int ctxq) {
    const int lane = c.lane, r32 = lane & 31, hi = lane >> 5; const int wid = __builtin_amdgcn_readfirstlane(c.wave);
    const bf16_t* P = (const bf16_t*)(p.ws + OFF_A + A_P);
    bf16_t* YC = (bf16_t*)(p.ws + OFF_H);
    const unsigned lds0 = (unsigned)(uintptr_t)c.lds;
    LAS float* wsf = (LAS float*)(c.lds + L_WS) + wid * 64;
    LAS float* tab = (LAS float*)(c.lds + F_TAB);
    const int qcolP = MODE == 1 ? SW_Q + h * 64 : NA_Q + h * 64, kcolP = MODE == 1 ? SW_K + (h >> 1) * 64 : NA_K + h * 64, vcolP = MODE == 1 ? SW_V + (h >> 1) * 64 : NA_V + h * 64;
    const int ycol = (MODE == 1 ? 256 : 512) + h * 64;
    int nloc = 0, loc0 = 0;
    if (!ctxq) {
        if (MODE == 1) { const int lo = qb == 0 ? 2 : 0, hi_t = qb == 31 ? 5 : 7; loc0 = qb * 256 - 128 + 64 * lo; nloc = hi_t - lo + 1; }
        else { const int rmin = min(max(4 * qb - 4, 0), 120), rmax = min(max(4 * qb - 1, 0), 120) + 8; loc0 = rmin; nloc = rmax - rmin; nloc += nloc & 1; }
    }
    const int NT = 4 + nloc;
#define TROW(t) ((t) < 4 ? TX + b * CTXL + 64 * (t) : (MODE == 1 ? b * SEQ + loc0 + 64 * ((t) - 4) : b * SEQ + 64 * (loc0 + (t) - 4)))
    const int qrow0 = (ctxq ? TX + b * CTXL : b * SEQ + qb * 256) + wid * 32;
    const int qw0 = qb * 256 + wid * 32;
    const unsigned koff = (unsigned)(lane * INW + kcolP + wid * 8) * 2u, voff = (unsigned)((16 * (wid & 3) + (lane >> 2)) * INW + vcolP + (wid >> 2) * 32 + (lane & 3) * 8) * 2u;
    const unsigned kdst = lds0 + L_K + wid * 1024, vdst = lds0 + L_V + wid * 1024;
#define DMA_K(t, slot) glds16s(P + (size_t)TROW(t) * INW, koff, (unsigned)__builtin_amdgcn_readfirstlane(kdst + (slot)))
#define DMA_V(t, slot) glds16s(P + (size_t)TROW(t) * INW, voff, (unsigned)__builtin_amdgcn_readfirstlane(vdst + (slot)))
    bf16x8 kf[8];
    const lcp shm3 = (lcp)c.lds; const lcp kp0 = shm3 + L_K + hi * 1024 + r32 * 16;
    const lcp vp0 = shm3 + L_V + ((lane >> 4) & 1) * 32 + (lane & 3) * 8 + (4 * hi + ((lane & 15) >> 2)) * 64;
    asm volatile("s_waitcnt vmcnt(0)" ::: "memory");
    DMA_K(0, 0); DMA_V(0, 0); DMA_K(1, SLOTB);
    if (MODE == 2) { for (int i = lane_id_fresh() + 64 * wid; i < 465; i += NTHREADS) tab[i] = p.rpb[(size_t)(layer * 4 + h) * 465 + i] * 1.4426950408889634f; }
    bf16x8 qr[4];
    { const bf16_t* Qw = P + (size_t)(qrow0 + r32) * INW + qcolP + hi * 8;
#pragma unroll
      for (int d0 = 0; d0 < 4; ++d0) qr[d0] = *(const bf16x8*)(Qw + d0 * 16); }
    float mhat = 0.f, l_reg = 0.f; f32x16 o[2];
#pragma unroll
    for (int r = 0; r < 16; ++r) { o[0][r] = 0.f; o[1][r] = 0.f; }
    f32x16 negm;
#pragma unroll
    for (int r = 0; r < 16; ++r) negm[r] = 0.f;
    asm volatile("" : "+v"(negm));
    bool resc = false;
#define CMASK(C0_, C1_, t) do { const int tl_ = (t) - 4; if (!ctxq && tl_ >= 0) fmask<MODE>(C0_, C1_, tl_, loc0, qw0, tab); } while (0)
#define START(P0, P1) do { const float rm = rowmax(P0, P1); resc = false; \
    { const float dl = rm; mhat = fadd_s(mhat, dl); \
      _Pragma("unroll") for (int r = 0; r < 16; ++r) { P0[r] = fsub_s(P0[r], dl); P1[r] = fsub_s(P1[r], dl); } \
      _Pragma("unroll") for (int r = 0; r < 16; ++r) negm[r] = -mhat; asm volatile("" : "+v"(negm)); } \
    _Pragma("unroll") for (int r = 0; r < 16; ++r) P0[r] = __builtin_amdgcn_exp2f(P0[r]); } while (0)
#define RESC() do { if (resc) { asm volatile("s_waitcnt lgkmcnt(0)" ::: "memory"); \
      _Pragma("unroll") for (int r = 0; r < 16; ++r) { const float f_ = wsf[crow(r, hi)]; o[0][r] *= f_; o[1][r] *= f_; } } } while (0)
    f32x16 pA0, pA1, pB0, pB1;
    int sl_prev = 0, sl_cur = 0, sl_next = SLOTB;
#define ROT() do { sl_prev = sl_cur; sl_cur = sl_next; sl_next = (sl_next == (NSLOT - 1) * SLOTB) ? 0 : sl_next + SLOTB; } while (0)
    DMA_K(2, 2 * SLOTB);
    WAIT_BAR(3);
    {
        const lcp kb = kp0;
#pragma unroll
        for (int d0 = 0; d0 < 4; ++d0) {
            const bf16x8 b0 = *(const LAS bf16x8*)(kb + d0 * 2048), b1 = *(const LAS bf16x8*)(kb + d0 * 2048 + 512);
            if (d0 == 0) { pA0 = MFMA32(b0, qr[0], negm); pA1 = MFMA32(b1, qr[0], negm); }
            else { pA0 = MFMA32(b0, qr[d0], pA0); pA1 = MFMA32(b1, qr[d0], pA1); } }
        asm volatile("s_nop 15\n\ts_nop 7" : "+v"(pA0), "+v"(pA1));
    }
    START(pA0, pA1);
#pragma unroll
    for (int r = 0; r < 16; ++r) pA1[r] = __builtin_amdgcn_exp2f(pA1[r]);
    WAIT_BAR(0);
    DMA_K(3, 0); DMA_V(1, SLOTB);
    ROT();
#define KLOAD8(kp_) do { kf[0] = *(const LAS bf16x8*)(kp_); kf[1] = *(const LAS bf16x8*)((kp_) + 512); kf[2] = *(const LAS bf16x8*)((kp_) + 2048); kf[3] = *(const LAS bf16x8*)((kp_) + 2560); \
        kf[4] = *(const LAS bf16x8*)((kp_) + 4096); kf[5] = *(const LAS bf16x8*)((kp_) + 4608); kf[6] = *(const LAS bf16x8*)((kp_) + 6144); kf[7] = *(const LAS bf16x8*)((kp_) + 6656); } while (0)
    KLOAD8(kp0 + sl_cur);
    WAIT_BAR(2);
    s16x4 vlo[8], vhi[8]; u32x4 pw0, pw1, pw2, pw3;
#define PKW(P_, B_) pk2(P_[B_], P_[B_ + 1])
#define PAF(k) __builtin_bit_cast(bf16x8, pw##k)
#define VFR(i) (bf16x8){vlo[i][0], vlo[i][1], vlo[i][2], vlo[i][3], vhi[i][0], vhi[i][1], vhi[i][2], vhi[i][3]}
#define PIN(x) asm volatile("" : "+v"(x))
#define MX3(a, b, c_) __builtin_fmaxf(__builtin_fmaxf((a), (b)), (c_))
#define GAPA(MF, A0, A1, A2, A3, W0, W1, PW) do { MF; sacc += A0; sacc += A1; sacc += A2; sacc += A3; PIN(sacc); W0; W1; PIN(PW); SBAR(); } while (0)
#define EX(v) __builtin_amdgcn_exp2f(v)
#define GAPB(MF, X, B_) do { MF; X[B_] = EX(X[B_]); X[B_ + 1] = EX(X[B_ + 1]); X[B_ + 2] = EX(X[B_ + 2]); X[B_ + 3] = EX(X[B_ + 3]); PIN(X); SBAR(); } while (0)
#define VRD(i) do { vlo[i] = vtr(vp_ + (((i) >> 2) * 4096 + ((i) & 3) * 1024)); vhi[i] = vtr(vp_ + (((i) >> 2) * 4096 + ((i) & 3) * 1024 + 512)); } while (0)
#define KRD(G_, j) do { if (G_) { const lcp kn_ = kp0 + sl_next; kf[2 * (j)] = *(const LAS bf16x8*)(kn_ + (j) * 2048); kf[2 * (j) + 1] = *(const LAS bf16x8*)(kn_ + (j) * 2048 + 512); SBAR(); } } while (0)
#define STEP(C0, C1, P0, P1, t, GK, GV, GL) do { SBAR(); \
    const lcp vp_ = vp0 + sl_prev; \
    VRD(0); SBAR(); float sacc = (P0[0] + P0[1]); \
    GAPA(C0 = MFMA32(kf[0], qr[0], negm), P0[2], P0[3], P0[4], P0[5],     pw0[0] = PKW(P0, 0), pw0[1] = PKW(P0, 2), pw0); \
    VRD(4); SBAR(); GAPA(C1 = MFMA32(kf[1], qr[0], negm), P0[6], P0[7], P0[8], P0[9],     pw0[2] = PKW(P0, 4), pw0[3] = PKW(P0, 6), pw0); \
    VRD(1); SBAR(); GAPA(C0 = MFMA32(kf[2], qr[1], C0),   P0[10], P0[11], P0[12], P0[13], pw1[0] = PKW(P0, 8), pw1[1] = PKW(P0, 10), pw1); \
    VRD(5); SBAR(); GAPA(C1 = MFMA32(kf[3], qr[1], C1),   P0[14], P0[15], P1[0], P1[1],   pw1[2] = PKW(P0, 12), pw1[3] = PKW(P0, 14), pw1); \
    VRD(2); SBAR(); GAPA(C0 = MFMA32(kf[4], qr[2], C0),   P1[2], P1[3], P1[4], P1[5],     pw2[0] = PKW(P1, 0), pw2[1] = PKW(P1, 2), pw2); \
    VRD(6); SBAR(); GAPA(C1 = MFMA32(kf[5], qr[2], C1),   P1[6], P1[7], P1[8], P1[9],     pw2[2] = PKW(P1, 4), pw2[3] = PKW(P1, 6), pw2); \
    VRD(3); SBAR(); GAPA(C0 = MFMA32(kf[6], qr[3], C0),   P1[10], P1[11], P1[12], P1[13], pw3[0] = PKW(P1, 8), pw3[1] = PKW(P1, 10), pw3); \
    VRD(7); SBAR(); GAPA(C1 = MFMA32(kf[7], qr[3], C1),   P1[14], P1[15], 0.f, 0.f,       pw3[2] = PKW(P1, 12), pw3[3] = PKW(P1, 14), pw3); \
    l_reg += sacc; \
    if (GK) { DMA_K((t) + 3, sl_cur); } if (GV) { DMA_V((t) + 1, sl_next); } \
    CMASK(C0, C1, t); \
    { float a = MX3(C0[0], C0[1], C1[0]), b_ = MX3(C0[2], C0[3], C1[1]); a = MX3(a, C1[2], C1[3]); \
      _Pragma("unroll") for (int r = 4; r < 16; r += 4) { a = MX3(a, C0[r], C0[r + 1]); b_ = MX3(b_, C0[r + 2], C0[r + 3]); a = MX3(a, C1[r], C1[r + 1]); b_ = MX3(b_, C1[r + 2], C1[r + 3]); } \
      float rm = __builtin_fmaxf(a, b_); { auto rr = __builtin_amdgcn_permlane32_swap(__float_as_uint(rm), __float_as_uint(rm), false, false); rm = __builtin_fmaxf(__uint_as_float(rr[0]), __uint_as_float(rr[1])); } \
      resc = false; \
      if (__builtin_expect(__builtin_amdgcn_ballot_w64(rm > (float)THRL) != 0ull, 0)) { const float dl = __builtin_fmaxf(rm, 0.f); mhat += dl; \
        _Pragma("unroll") for (int r = 0; r < 16; ++r) { C0[r] -= dl; C1[r] -= dl; } \
        _Pragma("unroll") for (int r = 0; r < 16; ++r) negm[r] = -mhat; asm volatile("" : "+v"(negm)); \
        const float f = __builtin_amdgcn_exp2f(-dl); l_reg *= f; if (hi == 0) wsf[r32] = f; resc = true; } } \
    SBAR(); \
    GAPB(o[0] = MFMA32(PAF(0), VFR(0), o[0]), C0, 0); \
    GAPB(o[1] = MFMA32(PAF(0), VFR(4), o[1]), C0, 4); \
    KRD(GL, 0); GAPB(o[0] = MFMA32(PAF(1), VFR(1), o[0]), C0, 8); \
    KRD(GL, 1); GAPB(o[1] = MFMA32(PAF(1), VFR(5), o[1]), C0, 12); \
    KRD(GL, 2); GAPB(o[0] = MFMA32(PAF(2), VFR(2), o[0]), C1, 0); \
    KRD(GL, 3); GAPB(o[1] = MFMA32(PAF(2), VFR(6), o[1]), C1, 4); \
    GAPB(o[0] = MFMA32(PAF(3), VFR(3), o[0]), C1, 8); \
    GAPB(o[1] = MFMA32(PAF(3), VFR(7), o[1]), C1, 12); \
    } while (0)
#define ENDW(tt) do { if ((tt) + 3 < NT) { WAIT_BAR(2); } else if ((tt) + 2 < NT) { WAIT_BAR(1); } else { WAIT_BAR(0); } } while (0)
    int t = 1;
    for (; t + 1 < NT; t += 2) {
        STEP(pB0, pB1, pA0, pA1, t, (t + 3 < NT), (t + 1 < NT), (t + 1 < NT));         ENDW(t);     RESC(); ROT();
        STEP(pA0, pA1, pB0, pB1, t + 1, (t + 4 < NT), (t + 2 < NT), (t + 2 < NT));     ENDW(t + 1); RESC(); ROT();
    }
    STEP(pB0, pB1, pA0, pA1, NT - 1, false, false, false); RESC();
    { float sacc = pB0[0] + pB0[1];
#pragma unroll
      for (int r = 2; r < 16; ++r) sacc += pB0[r];
#pragma unroll
      for (int r = 0; r < 16; ++r) sacc += pB1[r];
      l_reg += sacc;
      pw0 = (u32x4){PKW(pB0, 0), PKW(pB0, 2), PKW(pB0, 4), PKW(pB0, 6)}; pw1 = (u32x4){PKW(pB0, 8), PKW(pB0, 10), PKW(pB0, 12), PKW(pB0, 14)};
      pw2 = (u32x4){PKW(pB1, 0), PKW(pB1, 2), PKW(pB1, 4), PKW(pB1, 6)}; pw3 = (u32x4){PKW(pB1, 8), PKW(pB1, 10), PKW(pB1, 12), PKW(pB1, 14)};
      SBAR(); pv(o, (int)(uintptr_t)vp0 + sl_cur, PAF(0), PAF(1), PAF(2), PAF(3)); }
#undef PKW
#undef PAF
#undef VFR
#undef PIN
#undef MX3
#undef GAPA
#undef GAPB
#undef EX
#undef VRD
#undef KRD
#undef STEP
#undef ENDW
#undef KLOAD8
    { auto rr = __builtin_amdgcn_permlane32_swap(__float_as_uint(l_reg), __float_as_uint(l_reg), false, false); l_reg = __uint_as_float(rr[0]) + __uint_as_float(rr[1]); }
    if (MODE == 1) l_reg += __builtin_amdgcn_exp2f(p.sink[layer * 4 + h] * 1.4426950408889634f - mhat);
    {
        const int lnf = lane_id_fresh(), r32f = lnf & 31, hif = lnf >> 5;
        if (hif == 0) wsf[32 + r32f] = l_reg;
        asm volatile("s_waitcnt lgkmcnt(0)" ::: "memory");
        LAS bf16_t* stg = (LAS bf16_t*)(c.lds + F_OST) + wid * 2048;
#pragma unroll
        for (int r = 0; r < 16; ++r) { const int orow = crow(r, hif); const float rl = __builtin_amdgcn_rcpf(wsf[32 + orow]);
            stg[orow * 64 + r32f] = f2bf(o[0][r] * rl); stg[orow * 64 + 32 + r32f] = f2bf(o[1][r] * rl); }
        asm volatile("s_waitcnt lgkmcnt(0)" ::: "memory");
        bf16_t* Ow = YC + (size_t)qrow0 * D + ycol;
#pragma unroll
        for (int i = 0; i < 4; ++i) { const int row = i * 8 + (lnf >> 3), ch = lnf & 7; const u32x4 v = *(const LAS u32x4*)(stg + row * 64 + ch * 8); *(u32x4*)(Ow + (size_t)row * D + ch * 8) = v; } }
    asm volatile("s_waitcnt lgkmcnt(0)\n\ts_barrier" ::: "memory");
#undef DMA_K
#undef DMA_V
#undef CMASK
#undef START
#undef RESC
#undef ROT
#undef TROW
}
#undef SBAR
#undef WAIT_BAR
}

template <int MODE>
DI void phase_fa64(const Params& p, const Cx& c0, int layer, int ctxq, int first_blk = 0) {
    const Cx c = fresh(c0);
    const int nunits = ctxq ? NB * 4 : NB * 4 * 32;
    __syncthreads();
    for (int unit = c.vcu >= first_blk ? c.vcu - first_blk : c.vcu - first_blk + c.G; unit < nunits; unit += c.G) {
        const int qb = ctxq ? 0 : unit & 31, h = ctxq ? unit & 3 : (unit >> 5) & 3, b = ctxq ? unit >> 2 : unit >> 7;
        da2::unit64<MODE, 8>(p, c, layer, b, h, qb, ctxq);
    }
    __syncthreads();
}
template <int l>
DI void layer_body(const Params& p, const Cx& c, const XcdBarrier& bar) {
    unsigned char* ws = p.ws;
    bf16_t* H = (bf16_t*)(ws + OFF_H);
    bf16_t* P = (bf16_t*)(ws + OFF_A + A_P);
    bf16_t* ACT = (bf16_t*)(ws + OFF_A + A_ACT);
    const int bid = (int)blockIdx.x;
        if (l == 0) { phase_norm1(p, c, l); xcd_barrier(bar); }
        {
            pg8::Gemm g{H, (const bf16_t*)(ws + OFF_WIN) + (size_t)l * INW * D, D}; pg8::StaticOrder S; S.init(T, INW, D, c.G, bid);
            pg8::EpiWin E{P, (bf16_t*)(ws + OFF_A + A_VT), (const float2*)(ws + OFF_ROPE)};
            pg8::gemm_phase<pg8::EpiWin, pg8::StaticOrder, true, false>(c.lds, g, S, E, c.wave);
        }
        bg_convert<(l == 0 ? 0 : 3)>(p, c);
        xcd_barrier(bar);
        phase_ret_u_mfma(p, c, l);
        phase_fa64<1>(p, c, l, 0);
        phase_fa64<2>(p, c, l, 0);
        phase_da2(p, c, l, 0);
        xcd_barrier(bar);
        phase_ret_scan2(p, c, l);
        bg_convert<(l == 0 ? 4 : 5)>(p, c);
        if (l == 0) phase_ret_out_mfma<true>(p, c, l, 0, c.G >= 168 ? 160 : 0);
        if (l == 0 && c.G >= 160) { phase_fa64<1>(p, c, l, 1, 128); phase_fa64<2>(p, c, l, 1, 136); phase_da2(p, c, l, 1, 144); }
        else if (l == 0) { phase_fa64<1>(p, c, l, 1); phase_fa64<2>(p, c, l, 1); phase_da2(p, c, l, 1); }
        xcd_barrier(bar);
        phase_ret_out_mfma<false>(p, c, l, 2);
        xcd_barrier(bar);
        if (l == 0) {
            pg8::Gemm g{H, (const bf16_t*)(ws + OFF_WOUT) + (size_t)l * D * D, D}; pg8::SplitOrder S; S.init(TX, TC, D, D, WOUT_SPLIT, c.G, bid);
            pg8::EpiBf16 E{(bf16_t*)(ws + OFF_B), D, 0, 0, (float*)(ws + OFF_B + B_SLAB_Y), TX, TC, 1.f};
            pg8::gemm_phase<pg8::EpiBf16, pg8::SplitOrder, true, false>(c.lds, g, S, E, c.wave);
            bg_convert<1>(p, c);
        } else {
            pg8::Gemm g{H, (const bf16_t*)(ws + OFF_WOUT) + (size_t)l * D * D, D}; pg8::StaticOrder S; S.init(TX, D, D, c.G, bid);
            pg8::EpiBf16 E{(bf16_t*)(ws + OFF_B), D, 0, 0, nullptr, 0, 0, 1.f};
            pg8::gemm_phase<pg8::EpiBf16, pg8::StaticOrder, true, false>(c.lds, g, S, E, c.wave);
        }
        xcd_barrier(bar);
        phase_post_attn(p, c, l);
        xcd_barrier(bar);
        if (l == 0) {
            {
                pg8::Gemm g{H, (const bf16_t*)(ws + OFF_WGU), D}; pg8::StaticOrder S; S.init(T, 2 * FF, D, c.G, bid);
                pg8::EpiSwiglu8 E{ws + OFF_A + A_ACT, FF, 0, 1.f, ACT8_SCALE};
                pg8::gemm_phase<pg8::EpiSwiglu8, pg8::StaticOrder, true, false>(c.lds, g, S, E, c.wave); }
            bg_convert<2>(p, c);
            xcd_barrier(bar);
            {
                pg8::Gemm g{(const bf16_t*)(ws + OFF_A + A_ACT), (const bf16_t*)(ws + OFF_WD), FF}; pg8::SplitOrder S; S.init(TX, TC, D, FF / 2, FFD_SPLIT, c.G, bid);
                pg8::EpiBf16 E{(bf16_t*)(ws + OFF_B), D, 0, 0, (float*)(ws + OFF_B + B_SLAB_F), TX, TC, W8_INV / ACT8_SCALE};
                pg8::gemm_phase<pg8::EpiBf16, pg8::SplitOrder, true, false, true>(c.lds, g, S, E, c.wave); }
            xcd_barrier(bar);
        } else {
            {
                pg8::Gemm g{(const bf16_t*)(ws + OFF_H8), (const bf16_t*)(ws + OFF_MGU), D}; pg8::MoeOrder S; S.init((const unsigned*)(ws + OFF_CNT), (const int*)(ws + OFF_TLIST), 2 * ED / 256, D / 128, c.G, c.vcu);
                pg8::EpiSwiglu8 E{ws + OFF_A + A_ACT, ED, 2 * ED / 256, W8_INV, 1.f};
                pg8::gemm_phase<pg8::EpiSwiglu8, pg8::MoeOrder, true, true, true>(c.lds, g, S, E, c.wave); }
            xcd_barrier(bar);
            {
                pg8::Gemm g{(const bf16_t*)(ws + OFF_A + A_ACT), (const bf16_t*)(ws + OFF_MD), ED}; pg8::MoeOrder S; S.init((const unsigned*)(ws + OFF_CNT), (const int*)(ws + OFF_TLIST), D / 256, ED / 128, c.G, c.vcu);
                pg8::EpiBf16S E{(bf16_t*)(ws + OFF_B), D, D / 256, W8_INV};
                pg8::gemm_phase<pg8::EpiBf16S, pg8::MoeOrder, true, false, true>(c.lds, g, S, E, c.wave); }
            xcd_barrier(bar);
        }
        phase_post_ffn(p, c, l);
        if (l == 0) xcd_barrier(bar);
}

__global__ void __launch_bounds__(NTHREADS, 2) mega_fwd(Params p) {
    extern __shared__ __attribute__((aligned(16))) unsigned char lds_raw[];
    Cx c;
    c.lds = (LAS unsigned char*)lds_raw;
    c.tid = threadIdx.x; c.lane = c.tid & 63; c.wave = __builtin_amdgcn_readfirstlane(c.tid >> 6);
    c.G = gridDim.x; { const int bx = blockIdx.x; c.vcu = (c.G % 8 == 0) ? (bx % 8) * (c.G / 8) + bx / 8 : bx; }
    for (int u = c.tid; u < (LDS_BYTES - LDSCTL_OFF) / 4; u += NTHREADS) ((LAS unsigned*)(c.lds + LDSCTL_OFF))[u] = 0u;
    __syncthreads();
    XcdBarrier bar = xcd_barrier_post((unsigned*)(p.ws + OFF_BAR), (volatile LAS unsigned*)(c.lds + LDSCTL_OFF + 64));

    phase_convert(p, c);
    phase_mod(p, c);
    xcd_barrier(bar);
    layer_body<0>(p, c, bar);
    layer_body<1>(p, c, bar);
}

extern "C" void kernel_launch(void* const* d_in, const int* in_sizes, int n_in, void* d_out, int out_size, void* d_ws, size_t ws_size, hipStream_t stream) {
    static int grid = 0;
    if (grid == 0) {
        if (n_in != 28 || ws_size < WS_NEED) { fprintf(stderr, "kernel_launch: need 28 inputs and %zu bytes of workspace (got %d, %zu)\n", (size_t)WS_NEED, n_in, ws_size); grid = -1; return; }
        int dev = 0, cus = 0, per_cu = 0;
        if (hipGetDevice(&dev) != hipSuccess || hipDeviceGetAttribute(&cus, hipDeviceAttributeMultiprocessorCount, dev) != hipSuccess) { grid = -1; return; }
        if (hipFuncSetAttribute((const void*)mega_fwd, hipFuncAttributeMaxDynamicSharedMemorySize, LDS_BYTES) != hipSuccess) { fprintf(stderr, "kernel_launch: hipFuncSetAttribute failed\n"); grid = -1; return; }
        if (hipOccupancyMaxActiveBlocksPerMultiprocessor(&per_cu, (const void*)mega_fwd, NTHREADS, LDS_BYTES) != hipSuccess || per_cu < 1) { fprintf(stderr, "kernel_launch: occupancy query says %d\n", per_cu); }
        (void)hipGetLastError();
        grid = cus;
    }
    if (grid < 0) return;
    Params p{};
    const float* const* in = (const float* const*)d_in;
    p.x = in[0]; p.c = in[1]; p.ctx = in[2]; p.c_ctx = in[3]; p.w_mod = in[4]; p.b_mod = in[5]; p.g_attn_pre = in[6]; p.g_attn_post = in[7]; p.g_ffn_pre = in[8]; p.g_ffn_post = in[9];
    p.w_in = in[10]; p.w_out = in[11]; p.lq1 = in[12]; p.lk1 = in[13]; p.lq2 = in[14]; p.lk2 = in[15]; p.subln = in[16]; p.sink = in[17]; p.rpb = in[18]; p.gam_f = in[19]; p.gam_b = in[20];
    p.ffn_wg = in[21]; p.ffn_wu = in[22]; p.ffn_wd = in[23]; p.router = in[24]; p.moe_wg = in[25]; p.moe_wu = in[26]; p.moe_wd = in[27];
    p.out = (float*)d_out; p.ws = (unsigned char*)d_ws;
    if (hipMemsetAsync(d_ws, 0, CTL_ZERO_BYTES, stream) != hipSuccess) return;
    hipLaunchKernelGGL(mega_fwd, dim3(grid), dim3(NTHREADS), LDS_BYTES, stream, p);
}
```

```cpp
#include <hip/hip_runtime.h>
#include <stdint.h>
#include <stddef.h>
#include <stdio.h>

typedef unsigned short bf16_t;
typedef short bf16x8 __attribute__((ext_vector_type(8)));
typedef float f32x4 __attribute__((ext_vector_type(4)));
typedef unsigned u32x4 __attribute__((ext_vector_type(4)));
typedef unsigned u32x2 __attribute__((ext_vector_type(2)));
#define LAS __attribute__((address_space(3)))
#define DI __device__ __forceinline__
typedef LAS float lfloat;
typedef float f32x16 __attribute__((ext_vector_type(16)));
#define MFMA32(a, b, c) __builtin_amdgcn_mfma_f32_32x32x16_bf16((a), (b), (c), 0, 0, 0)

constexpr int D = 1024, SEQ = 8192, NB = 2, CTXL = 256;
constexpr int TX = NB * SEQ;
constexpr int TC = NB * CTXL;
constexpr int T = TX + TC;
constexpr int INW = 3072, FF = 2816, NE = 8, ED = 3584;
constexpr int NCH = 66;
constexpr float EPS = 1e-6f;
constexpr int MOE_ROWS = 34816;
constexpr int PASS_TILES = 64, PASS_ROWS = PASS_TILES * 256;
constexpr int PASS1_ROWS = MOE_ROWS - PASS_ROWS;
constexpr int NTHREADS = 512, NWAVES = 8;

constexpr int DA_Q = 0, DA_K = 256, DA_V = 512;
constexpr int SW_Q = 768, SW_K = 1024, SW_V = 1152;
constexpr int NA_Q = 1280, NA_K = 1536, NA_V = 1792;
constexpr int RT_Q = 2048, RT_K = 2304, RT_V = 2560, RT_G = 2816;

constexpr size_t al256(size_t x) { return (x + 255) & ~(size_t)255; }
constexpr size_t OFF_BAR = 0;
constexpr size_t OFF_CNT = 16384;
constexpr size_t CTL_ZERO_BYTES = 32768;
constexpr size_t OFF_MOD = 32768;
constexpr size_t OFF_ROPE = al256(OFF_MOD + 2 * 3 * 6144 * 4);
constexpr size_t OFF_TLIST = al256(OFF_ROPE + 128 * 24 * 8);
constexpr size_t OFF_TOKE = OFF_TLIST + 8 * 16384 * 4;
constexpr size_t OFF_TOKJ = OFF_TOKE + 16384 * 2 * 4;
constexpr size_t OFF_TOKW = OFF_TOKJ + 16384 * 2 * 4;
constexpr size_t OFF_XC = OFF_TOKW + 16384 * 2 * 4;
constexpr size_t OFF_WIN = OFF_XC + (size_t)TC * D * 4;
constexpr size_t OFF_WOUT = OFF_WIN + (size_t)2 * INW * D * 2;
constexpr size_t OFF_WGU = OFF_WOUT + (size_t)2 * D * D * 2;
constexpr size_t OFF_WD = OFF_WGU + (size_t)2 * FF * D * 2;
constexpr size_t OFF_MGU = OFF_WD + (size_t)D * FF * 2;
constexpr size_t OFF_MD = OFF_MGU + (size_t)NE * 2 * ED * D * 2;
constexpr size_t OFF_H8 = OFF_MD + (size_t)NE * D * ED;
constexpr size_t OFF_H = OFF_MD + (size_t)NE * D * ED * 2;
constexpr size_t OFF_A = OFF_H + (size_t)T * D * 2;
constexpr size_t A_P = 0;
constexpr size_t A_U = A_P + (size_t)T * INW * 2;
constexpr size_t A_S = A_U + (size_t)NB * 4 * 2 * NCH * 4096 * 4;
constexpr size_t A_VT = A_S + (size_t)NB * 4 * 2 * NCH * 4096 * 4;
constexpr int NKEY = CTXL + SEQ;
constexpr int VH_DA = 0, VH_SW = 4, VH_NA = 6, VH_RT = 10, NVH = 14;
constexpr size_t A_END = A_VT + (size_t)NB * NVH * 64 * NKEY * 2;
constexpr size_t A_ACT = 0;
constexpr size_t SZ_A = A_END > (size_t)MOE_ROWS * ED ? A_END : (size_t)MOE_ROWS * ED;
static_assert((size_t)T * D <= (size_t)NE * D * ED, "H8 fits behind MD8");
constexpr float ACT8_SCALE = 8.f;
constexpr float W8_SCALE = 64.f, W8_INV = 1.f / 64.f;
constexpr size_t OFF_B = OFF_A + al256(SZ_A);
constexpr size_t SZ_B = (size_t)MOE_ROWS * D * 2 > (size_t)T * D * 4 ? (size_t)MOE_ROWS * D * 2 : (size_t)T * D * 4;
constexpr size_t OFF_XS = OFF_B + al256(SZ_B);
constexpr size_t WS_NEED = OFF_XS + (size_t)T * D * 2;
constexpr int WOUT_SPLIT = 4, FFD_SPLIT = 11;
constexpr size_t B_SLAB_Y = (size_t)36 << 20;
constexpr size_t B_SLAB_F = B_SLAB_Y + (size_t)WOUT_SPLIT * TC * D * 4;
static_assert(B_SLAB_F + (size_t)FFD_SPLIT * TC * D * 4 <= SZ_B, "slabs fit");

constexpr int RING_BYTES = 131072, LDSCTL_OFF = RING_BYTES, LDS_BYTES = 147456;

struct Params {
    const float *x, *c, *ctx, *c_ctx, *w_mod, *b_mod, *g_attn_pre, *g_attn_post, *g_ffn_pre, *g_ffn_post, *w_in, *w_out;
    const float *lq1, *lk1, *lq2, *lk2, *subln, *sink, *rpb, *gam_f, *gam_b, *ffn_wg, *ffn_wu, *ffn_wd, *router, *moe_wg, *moe_wu, *moe_wd;
    float* out;
    unsigned char* ws;
};

DI float bf2f(bf16_t v) { return __uint_as_float(((unsigned)v) << 16); }
DI bf16_t f2bf(float f) { unsigned u = __float_as_uint(f); u += 0x7fffu + ((u >> 16) & 1u); return (bf16_t)(u >> 16); }
typedef __bf16 v2bf_t __attribute__((ext_vector_type(2)));
typedef float v2f_t __attribute__((ext_vector_type(2)));
DI unsigned pk2(float lo, float hi) { const v2f_t x = {lo, hi}; return __builtin_bit_cast(unsigned, __builtin_convertvector(x, v2bf_t)); }
DI float silu_f(float v) { return v / (1.f + __expf(-v)); }
DI int lane_id_fresh() { int ln; asm volatile("v_mbcnt_lo_u32_b32 %0, -1, 0\n\tv_mbcnt_hi_u32_b32 %0, -1, %0" : "=v"(ln)); return ln; }
DI float shx(float v, int mask, int lane) { return __int_as_float(__builtin_amdgcn_ds_bpermute((lane ^ mask) << 2, __float_as_int(v))); }
DI float wave_sum(float v, int lane) {
#pragma unroll
    for (int o = 1; o < 64; o <<= 1) v += shx(v, o, lane);
    return v;
}

DI const float* xin0_row(const Params& p, int row) { return row < TX ? p.x + (size_t)row * D : p.ctx + (size_t)(row - TX) * D; }
DI const float* mod_row(const Params& p, int layer, int row) {
    const int v = row < TX ? (row >> 13) : 2;
    return (const float*)(p.ws + OFF_MOD) + (size_t)(layer * 3 + v) * 6144;
}
#define XB_TMO      128
#define XB_XCNT(j)  (256  + 64 * (j))
#define XB_XSUB(j)  (1280 + 64 * (j))
#define XB_XGEN(j)  (2304 + 64 * (j))
#define XB_TOP      3328
#define XB_TOPGEN   3392
#define XCD_BAR_WORDS 3456
#define XB_SPIN_CAP (1u << 23)

__device__ __forceinline__ unsigned xb_ld(unsigned* p)              { return __hip_atomic_load(p, __ATOMIC_RELAXED, __HIP_MEMORY_SCOPE_AGENT); }
__device__ __forceinline__ unsigned xb_add(unsigned* p, unsigned v) { return __hip_atomic_fetch_add(p, v, __ATOMIC_RELAXED, __HIP_MEMORY_SCOPE_AGENT); }
__device__ __forceinline__ unsigned xb_xcc_id() { return (unsigned)__builtin_amdgcn_s_getreg((3 << 11) | 20) & 0xFu; }
#define XB_SPIN(cond, bar) do { unsigned _sp = 0; while (cond) { __builtin_amdgcn_s_sleep(1); \
    if ((++_sp & 255u) == 0u) { if (xb_ld(&(bar)[XB_TMO])) break; if (_sp > XB_SPIN_CAP) { atomicAdd(&(bar)[XB_TMO], 1u); break; } } } } while (0)

struct XcdBarrier {
    unsigned* bar; unsigned x;
    volatile LAS unsigned* st;
};

__device__ __forceinline__ XcdBarrier xcd_barrier_post(unsigned* bar, volatile LAS unsigned* st) {
    XcdBarrier b; b.bar = bar; b.x = xb_xcc_id(); b.st = st;
    if (threadIdx.x == 0) (void)xb_add(&bar[XB_XCNT(b.x)], 1u);
    return b;
}
__device__ __forceinline__ void xcd_barrier_complete(unsigned* bar, unsigned x, unsigned& nloc, unsigned& nx) {
    const unsigned G = gridDim.x * gridDim.y * gridDim.z;
    unsigned sum, cnt, mine, sp = 0u;
    for (;;) {
        sum = 0u; cnt = 0u; mine = 0u;
#pragma unroll
        for (unsigned j = 0; j < 16; ++j) { const unsigned c = xb_ld(&bar[XB_XCNT(j)]); sum += c; cnt += (c > 0u) ? 1u : 0u; mine = (j == x) ? c : mine; }
        if (sum == G) break;
        __builtin_amdgcn_s_sleep(1);
        if ((++sp & 255u) == 0u) { if (xb_ld(&bar[XB_TMO])) break; if (sp > XB_SPIN_CAP) { atomicAdd(&bar[XB_TMO], 1u); break; } }
    }
    nloc = mine > 0u ? mine : 1u; nx = cnt > 0u ? cnt : 1u;
}

__device__ __forceinline__ void xcd_barrier(const XcdBarrier& b) {
    asm volatile("s_waitcnt vmcnt(0)" ::: "memory");
    __syncthreads();
    if (threadIdx.x == 0) {
        unsigned* bar = b.bar;
        __builtin_amdgcn_s_waitcnt(0);
        unsigned nloc = b.st[0], nx = b.st[1];
        if (nloc == 0u) { xcd_barrier_complete(bar, b.x, nloc, nx); b.st[0] = nloc; b.st[1] = nx; }
        const unsigned old = xb_add(&bar[XB_XSUB(b.x)], 1u);
        const unsigned gen = old / nloc;
        if (old + 1u == (gen + 1u) * nloc) {
            __builtin_amdgcn_fence(__ATOMIC_RELEASE, "agent");
            asm volatile("s_waitcnt vmcnt(0)" ::: "memory");
            const unsigned og = xb_add(&bar[XB_TOP], 1u);
            const unsigned tg = og / nx;
            if (og + 1u == (tg + 1u) * nx) xb_add(&bar[XB_TOPGEN], 1u);
            else XB_SPIN(xb_ld(&bar[XB_TOPGEN]) == tg, bar);
            __builtin_amdgcn_fence(__ATOMIC_ACQUIRE, "agent");
            xb_add(&bar[XB_XGEN(b.x)], 1u);
            asm volatile("s_waitcnt vmcnt(0)" ::: "memory");
        } else {
            XB_SPIN(xb_ld(&bar[XB_XGEN(b.x)]) == gen, bar);
            __builtin_amdgcn_fence(__ATOMIC_ACQUIRE, "agent");
            asm volatile("s_waitcnt vmcnt(0)" ::: "memory");
        }
    }
    __syncthreads();
}
namespace pg8 {
typedef int v4i_t __attribute__((ext_vector_type(4)));
typedef int v8i_t __attribute__((ext_vector_type(8)));
constexpr int BM = 256, BK = 64, HALF = 128, HTB = HALF * BK * 2  , STAGE_BYTES = 8 * HTB, NXCD = 8, WGM = 8;
__host__ __device__ __forceinline__ int lds_byte(int r, int c) { const int st = (r >> 4) * 2 + (c >> 5), rr = r & 15, cc = c & 31, ob = rr * 64 + cc * 2; return st * 1024 + (ob ^ (((ob >> 9) & 1) << 5)); }
__host__ __device__ __forceinline__ void stage_rc(int b, int& R, int& C) { const int st = b / 1024, sb = b % 1024, swz = sb ^ (((sb >> 9) & 1) << 5); R = (st >> 1) * 16 + swz / 64; C = (st & 1) * 32 + (swz % 64) / 2; }
__host__ __device__ __forceinline__ int perm32(int rho) { const int n = rho >> 4, i = rho & 15; return 8 * (i >> 2) + 4 * n + (i & 3); }

struct Unit { int pm, pn, e, j0, kt0, nkt, slice; };
struct Gemm { const bf16_t* A; const bf16_t* Bt; int K; };

struct StaticOrder {
    int nM, nN, nwg, G, c, nkt;
    __device__ void init(int M, int N, int K, int G_, int c_) { nM = M / BM; nN = N / BM; nwg = nM * nN; G = G_; c = c_; nkt = K / BK; }
    __device__ bool next(int i, Unit& u) const {
        const long L = (long)i * G + c; if (L >= nwg) return false;
        int wgid = (int)L; { const int q = nwg / NXCD, r = nwg % NXCD, xcd = wgid % NXCD, off = wgid / NXCD; wgid = (xcd < r ? xcd * (q + 1) : r * (q + 1) + (xcd - r) * q) + off; }
        const int nig = WGM * nN, gid = wgid / nig, fm = gid * WGM, gsz = (nM - fm) < WGM ? (nM - fm) : WGM;
        u.pm = fm + ((wgid % nig) % gsz); u.pn = (wgid % nig) / gsz; u.e = 0; u.j0 = 0; u.kt0 = 0; u.nkt = nkt; u.slice = -1; return true;
    }
    __device__ __forceinline__ int arow(const Unit&, int) const { return 0; }
};
struct SplitOrder {
    StaticOrder main; int nExtra, S, nN, nktS;
    __device__ void init(int Mmain, int Mextra, int N, int K, int S_, int G_, int c_) { main.init(Mmain, N, K, G_, c_); nExtra = Mextra / BM; S = S_; nN = N / BM; nktS = (K / BK) / S_; }
    __device__ bool next(int i, Unit& u) const {
        const long L = (long)i * main.G + main.c;
        if (L < main.nwg) return main.next(i, u);
        const int idx = (int)(L - main.nwg); if (idx >= nExtra * nN * S) return false;
        const int sl = idx % S, r = idx / S;
        u.pm = main.nM + r / nN; u.pn = r % nN; u.e = 0; u.j0 = 0; u.kt0 = sl * nktS; u.nkt = nktS; u.slice = sl; return true;
    }
    __device__ __forceinline__ int arow(const Unit&, int) const { return 0; }
};

struct MoeOrder {
    int G, c, nN, t0, ntp, S, nktS; int tc[NE]; int cnt[NE]; const int* tlist;
    __device__ void init(const unsigned* cntp, const int* tl, int nN_, int nkt_, int G_, int c_) {
        G = G_; c = c_; nN = nN_; tlist = tl; S = 1; nktS = nkt_; int tot = 0;
#pragma unroll
        for (int e = 0; e < NE; ++e) { cnt[e] = (int)cntp[e]; tc[e] = (cnt[e] + 255) >> 8; tot += tc[e]; }
        t0 = 0; ntp = tot;
    }
    __device__ bool next(int i, Unit& u) const {
        const int L0 = i * G + c; if (L0 >= ntp * nN * S) return false;
        const int sl = L0 % S, L = L0 / S;
        const int g = L / (8 * nN), r = L - g * 8 * nN, gsz = (ntp - 8 * g) < 8 ? (ntp - 8 * g) : 8;
        const int pml = 8 * g + r % gsz, pnl = r / gsz, gt = t0 + pml;
        int e = 0, base = 0, run = 0; bool found = false;
#pragma unroll
        for (int k = 0; k < NE; ++k) { if (!found && gt < run + tc[k]) { e = k; base = run; found = true; } run += tc[k]; }
        u.pm = pml; u.pn = e * nN + pnl; u.e = e; u.j0 = (gt - base) * 256; u.kt0 = sl * nktS; u.nkt = nktS; u.slice = S > 1 ? sl : -1; return true;
    }
    __device__ __forceinline__ int arow(const Unit& u, int r) const {
        int j = u.j0 + r; int ce = 0;
#pragma unroll
        for (int k = 0; k < NE; ++k) ce = (u.e == k) ? cnt[k] : ce;
        if (j > ce - 1) j = ce - 1;
        return tlist[u.e * 16384 + j];
    }
};

struct EpiBf16 {
    bf16_t* O; int ldc; int row_off; int pn_mod; float* slab; int slab_row0, slab_rows; float scale;
    DI void operator()(const f32x4 (&acc)[2][2][4][2], const Unit& u, int wr, int wc, int fr, int fq) const {
        const int pn = pn_mod ? u.pn % pn_mod : u.pn;
        const int row0 = row_off + u.pm * BM + wr * 64 + fr, col0 = pn * BM + wc * 32 + 8 * fq;
        if (u.slice >= 0) {
#pragma unroll
            for (int ai = 0; ai < 2; ++ai)
#pragma unroll
                for (int m = 0; m < 4; ++m) { float* rowp = slab + ((size_t)u.slice * slab_rows + (row0 - slab_row0 + ai * HALF + m * 16)) * ldc + col0;
#pragma unroll
                    for (int bj = 0; bj < 2; ++bj) { *(f32x4*)(rowp + bj * HALF) = acc[ai][bj][m][0] * scale; *(f32x4*)(rowp + bj * HALF + 4) = acc[ai][bj][m][1] * scale; } }
            return;
        }
#pragma unroll
        for (int ai = 0; ai < 2; ++ai)
#pragma unroll
            for (int m = 0; m < 4; ++m) { bf16_t* rowp = O + (size_t)(row0 + ai * HALF + m * 16) * ldc + col0;
#pragma unroll
                for (int bj = 0; bj < 2; ++bj) { const f32x4 v0 = acc[ai][bj][m][0] * scale, v1 = acc[ai][bj][m][1] * scale;
                    u32x4 w; w.x = pk2(v0[0], v0[1]); w.y = pk2(v0[2], v0[3]); w.z = pk2(v1[0], v1[1]); w.w = pk2(v1[2], v1[3]);
                    *(u32x4*)(rowp + bj * HALF) = w; } }
    }
};
DI float clamp8(float x) { return fminf(fmaxf(x, -448.f), 448.f); }
DI unsigned pk4_fp8(float a, float b, float c_, float d) { int w = 0; w = __builtin_amdgcn_cvt_pk_fp8_f32(a, b, w, false); w = __builtin_amdgcn_cvt_pk_fp8_f32(c_, d, w, true); return (unsigned)w; }
struct EpiSwiglu8 {
    unsigned char* O; int ldc; int pn_mod; float sc, asc;
    DI void operator()(const f32x4 (&acc)[2][2][4][2], const Unit& u, int wr, int wc, int fr, int fq) const {
        const int pn = pn_mod ? u.pn % pn_mod : u.pn;
        const int row0 = u.pm * BM + wr * 64 + fr, col0 = pn * HALF + wc * 32 + 8 * fq;
        const float k1 = -sc * 1.4426950408889634f, k2 = sc * sc * asc;
#pragma unroll
        for (int ai = 0; ai < 2; ++ai)
#pragma unroll
            for (int m = 0; m < 4; ++m) {
                float o[8];
#pragma unroll
                for (int n = 0; n < 2; ++n)
#pragma unroll
                    for (int k = 0; k < 4; ++k) { const float ag = acc[ai][0][m][n][k], au = acc[ai][1][m][n][k];
                        const float r = __builtin_amdgcn_rcpf(1.f + __builtin_amdgcn_exp2f(ag * k1));
                        o[n * 4 + k] = __builtin_amdgcn_fmed3f((ag * k2) * au * r, -448.f, 448.f); }
                u32x2 w; w.x = pk4_fp8(o[0], o[1], o[2], o[3]); w.y = pk4_fp8(o[4], o[5], o[6], o[7]);
                *(u32x2*)(O + (size_t)(row0 + ai * HALF + m * 16) * ldc + col0) = w; }
    }
};
struct EpiBf16S {
    bf16_t* O; int ldc; int pn_mod; float scale;
    DI void operator()(const f32x4 (&acc)[2][2][4][2], const Unit& u, int wr, int wc, int fr, int fq) const {
        const int pn = pn_mod ? u.pn % pn_mod : u.pn;
        const int row0 = u.pm * BM + wr * 64 + fr, col0 = pn * BM + wc * 32 + 8 * fq;
#pragma unroll
        for (int ai = 0; ai < 2; ++ai)
#pragma unroll
            for (int m = 0; m < 4; ++m) { bf16_t* rowp = O + (size_t)(row0 + ai * HALF + m * 16) * ldc + col0;
#pragma unroll
                for (int bj = 0; bj < 2; ++bj) { const f32x4 v0 = acc[ai][bj][m][0] * scale, v1 = acc[ai][bj][m][1] * scale;
                    u32x4 w; w.x = pk2(v0[0], v0[1]); w.y = pk2(v0[2], v0[3]); w.z = pk2(v1[0], v1[1]); w.w = pk2(v1[2], v1[3]);
                    *(u32x4*)(rowp + bj * HALF) = w; } }
    }
};
struct EpiF32 {
    float* O; int ldc;
    DI void operator()(const f32x4 (&acc)[2][2][4][2], const Unit& u, int wr, int wc, int fr, int fq) const {
        const int row0 = u.pm * BM + wr * 64 + fr, col0 = u.pn * BM + wc * 32 + 8 * fq;
#pragma unroll
        for (int ai = 0; ai < 2; ++ai)
#pragma unroll
            for (int m = 0; m < 4; ++m) { float* rowp = O + (size_t)(row0 + ai * HALF + m * 16) * ldc + col0;
#pragma unroll
                for (int bj = 0; bj < 2; ++bj) { *(f32x4*)(rowp + bj * HALF) = acc[ai][bj][m][0]; *(f32x4*)(rowp + bj * HALF + 4) = acc[ai][bj][m][1]; } }
    }
};
struct EpiSwiglu {
    bf16_t* O; int ldc; int pn_mod;
    DI void operator()(const f32x4 (&acc)[2][2][4][2], const Unit& u, int wr, int wc, int fr, int fq) const {
        const int pn = pn_mod ? u.pn % pn_mod : u.pn;
        const int row0 = u.pm * BM + wr * 64 + fr, col0 = pn * HALF + wc * 32 + 8 * fq;
#pragma unroll
        for (int ai = 0; ai < 2; ++ai)
#pragma unroll
            for (int m = 0; m < 4; ++m) {
                float o[8];
#pragma unroll
                for (int n = 0; n < 2; ++n)
#pragma unroll
                    for (int k = 0; k < 4; ++k) { const float g = acc[ai][0][m][n][k], up = acc[ai][1][m][n][k]; o[n * 4 + k] = g * __builtin_amdgcn_rcpf(1.f + __expf(-g)) * up; }
                u32x4 w; w.x = pk2(o[0], o[1]); w.y = pk2(o[2], o[3]); w.z = pk2(o[4], o[5]); w.w = pk2(o[6], o[7]);
                *(u32x4*)(O + (size_t)(row0 + ai * HALF + m * 16) * ldc + col0) = w; }
    }
};


__host__ __device__ __forceinline__ int win_col_pos(int c) {
    if (c < 512) { const int g = (c >> 2) & 3; return (c & ~12) | ((g == 1 ? 2 : g == 2 ? 1 : g) << 2); }
    if ((c >= 768 && c < 1152) || (c >= 2048 && c < 2560)) { const int g = (c >> 2) & 7; return (c & ~28) | ((g < 4 ? 2 * g : 2 * (g - 4) + 1) << 2); }
    return c;
}
constexpr float DA_QSCALE = 0.17677669529663687f * 1.4426950408889634f, FA_QSCALE = 0.125f * 1.4426950408889634f;
struct EpiWin {
    bf16_t* P; bf16_t* VT; const float2* tab;
    DI void operator()(const f32x4 (&acc)[2][2][4][2], const Unit& u, int wr, int wc, int fr, int fq) const {
        const int lane = fq * 16 + fr;
        const bool xrows = u.pm < TX / BM;
#pragma unroll
        for (int bj = 0; bj < 2; ++bj) {
            const int cg = u.pn * BM + bj * HALF + wc * 32;
            int cls = 0;
            if (cg < 512) cls = 1;
            else if (cg < 768) cls = 0;
            else if (cg < 1152) cls = 2;
            else if (cg >= 2048 && cg < 2560) cls = 2;
            if (!xrows) cls = 0;
#pragma unroll
            for (int ai = 0; ai < 2; ++ai)
#pragma unroll
                for (int m = 0; m < 4; ++m) {
                    const int r = u.pm * BM + ai * HALF + wr * 64 + m * 16 + fr;
                    f32x4 v0 = acc[ai][bj][m][0], v1 = acc[ai][bj][m][1];
                    if (cg < 256) { v0 *= DA_QSCALE; v1 *= DA_QSCALE; }
                    else if ((cg >= 768 && cg < 1024) || (cg >= 1280 && cg < 1536)) { v0 *= FA_QSCALE; v1 *= FA_QSCALE; }
                    if (cls != 0) {
                        const int s = r & (SEQ - 1);
                        const int ax = cls == 1 ? (fq >> 1) : ((cg >> 5) & 1);
                        const int pos = ax ? (s & 63) : (s >> 6);
                        const float2* tb = tab + pos * 24 + (cls == 1 ? 4 * (fq & 1) : 8 + 4 * fq);
                        const f32x4 c01 = *(const f32x4*)(tb), c23 = *(const f32x4*)(tb + 2);
                        const f32x4 cs = (f32x4){c01[0], c01[2], c23[0], c23[2]}, sn = (f32x4){c01[1], c01[3], c23[1], c23[3]};
                        const f32x4 a = v0, b = v1;
                        v0 = a * cs - b * sn; v1 = b * cs + a * sn;
                    }
                    u32x4 w; w.x = pk2(v0[0], v0[1]); w.y = pk2(v0[2], v0[3]); w.z = pk2(v1[0], v1[1]); w.w = pk2(v1[2], v1[3]);
                    *(u32x4*)(P + (size_t)r * INW + cg + 8 * fq) = w;
                }
        }
    }
};

template <class Epi, class Sched, bool ALIGN_EPI, bool GATHER, bool FP8 = false>
DI void gemm_phase(LAS unsigned char* lds, const Gemm g, const Sched& S, const Epi& E, int wave_in) {
    int wv_ = wave_in; asm volatile("" : "+s"(wv_)); const int tid = lane_id_fresh() + 64 * wv_;
    const int wid = __builtin_amdgcn_readfirstlane(tid >> 6), lane = tid & 63, wr = wid >> 2, wc = wid & 3, fr = lane & 15, fq = lane >> 4;
    const int K = FP8 ? g.K / 2 : g.K;
    unsigned voffB[2]; int RA[2], CA[2];
#pragma unroll
    for (int i = 0; i < 2; ++i) { int R, C; stage_rc(tid * 16 + i * 8192, R, C); const int Rb = (R & ~31) + perm32(R & 31);
        RA[i] = R; CA[i] = C; voffB[i] = (unsigned)(Rb * K + C) * 2u; }
    const size_t kstep = (size_t)(BK * 2);
    const size_t hstep = (size_t)HALF * K * 2;
    const size_t tstep = 2 * hstep;
    const unsigned ldsw = (unsigned)wid * 1024u;
    const int aoff = lds_byte(wr * 64 + fr, fq * 8), boff = lds_byte(wc * 32 + fr, fq * 8);
#define PG8_SA(b, h) (((b) * 2 + (h)) * HTB)
#define PG8_SB(b, h) ((4 + (b) * 2 + (h)) * HTB)
#define PG8_STAGE(bufoff, gbase, voff) do { _Pragma("unroll") for (int _i = 0; _i < 2; ++_i) \
        __builtin_amdgcn_global_load_lds((const unsigned*)((const char*)(gbase) + (voff)[_i]), (LAS unsigned*)(lds + (bufoff) + ldsw + _i * 8192), 16, 0, 0); } while (0)
#define PG8_LDA(dst, b, h) do { _Pragma("unroll") for (int m = 0; m < 4; ++m) { \
        if constexpr (FP8) dst##8[m] = __builtin_shufflevector(*(const LAS v4i_t*)(lds + PG8_SA(b, h) + aoff + m * 2048), *(const LAS v4i_t*)(lds + PG8_SA(b, h) + aoff + m * 2048 + 1024), 0, 1, 2, 3, 4, 5, 6, 7); \
        else { _Pragma("unroll") for (int k = 0; k < 2; ++k) dst[m][k] = *(const LAS bf16x8*)(lds + PG8_SA(b, h) + aoff + m * 2048 + k * 1024); } } } while (0)
#define PG8_LDB(dst, b, h) do { _Pragma("unroll") for (int n = 0; n < 2; ++n) { \
        if constexpr (FP8) dst##8[n] = __builtin_shufflevector(*(const LAS v4i_t*)(lds + PG8_SB(b, h) + boff + n * 2048), *(const LAS v4i_t*)(lds + PG8_SB(b, h) + boff + n * 2048 + 1024), 0, 1, 2, 3, 4, 5, 6, 7); \
        else { _Pragma("unroll") for (int k = 0; k < 2; ++k) dst[n][k] = *(const LAS bf16x8*)(lds + PG8_SB(b, h) + boff + n * 2048 + k * 1024); } } } while (0)
#define PG8_MMA(ai, bj, At, Bt) do { __builtin_amdgcn_s_setprio(1); _Pragma("unroll") for (int m = 0; m < 4; ++m) _Pragma("unroll") for (int n = 0; n < 2; ++n) { \
        if constexpr (FP8) asm volatile("v_mfma_f32_16x16x128_f8f6f4 %0, %1, %2, %0" : "+v"(acc[ai][bj][m][n]) : "v"(Bt##8[n]), "v"(At##8[m]));   \
        else { _Pragma("unroll") for (int k = 0; k < 2; ++k) acc[ai][bj][m][n] = __builtin_amdgcn_mfma_f32_16x16x32_bf16(Bt[n][k], At[m][k], acc[ai][bj][m][n], 0, 0, 0); } } \
        __builtin_amdgcn_s_setprio(0); } while (0)
#define PG8_WAIT_V(n) asm volatile("s_waitcnt vmcnt(" #n ")" ::: "memory")
#define PG8_WAIT_L(n) asm volatile("s_waitcnt lgkmcnt(" #n ")" ::: "memory")
#define PG8_BAR __builtin_amdgcn_s_barrier()
#define PG8_SCHED __builtin_amdgcn_sched_barrier(0)
#define PG8_SETV(V, u) do { _Pragma("unroll") for (int _h = 0; _h < 2; ++_h) _Pragma("unroll") for (int _i = 0; _i < 2; ++_i) \
        V[_h][_i] = GATHER ? (unsigned)S.arow(u, _h * HALF + RA[_i]) * (unsigned)(K * 2) + (unsigned)(CA[_i] * 2) : (unsigned)(_h * (int)hstep) + (unsigned)(RA[_i] * K + CA[_i]) * 2u; } while (0)
    Unit cur, nxt; int ui = 0;
    if (!S.next(0, cur)) return;
    f32x4 acc[2][2][4][2];
#pragma unroll
    for (int a = 0; a < 2; ++a)
#pragma unroll
        for (int b = 0; b < 2; ++b)
#pragma unroll
            for (int m = 0; m < 4; ++m)
#pragma unroll
                for (int n = 0; n < 2; ++n) acc[a][b][m][n] = (f32x4){0.f, 0.f, 0.f, 0.f};
    bf16x8 At[4][2], B0[2][2], B1[2][2];
    v8i_t At8[4], B08[2], B18[2];
    unsigned vA[2][2], vN[2][2];
    PG8_SETV(vA, cur);
    if (GATHER) PG8_WAIT_V(0);
    int nt = cur.nkt;
    const char* cA = (GATHER ? (const char*)g.A : (const char*)g.A + (size_t)cur.pm * tstep) + (size_t)cur.kt0 * kstep; const char* cB = (const char*)g.Bt + (size_t)cur.pn * tstep + (size_t)cur.kt0 * kstep;
    PG8_STAGE(PG8_SB(0, 0), cB, voffB); PG8_STAGE(PG8_SB(0, 1), cB + hstep, voffB); PG8_STAGE(PG8_SA(0, 0), cA, vA[0]); PG8_STAGE(PG8_SA(0, 1), cA, vA[1]);
    if (wr == 1) PG8_BAR;
    PG8_WAIT_V(2); PG8_BAR;
    PG8_STAGE(PG8_SB(1, 0), cB + kstep, voffB); PG8_STAGE(PG8_SA(1, 0), cA + kstep, vA[0]); PG8_STAGE(PG8_SB(1, 1), cB + hstep + kstep, voffB);
    PG8_WAIT_V(6); PG8_BAR;
    for (;;) {
        const bool has_next = S.next(ui + 1, nxt);
        if constexpr (GATHER) {
            if (has_next) { PG8_SETV(vN, nxt); }
            else {
#pragma unroll
                for (int h = 0; h < 2; ++h)
#pragma unroll
                    for (int i = 0; i < 2; ++i) vN[h][i] = vA[h][i]; }
        }
        const char* nA = has_next ? (GATHER ? (const char*)g.A : (const char*)g.A + (size_t)nxt.pm * tstep) + (size_t)nxt.kt0 * kstep : cA; const char* nB = has_next ? (const char*)g.Bt + (size_t)nxt.pn * tstep + (size_t)nxt.kt0 * kstep : cB;
        for (int t = 0; t < nt; t += 2) {
            const bool last = (t == nt - 2);
            const char* a1 = cA + (size_t)(t + 1) * kstep;
            const char* a2 = last ? nA : cA + (size_t)(t + 2) * kstep; const char* b2 = last ? nB : cB + (size_t)(t + 2) * kstep;
            const char* a3 = a2 + kstep; const char* b3 = b2 + kstep;
            unsigned w0[2], w1[2];
#pragma unroll
            for (int i = 0; i < 2; ++i) { w0[i] = (GATHER && last) ? vN[0][i] : vA[0][i]; w1[i] = (GATHER && last) ? vN[1][i] : vA[1][i]; }
            PG8_LDB(B0, 0, 0); PG8_LDB(B1, 0, 1); PG8_SCHED; PG8_LDA(At, 0, 0); PG8_STAGE(PG8_SA(1, 1), a1, vA[1]);
            PG8_WAIT_V(8); PG8_WAIT_L(0); PG8_BAR; PG8_MMA(0, 0, At, B0); PG8_MMA(0, 1, At, B1); PG8_BAR; PG8_SCHED;
            PG8_LDA(At, 0, 1); PG8_STAGE(PG8_SB(0, 0), b2, voffB); PG8_STAGE(PG8_SB(0, 1), b2 + hstep, voffB); PG8_STAGE(PG8_SA(0, 0), a2, w0);
            PG8_WAIT_V(8); PG8_WAIT_L(0); PG8_BAR; PG8_MMA(1, 0, At, B0); PG8_MMA(1, 1, At, B1); PG8_BAR; PG8_SCHED;
            PG8_LDB(B0, 1, 0); PG8_LDB(B1, 1, 1); PG8_SCHED; PG8_LDA(At, 1, 0); PG8_STAGE(PG8_SA(0, 1), a2, w1);
            PG8_WAIT_V(8); PG8_WAIT_L(0); PG8_BAR; PG8_MMA(0, 0, At, B0); PG8_MMA(0, 1, At, B1); PG8_BAR; PG8_SCHED;
            PG8_LDA(At, 1, 1); PG8_STAGE(PG8_SB(1, 0), b3, voffB); PG8_STAGE(PG8_SB(1, 1), b3 + hstep, voffB); PG8_STAGE(PG8_SA(1, 0), a3, w0);
            PG8_WAIT_V(8); PG8_WAIT_L(0); PG8_BAR; PG8_MMA(1, 0, At, B0); PG8_MMA(1, 1, At, B1); PG8_BAR; PG8_SCHED;
        }
        if constexpr (ALIGN_EPI) { if (wr == 0) PG8_BAR; }
        if constexpr (FP8) asm volatile("s_nop 15\n\ts_nop 15" ::: "memory");
        E(acc, cur, wr, wc, fr, fq);
        if (!has_next) break;
#pragma unroll
        for (int a = 0; a < 2; ++a)
#pragma unroll
            for (int b = 0; b < 2; ++b)
#pragma unroll
                for (int m = 0; m < 4; ++m)
#pragma unroll
                    for (int n = 0; n < 2; ++n) acc[a][b][m][n] = (f32x4){0.f, 0.f, 0.f, 0.f};
        cur = nxt; cA = nA; cB = nB; ++ui; nt = cur.nkt;
        if constexpr (GATHER) {
#pragma unroll
            for (int h = 0; h < 2; ++h)
#pragma unroll
                for (int i = 0; i < 2; ++i) vA[h][i] = vN[h][i]; }
        if constexpr (ALIGN_EPI) { if (wr == 1) PG8_BAR; }
    }
    PG8_WAIT_V(0);
    if constexpr (!ALIGN_EPI) { if (wr == 0) PG8_BAR; }
    PG8_BAR;
#undef PG8_SA
#undef PG8_SB
#undef PG8_STAGE
#undef PG8_LDA
#undef PG8_LDB
#undef PG8_MMA
#undef PG8_WAIT_V
#undef PG8_WAIT_L
#undef PG8_BAR
#undef PG8_SCHED
#undef PG8_SETV
}
}
DI f32x4 ld_bf4(const bf16_t* p) { const u32x2 a = *(const u32x2*)p; f32x4 r; r.x = __uint_as_float(a.x << 16); r.y = __uint_as_float(a.x & 0xffff0000u); r.z = __uint_as_float(a.y << 16); r.w = __uint_as_float(a.y & 0xffff0000u); return r; }
struct Cx { LAS unsigned char* lds; int tid, lane, wave, vcu, G; };
DI Cx fresh(const Cx& c0) { Cx c; int g = c0.G, v = c0.vcu, w = c0.wave; asm volatile("" : "+s"(g), "+s"(v), "+s"(w));
    const int ln = lane_id_fresh();
    c.lds = c0.lds; c.wave = w; c.lane = ln; c.tid = w * 64 + ln; c.vcu = v; c.G = g; return c; }

template <bool WINPERM = false>
DI void tcvt_item(const float* W, int K, int N, bf16_t* WT, int rstride, int roff, LAS float* scr, int item, int lane) {
    const int nblk = N / 32, kb = item / nblk, nb = item % nblk, k0 = 64 * kb, n0 = 32 * nb;
#pragma unroll 8
    for (int i = 0; i < 32; ++i) { const int kk = 2 * i + (lane >> 5); scr[kk * 33 + (lane & 31)] = W[(size_t)(k0 + kk) * N + n0 + (lane & 31)]; }
    asm volatile("s_waitcnt lgkmcnt(0)" ::: "memory");
    const int c = lane & 7;
#pragma unroll
    for (int j = 0; j < 4; ++j) { const int n = (lane >> 3) + 8 * j; const LAS float* s = scr + (8 * c) * 33 + n;
        u32x4 o; o.x = pk2(s[0 * 33], s[1 * 33]); o.y = pk2(s[2 * 33], s[3 * 33]); o.z = pk2(s[4 * 33], s[5 * 33]); o.w = pk2(s[6 * 33], s[7 * 33]);
        const int ncol = WINPERM ? pg8::win_col_pos(n0 + n) : n0 + n, drow = (ncol >> 7) * rstride + roff + (ncol & 127);
        *(u32x4*)(WT + (size_t)drow * K + k0 + 8 * c) = o; }
    asm volatile("s_waitcnt lgkmcnt(0)" ::: "memory");
}
DI void tcvt_item8(const float* W, int K, int N, unsigned char* WT, int rstride, int roff, LAS float* scr, int item, int lane) {
    const int nblk = N / 32, kb = item / nblk, nb = item % nblk, k0 = 64 * kb, n0 = 32 * nb;
#pragma unroll 8
    for (int i = 0; i < 32; ++i) { const int kk = 2 * i + (lane >> 5); scr[kk * 33 + (lane & 31)] = W[(size_t)(k0 + kk) * N + n0 + (lane & 31)]; }
    asm volatile("s_waitcnt lgkmcnt(0)" ::: "memory");
    const int c = lane & 7;
#pragma unroll
    for (int j = 0; j < 4; ++j) { const int n = (lane >> 3) + 8 * j; const LAS float* s = scr + (8 * c) * 33 + n;
        u32x2 o; o.x = pg8::pk4_fp8(s[0 * 33] * W8_SCALE, s[1 * 33] * W8_SCALE, s[2 * 33] * W8_SCALE, s[3 * 33] * W8_SCALE); o.y = pg8::pk4_fp8(s[4 * 33] * W8_SCALE, s[5 * 33] * W8_SCALE, s[6 * 33] * W8_SCALE, s[7 * 33] * W8_SCALE);
        const int ncol = n0 + n, drow = (ncol >> 7) * rstride + roff + (ncol & 127);
        *(u32x2*)(WT + (size_t)drow * K + k0 + 8 * c) = o; }
    asm volatile("s_waitcnt lgkmcnt(0)" ::: "memory");
}
constexpr int I_IN = 16 * 96, I_OUT = 16 * 32, I_FG = 16 * 88, I_FD = 44 * 32, I_MG = 16 * 112, I_MD = 56 * 32, MOE_ITEMS = 16 * I_MG + 8 * I_MD;
constexpr int BG_N = 6;
constexpr int bg_cu0(int w) { return w == 0 ? 24 : w == 1 ? 32 : w == 2 ? 172 : w == 3 ? 24 : w == 4 ? 168 : 128; }
constexpr int bg_pw(int w) { return w == 0 ? 5 : w == 1 ? 2 : w == 2 ? 8 : w == 3 ? 5 : 2; }
constexpr int bg_count(int w) { return (256 - bg_cu0(w)) * NWAVES * bg_pw(w); }
constexpr int bg_base(int w) { return w >= BG_N ? MOE_ITEMS : bg_base(w + 1) - bg_count(w); }
DI void moe_item(const Params& p, LAS float* scr, int r, int lane) {
    unsigned char* ws = p.ws;
    if (r < 16 * I_MG) { const int q = r / I_MG, u = q >> 3, e = q & 7;
        tcvt_item8((u ? p.moe_wu : p.moe_wg) + (size_t)e * D * ED, D, ED, ws + OFF_MGU + (size_t)e * 2 * ED * D, 256, u * 128, scr, r % I_MG, lane); return; }
    r -= 16 * I_MG;
    { const int e = r / I_MD; tcvt_item8(p.moe_wd + (size_t)e * ED * D, ED, D, ws + OFF_MD + (size_t)e * D * ED, 128, 0, scr, r % I_MD, lane); }
}
template <int W>
DI void bg_convert(const Params& p, const Cx& c0) {
    constexpr int CU0 = bg_cu0(W), PW = bg_pw(W), BASE = bg_base(W);
    if (c0.G != 256) return;
    const int bid = (int)blockIdx.x;
    if (bid < CU0) return;
    const Cx c = fresh(c0);
    LAS float* scr = (LAS float*)(c.lds + c.wave * 16384);
    const int first = BASE + ((bid - CU0) * NWAVES + c.wave) * PW;
    for (int k = 0; k < PW; ++k) moe_item(p, scr, first + k, c.lane);
}
DI void phase_convert(const Params& p, const Cx& c0) {
    const Cx c = fresh(c0);
    LAS float* scr = (LAS float*)(c.lds + c.wave * 16384);
    unsigned char* ws = p.ws;
    const int gw = c.vcu * NWAVES + c.wave, NGW = c.G * NWAVES;
    constexpr int NFIX = 2 * I_IN + 2 * I_OUT + 2 * I_FG + I_FD;
    constexpr int MOE_PRO = bg_base(0);
    const int NITEMS = NFIX + (c.G == 256 ? MOE_PRO : MOE_ITEMS);
    for (int it = gw; it < NITEMS; it += NGW) {
        int r = it;
        if (r < 2 * I_IN) { const int l = r / I_IN; tcvt_item<true>(p.w_in + (size_t)l * D * INW, D, INW, (bf16_t*)(ws + OFF_WIN) + (size_t)l * INW * D, 128, 0, scr, r % I_IN, c.lane); continue; } r -= 2 * I_IN;
        if (r < 2 * I_OUT) { const int l = r / I_OUT; tcvt_item(p.w_out + (size_t)l * D * D, D, D, (bf16_t*)(ws + OFF_WOUT) + (size_t)l * D * D, 128, 0, scr, r % I_OUT, c.lane); continue; } r -= 2 * I_OUT;
        if (r < 2 * I_FG) { const int u = r / I_FG; tcvt_item8(u ? p.ffn_wu : p.ffn_wg, D, FF, ws + OFF_WGU, 256, u * 128, scr, r % I_FG, c.lane); continue; } r -= 2 * I_FG;
        if (r < I_FD) { tcvt_item8(p.ffn_wd, FF, D, ws + OFF_WD, 128, 0, scr, r, c.lane); continue; } r -= I_FD;
        moe_item(p, scr, r, c.lane);
    }
}
DI void phase_mod(const Params& p, const Cx& c0) {
    const Cx c = fresh(c0);
    for (int i = c.vcu * NTHREADS + c.tid; i < 128 * 24; i += c.G * NTHREADS) {
        const int pos = i / 24, e = i % 24;
        const float inv = e < 8 ? powf(10000.f, -(float)e * 2.0f / 16.0f) : powf(10000.f, -(float)(e - 8) * 2.0f / 32.0f);
        float sn, cs; sincosf((float)pos * inv, &sn, &cs);
        ((float2*)(p.ws + OFF_ROPE))[i] = make_float2(cs, sn);
    }
    LAS float* red = (LAS float*)(c.lds);
    LAS float* sl = red + 8 * 48 * 3;
    __syncthreads();
    for (int i = c.tid; i < 3 * 1024; i += NTHREADS) sl[i] = silu_f(i < 1024 ? p.c[i] : i < 2048 ? p.c[i] : p.c_ctx[i - 2048]);
    for (int cb = c.vcu; cb < 256; cb += c.G) {
        __syncthreads();
        if (c.tid < 384) {
            const int cl = c.tid % 48, kg = c.tid / 48, gc = cb * 48 + cl, layer = gc / 6144, col = gc % 6144;
            const float* w = p.w_mod + (size_t)layer * D * 6144 + col;
            float a0 = 0.f, a1 = 0.f, a2 = 0.f;
#pragma unroll 16
            for (int k = kg * 128; k < kg * 128 + 128; ++k) { const float wv = w[(size_t)k * 6144]; a0 += sl[k] * wv; a1 += sl[1024 + k] * wv; a2 += sl[2048 + k] * wv; }
            red[(kg * 48 + cl) * 3 + 0] = a0; red[(kg * 48 + cl) * 3 + 1] = a1; red[(kg * 48 + cl) * 3 + 2] = a2;
        }
        __syncthreads();
        if (c.tid < 144) {
            const int cl = c.tid % 48, v = c.tid / 48, gc = cb * 48 + cl, layer = gc / 6144, col = gc % 6144;
            float s = p.b_mod[layer * 6144 + col];
#pragma unroll
            for (int kg = 0; kg < 8; ++kg) s += red[(kg * 48 + cl) * 3 + v];
            ((float*)(p.ws + OFF_MOD))[(size_t)(layer * 3 + v) * 6144 + col] = s;
        }
    }
    __syncthreads();
}
DI void phase_norm1(const Params& p, const Cx& c0, int layer) {
    const Cx c = fresh(c0);
    const int gw = c.vcu * NWAVES + c.wave, NGW = c.G * NWAVES;
    f32x4 v[4], vn[4];
    if (gw < T) { const f32x4* xr = (const f32x4*)xin0_row(p, gw) + c.lane;
#pragma unroll
        for (int j = 0; j < 4; ++j) v[j] = xr[64 * j]; }
    for (int row = gw; row < T; row += NGW) {
        if (row + NGW < T) { const f32x4* xn = (const f32x4*)xin0_row(p, row + NGW) + c.lane;
#pragma unroll
            for (int j = 0; j < 4; ++j) vn[j] = xn[64 * j]; }
        float s = 0.f;
#pragma unroll
        for (int j = 0; j < 4; ++j) s += (v[j].x * v[j].x + v[j].y * v[j].y) + (v[j].z * v[j].z + v[j].w * v[j].w);
        const float r = rsqrtf(wave_sum(s, c.lane) * (1.f / D) + EPS);
        const float* mod = mod_row(p, layer, row);
        const float* g = p.g_attn_pre + layer * D;
        bf16_t* h = (bf16_t*)(p.ws + OFF_H) + (size_t)row * D;
#pragma unroll
        for (int j = 0; j < 4; ++j) { const int idx = (c.lane + 64 * j) * 4;
            const f32x4 gg = *(const f32x4*)(g + idx), sh = *(const f32x4*)(mod + idx), sc = *(const f32x4*)(mod + 1024 + idx);
            const f32x4 o = v[j] * r * gg * (sc + 1.f) + sh;
            uint2 w; w.x = pk2(o.x, o.y); w.y = pk2(o.z, o.w); *(uint2*)(h + idx) = w; }
#pragma unroll
        for (int j = 0; j < 4; ++j) v[j] = vn[j];
    }
}
DI int ret_row(int b, int n) { return n < 2 ? TX + b * CTXL + n * 128 : b * SEQ + (n - 2) * 128; }
DI float logsig(float g) { return -log1pf(expf(-g)); }

DI void phase_post_attn(const Params& p, const Cx& c0, int layer) {
    const Cx c = fresh(c0);
    const int gw = c.vcu * NWAVES + c.wave, NGW = c.G * NWAVES, rows = layer == 0 ? T : TX;
    constexpr int RT_MAXSEL = 512;
    LAS int* rsel = (LAS int*)(c.lds + c.wave * (RT_MAXSEL * 16 + 64));
    int nsel = 0;
    f32x4 y[4], x1[4], yn[4], xn[4];
    auto load_row = [&](int row, f32x4 (&yy)[4], f32x4 (&xx)[4]) {
        const bf16_t* yr = (const bf16_t*)(p.ws + OFF_B) + (size_t)row * D + c.lane * 4;
        const f32x4* xr = (const f32x4*)xin0_row(p, row) + c.lane;
        const bf16_t* xsr = (const bf16_t*)(p.ws + OFF_XS) + (size_t)row * D;
#pragma unroll
        for (int j = 0; j < 4; ++j) {
            if (layer == 0 && row >= TX) { const float* sl = (const float*)(p.ws + OFF_B + B_SLAB_Y) + (size_t)(row - TX) * D + (c.lane + 64 * j) * 4;
                yy[j] = *(const f32x4*)sl;
#pragma unroll
                for (int k = 1; k < WOUT_SPLIT; ++k) yy[j] = yy[j] + *(const f32x4*)(sl + (size_t)k * TC * D); }
            else yy[j] = ld_bf4(yr + 256 * j);
            xx[j] = layer == 0 ? xr[64 * j] : ld_bf4(xsr + (c.lane + 64 * j) * 4); }
    };
    if (gw < rows) load_row(gw, y, x1);
    for (int row = gw; row < rows; row += NGW) {
        if (row + NGW < rows) load_row(row + NGW, yn, xn);
        bf16_t* xs = (bf16_t*)(p.ws + OFF_XS) + (size_t)row * D;
        float s = 0.f;
#pragma unroll
        for (int j = 0; j < 4; ++j) s += (y[j].x * y[j].x + y[j].y * y[j].y) + (y[j].z * y[j].z + y[j].w * y[j].w);
        const float r = rsqrtf(wave_sum(s, c.lane) * (1.f / D) + EPS);
        const float* mod = mod_row(p, layer, row);
        float s2 = 0.f;
#pragma unroll
        for (int j = 0; j < 4; ++j) { const int idx = (c.lane + 64 * j) * 4;
            const f32x4 gp = *(const f32x4*)(p.g_attn_post + layer * D + idx), gt = *(const f32x4*)(mod + 2048 + idx);
            x1[j] = x1[j] + gt * (y[j] * r * gp);
            { u32x2 w; w.x = pk2(x1[j].x, x1[j].y); w.y = pk2(x1[j].z, x1[j].w); *(u32x2*)(xs + idx) = w; }
            s2 += (x1[j].x * x1[j].x + x1[j].y * x1[j].y) + (x1[j].z * x1[j].z + x1[j].w * x1[j].w); }
        const float r2 = rsqrtf(wave_sum(s2, c.lane) * (1.f / D) + EPS);
        bf16_t* h = (bf16_t*)(p.ws + OFF_H) + (size_t)row * D;
        float l8[8];
#pragma unroll
        for (int e = 0; e < 8; ++e) l8[e] = 0.f;
#pragma unroll
        for (int j = 0; j < 4; ++j) { const int idx = (c.lane + 64 * j) * 4;
            const f32x4 g2 = *(const f32x4*)(p.g_ffn_pre + layer * D + idx), sh = *(const f32x4*)(mod + 3072 + idx), sc = *(const f32x4*)(mod + 4096 + idx);
            const f32x4 hv = x1[j] * r2 * g2 * (sc + 1.f) + sh;
            *(unsigned*)(p.ws + OFF_H8 + (size_t)row * D + idx) = pg8::pk4_fp8(pg8::clamp8(hv.x), pg8::clamp8(hv.y), pg8::clamp8(hv.z), pg8::clamp8(hv.w));
            if (layer == 1) {
#pragma unroll
                for (int i = 0; i < 4; ++i) { const f32x4 ra = *(const f32x4*)(p.router + (size_t)(idx + i) * 8), rb = *(const f32x4*)(p.router + (size_t)(idx + i) * 8 + 4);
                    const float hh = hv[i];
                    l8[0] += hh * ra.x; l8[1] += hh * ra.y; l8[2] += hh * ra.z; l8[3] += hh * ra.w; l8[4] += hh * rb.x; l8[5] += hh * rb.y; l8[6] += hh * rb.z; l8[7] += hh * rb.w; }
            } }
        if (layer == 1) {
#pragma unroll
            for (int e = 0; e < 8; ++e) l8[e] = wave_sum(l8[e], c.lane);
            if (c.lane == 0) {
                int i0 = 0; float v0 = l8[0];
#pragma unroll
                for (int e = 1; e < 8; ++e) if (l8[e] > v0) { v0 = l8[e]; i0 = e; }
                int i1 = -1; float v1 = -3.0e38f;
#pragma unroll
                for (int e = 0; e < 8; ++e) if (e != i0 && l8[e] > v1) { v1 = l8[e]; i1 = e; }
                const float e1 = expf(v1 - v0); const float w0 = 1.f / (1.f + e1), w1 = e1 / (1.f + e1);
                if (nsel < RT_MAXSEL) { rsel[nsel * 4] = row; rsel[nsel * 4 + 1] = i0 | (i1 << 8); rsel[nsel * 4 + 2] = __float_as_int(w0); rsel[nsel * 4 + 3] = __float_as_int(w1); }
            }
            ++nsel;
        }
#pragma unroll
        for (int j = 0; j < 4; ++j) { y[j] = yn[j]; x1[j] = xn[j]; }
    }
    if (layer == 1) {
        asm volatile("s_waitcnt lgkmcnt(0)" ::: "memory");
        unsigned* cnt = (unsigned*)(p.ws + OFF_CNT);
        int* tl = (int*)(p.ws + OFF_TLIST); int* te = (int*)(p.ws + OFF_TOKE); int* tj = (int*)(p.ws + OFF_TOKJ); float* tw = (float*)(p.ws + OFF_TOKW);
        LAS int* rbase = rsel + RT_MAXSEL * 4;
        if (c.lane < 8) { int n = 0;
            for (int k = 0; k < nsel; ++k) { const int ee = rsel[k * 4 + 1]; n += ((ee & 255) == c.lane) + ((ee >> 8) == c.lane); }
            rbase[c.lane] = n > 0 ? (int)atomicAdd(&cnt[c.lane], (unsigned)n) : 0; }
        asm volatile("s_waitcnt vmcnt(0) lgkmcnt(0)" ::: "memory");
        if (c.lane == 0) {
            for (int k = 0; k < nsel; ++k) { const int row = rsel[k * 4], ee = rsel[k * 4 + 1], i0 = ee & 255, i1 = ee >> 8;
                const int j0 = rbase[i0]; rbase[i0] = j0 + 1; const int j1 = rbase[i1]; rbase[i1] = j1 + 1;
                tl[i0 * 16384 + j0] = row; tl[i1 * 16384 + j1] = row;
                te[row * 2] = i0; te[row * 2 + 1] = i1; tj[row * 2] = j0; tj[row * 2 + 1] = j1; tw[row * 2] = __int_as_float(rsel[k * 4 + 2]); tw[row * 2 + 1] = __int_as_float(rsel[k * 4 + 3]); }
        }
    }
}
DI void phase_post_ffn(const Params& p, const Cx& c0, int layer) {
    const Cx c = fresh(c0);
    const int gw = c.vcu * NWAVES + c.wave, NGW = c.G * NWAVES, rows = layer == 0 ? T : TX;
    int off[8];
    if (layer == 1) { const unsigned* cnt = (const unsigned*)(p.ws + OFF_CNT); int a = 0;
#pragma unroll
        for (int e = 0; e < 8; ++e) { off[e] = a; a += ((int)cnt[e] + 255) & ~255; } }
    f32x4 f[4], xr1[4], fn[4], xn[4];
    u32x2 ea[4], eb_[4], ean[4], ebn[4]; float mw0 = 0.f, mw1 = 0.f, mw0n = 0.f, mw1n = 0.f; int ms0 = 0, ms1 = 0; float mq0 = 0.f, mq1 = 0.f;
    auto load_meta = [&](int row) {
        const int* te = (const int*)(p.ws + OFF_TOKE); const int* tj = (const int*)(p.ws + OFF_TOKJ); const float* tw = (const float*)(p.ws + OFF_TOKW);
        const int e0 = te[row * 2], e1 = te[row * 2 + 1];
        int s0 = 0, s1 = 0;
#pragma unroll
        for (int e = 0; e < 8; ++e) { if (e0 == e) s0 = off[e]; if (e1 == e) s1 = off[e]; }
        ms0 = s0 + tj[row * 2]; ms1 = s1 + tj[row * 2 + 1]; mq0 = tw[row * 2]; mq1 = tw[row * 2 + 1];
    };
    auto load_row1 = [&](int row, u32x2 (&a)[4], u32x2 (&b)[4], float& w0, float& w1, f32x4 (&xx)[4]) {
        const bf16_t* xsr = (const bf16_t*)(p.ws + OFF_XS) + (size_t)row * D;
        const bf16_t* O = (const bf16_t*)(p.ws + OFF_B);
#pragma unroll
        for (int j = 0; j < 4; ++j) { const int idx = (c.lane + 64 * j) * 4; xx[j] = ld_bf4(xsr + idx); a[j] = *(const u32x2*)(O + (size_t)ms0 * D + idx); b[j] = *(const u32x2*)(O + (size_t)ms1 * D + idx); }
        w0 = mq0; w1 = mq1;
    };
    auto load_row = [&](int row, f32x4 (&f)[4], f32x4 (&xx)[4]) {
        const bf16_t* xsr = (const bf16_t*)(p.ws + OFF_XS) + (size_t)row * D;
#pragma unroll
        for (int j = 0; j < 4; ++j) xx[j] = ld_bf4(xsr + (c.lane + 64 * j) * 4);
        if (layer == 0) {
            const bf16_t* fr = (const bf16_t*)(p.ws + OFF_B) + (size_t)row * D + c.lane * 4;
#pragma unroll
            for (int j = 0; j < 4; ++j) {
                if (row >= TX) { const float* sl = (const float*)(p.ws + OFF_B + B_SLAB_F) + (size_t)(row - TX) * D + (c.lane + 64 * j) * 4;
                    f[j] = *(const f32x4*)sl;
#pragma unroll
                    for (int k = 1; k < FFD_SPLIT; ++k) f[j] = f[j] + *(const f32x4*)(sl + (size_t)k * TC * D); }
                else f[j] = ld_bf4(fr + 256 * j); }
        } else {
            const int* te = (const int*)(p.ws + OFF_TOKE); const int* tj = (const int*)(p.ws + OFF_TOKJ); const float* tw = (const float*)(p.ws + OFF_TOKW);
            const int e0 = te[row * 2], e1 = te[row * 2 + 1];
            int s0 = 0, s1 = 0;
#pragma unroll
            for (int e = 0; e < 8; ++e) { if (e0 == e) s0 = off[e]; if (e1 == e) s1 = off[e]; }
            s0 += tj[row * 2]; s1 += tj[row * 2 + 1];
            const float w0 = tw[row * 2], w1 = tw[row * 2 + 1];
            const bf16_t* O = (const bf16_t*)(p.ws + OFF_B);
#pragma unroll
            for (int j = 0; j < 4; ++j) { const int idx = (c.lane + 64 * j) * 4;
                const f32x4 a = ld_bf4(O + (size_t)s0 * D + idx), bq = ld_bf4(O + (size_t)s1 * D + idx);
                f[j] = a * w0 + bq * w1; }
        }
    };
    if (layer == 0) { if (gw < rows) load_row(gw, f, xr1); }
    else if (gw < rows) { load_meta(gw); load_row1(gw, ea, eb_, mw0, mw1, xr1); if (gw + NGW < rows) load_meta(gw + NGW); }
    for (int row = gw; row < rows; row += NGW) {
        if (layer == 0) { if (row + NGW < rows) load_row(row + NGW, fn, xn); }
        else {
            if (row + NGW < rows) load_row1(row + NGW, ean, ebn, mw0n, mw1n, xn);
            if (row + 2 * NGW < rows) load_meta(row + 2 * NGW);
#pragma unroll
            for (int j = 0; j < 4; ++j) { const u32x2 a = ea[j], b = eb_[j];
                f[j] = (f32x4){__uint_as_float(a.x << 16), __uint_as_float(a.x & 0xffff0000u), __uint_as_float(a.y << 16), __uint_as_float(a.y & 0xffff0000u)} * mw0
                     + (f32x4){__uint_as_float(b.x << 16), __uint_as_float(b.x & 0xffff0000u), __uint_as_float(b.y << 16), __uint_as_float(b.y & 0xffff0000u)} * mw1; }
        }
        float s = 0.f;
#pragma unroll
        for (int j = 0; j < 4; ++j) s += (f[j].x * f[j].x + f[j].y * f[j].y) + (f[j].z * f[j].z + f[j].w * f[j].w);
        const float r = rsqrtf(wave_sum(s, c.lane) * (1.f / D) + EPS);
        const float* mod = mod_row(p, layer, row);
        bf16_t* xs = (bf16_t*)(p.ws + OFF_XS) + (size_t)row * D;
        float s3 = 0.f;
#pragma unroll
        for (int j = 0; j < 4; ++j) { const int idx = (c.lane + 64 * j) * 4;
            const f32x4 g = *(const f32x4*)(p.g_ffn_post + layer * D + idx), gt = *(const f32x4*)(mod + 5120 + idx), x1 = xr1[j];
            f[j] = x1 + gt * (f[j] * r * g);
            if (layer == 0) { u32x2 w; w.x = pk2(f[j].x, f[j].y); w.y = pk2(f[j].z, f[j].w); *(u32x2*)(xs + idx) = w; } else *(f32x4*)(p.out + (size_t)row * D + idx) = f[j];
            s3 += (f[j].x * f[j].x + f[j].y * f[j].y) + (f[j].z * f[j].z + f[j].w * f[j].w); }
        if (layer == 0) {
            const float r3 = rsqrtf(wave_sum(s3, c.lane) * (1.f / D) + EPS);
            const float* mod1 = mod_row(p, 1, row);
            bf16_t* h = (bf16_t*)(p.ws + OFF_H) + (size_t)row * D;
#pragma unroll
            for (int j = 0; j < 4; ++j) { const int idx = (c.lane + 64 * j) * 4;
                const f32x4 gg = *(const f32x4*)(p.g_attn_pre + D + idx), sh = *(const f32x4*)(mod1 + idx), sc = *(const f32x4*)(mod1 + 1024 + idx);
                const f32x4 o = f[j] * r3 * gg * (sc + 1.f) + sh;
                u32x2 w; w.x = pk2(o.x, o.y); w.y = pk2(o.z, o.w); *(u32x2*)(h + idx) = w; }
        }
#pragma unroll
        for (int j = 0; j < 4; ++j) { xr1[j] = xn[j]; if (layer == 0) f[j] = fn[j]; else { ea[j] = ean[j]; eb_[j] = ebn[j]; } }
        mw0 = mw0n; mw1 = mw1n;
    }
}
DI int key_row(int b, int u) { return u < CTXL ? TX + b * CTXL + u : b * SEQ + u - CTXL; }
DI void phase_ret_u_mfma(const Params& p, const Cx& c0, int layer) {
    const Cx c = fresh(c0);
    const int lane = c.lane, wave = c.wave, l31 = lane & 31, hi = lane >> 5;
    const bf16_t* P = (const bf16_t*)(p.ws + OFF_A + A_P);
    float* U = (float*)(p.ws + OFF_A + A_U);
    LAS bf16_t* VL = (LAS bf16_t*)c.lds + 3 * 64 * 136;
    LAS bf16_t* KT = (LAS bf16_t*)c.lds;
    const int nunits = NB * 4 * (NCH / 3);
    const float LOG2E = 1.4426950408889634f;
    for (int unit = c.vcu; unit < nunits; unit += c.G) {
        const int n3 = unit % (NCH / 3), h = (unit / (NCH / 3)) & 3, b = unit / ((NCH / 3) * 4);
        __syncthreads();
#pragma unroll
        for (int cc = 0; cc < 3; ++cc) { const int row0 = ret_row(b, 3 * n3 + cc);
#pragma unroll
            for (int ps = 0; ps < 2; ++ps) { const int j = ps * 64 + (c.tid >> 3), ch = c.tid & 7;
                const u32x4 v = *(const u32x4*)(P + (size_t)(row0 + j) * INW + RT_K + h * 64 + ch * 8);
#pragma unroll
                for (int e = 0; e < 4; ++e) { KT[cc * 64 * 136 + (ch * 8 + 2 * e) * 136 + j] = (bf16_t)(v[e] & 0xffffu); KT[cc * 64 * 136 + (ch * 8 + 2 * e + 1) * 136 + j] = (bf16_t)(v[e] >> 16); }
                const u32x4 vv = *(const u32x4*)(P + (size_t)(row0 + j) * INW + RT_V + h * 64 + ch * 8);
#pragma unroll
                for (int e = 0; e < 4; ++e) { VL[cc * 64 * 136 + (ch * 8 + 2 * e) * 136 + j] = (bf16_t)(vv[e] & 0xffffu); VL[cc * 64 * 136 + (ch * 8 + 2 * e + 1) * 136 + j] = (bf16_t)(vv[e] >> 16); } } }
        __syncthreads();
        const int eb = wave & 1, db = (wave >> 1) & 1, dir = wave >> 2;
        const float lg2 = logsig(dir ? p.gam_b[layer * 4 + h] : p.gam_f[layer * 4 + h]) * LOG2E;
#pragma unroll
        for (int cc = 0; cc < 3; ++cc) { const int n = 3 * n3 + cc;
            const LAS bf16_t* vrow = VL + cc * 64 * 136 + (eb * 32 + l31) * 136 + hi * 8;
            f32x16 acc;
#pragma unroll
            for (int r = 0; r < 16; ++r) acc[r] = 0.f;
#pragma unroll
            for (int s = 0; s < 8; ++s) {
                const bf16x8 af = *(const LAS bf16x8*)(vrow + s * 16);
                const u32x4 kv = *(const LAS u32x4*)(KT + cc * 64 * 136 + (db * 32 + l31) * 136 + s * 16 + hi * 8);
                u32x4 kw;
#pragma unroll
                for (int e = 0; e < 4; ++e) { const int j = s * 16 + hi * 8 + 2 * e;
                    const float w0 = __builtin_amdgcn_exp2f((float)(dir ? j : 127 - j) * lg2), w1 = __builtin_amdgcn_exp2f((float)(dir ? j + 1 : 126 - j) * lg2);
                    kw[e] = pk2(__uint_as_float(kv[e] << 16) * w0, __uint_as_float(kv[e] & 0xffff0000u) * w1); }
                acc = MFMA32(af, __builtin_bit_cast(bf16x8, kw), acc);
            }
            float* Uo = U + ((size_t)((b * 4 + h) * 2 + dir) * NCH + n) * 4096 + db * 32 + l31;
#pragma unroll
            for (int r = 0; r < 16; ++r) Uo[(eb * 32 + (r & 3) + 8 * (r >> 2) + 4 * hi) * 64] = acc[r] * 0.125f;
        }
    }
    __syncthreads();
}
DI void phase_ret_scan2(const Params& p, const Cx& c0, int layer) {
    const Cx c = fresh(c0);
    const float* U = (const float*)(p.ws + OFF_A + A_U);
    bf16_t* S = (bf16_t*)(p.ws + OFF_A + A_S);
    for (int gid = c.vcu * NTHREADS + c.tid; gid < NB * 4 * 2 * 4096; gid += c.G * NTHREADS) {
        const int de = gid & 4095, dir = (gid >> 12) & 1, h = (gid >> 13) & 3;
        const size_t base = (size_t)(gid >> 12) * NCH * 4096 + de;
        const float lg = logsig(dir ? p.gam_b[layer * 4 + h] : p.gam_f[layer * 4 + h]);
        const float gch = expf(128.f * lg);
        float s = 0.f;
#pragma unroll
        for (int i0 = 0; i0 < NCH; i0 += 33) {
            float u[33];
#pragma unroll
            for (int k = 0; k < 33; ++k) { const int i = i0 + k, n = dir == 0 ? i : (i < 2 ? 1 - i : 67 - i); u[k] = U[base + (size_t)n * 4096]; }
#pragma unroll
            for (int k = 0; k < 33; ++k) { const int i = i0 + k, n = dir == 0 ? i : (i < 2 ? 1 - i : 67 - i); S[base + (size_t)n * 4096] = f2bf(s); s = gch * s + u[k]; }
        }
    }
}
constexpr int RO_KP = 144, RO_VP = 272, RO_K = 0, RO_V = 128 * RO_KP, RO_S = RO_V + 64 * RO_VP, RO_HALF = RO_S + 128 * RO_KP;
template <bool CTXU>
DI void phase_ret_out_mfma(const Params& p, const Cx& c0, int layer, int n0, int first_blk = 0) {
    const Cx c = fresh(c0);
    const int lane = c.lane, l31 = lane & 31, hi = lane >> 5, half = c.wave >> 2, ht = (c.wave & 3) * 64 + lane;
    const bf16_t* P = (const bf16_t*)(p.ws + OFF_A + A_P);
    const bf16_t* ST = (const bf16_t*)(p.ws + OFF_A + A_S);
    bf16_t* YC = (bf16_t*)(p.ws + OFF_H);
    const float* U = (const float*)(p.ws + OFF_A + A_U);
    const int nn = CTXU ? 2 : NCH - n0, nunits = NB * 4 * nn * 4, NGW = c.G * NWAVES;
    const int gw = (c.vcu >= first_blk ? c.vcu - first_blk : c.vcu - first_blk + c.G) * NWAVES + c.wave;
    const float LOG2E = 1.4426950408889634f;
    LAS unsigned char* img = c.lds + half * RO_HALF;
    __syncthreads();
    for (int unit = gw; unit < nunits; unit += NGW) {
        const int ib = unit & 3, n = n0 + (unit >> 2) % nn, h = ((unit >> 2) / nn) & 3, b = (unit >> 2) / (nn * 4);
        const int row0 = ret_row(b, n), u0 = n < 2 ? n * 128 : CTXL + (n - 2) * 128;
        const int iq = ib * 32 + l31, qrow = row0 + iq;
        const float lf2 = logsig(p.gam_f[layer * 4 + h]) * LOG2E, lb2 = logsig(p.gam_b[layer * 4 + h]) * LOG2E;
        u32x4 kr[4], vr[4], sr[4];
#pragma unroll
        for (int i = 0; i < 4; ++i) { const int pc = ht + 256 * i;
            kr[i] = *(const u32x4*)(P + (size_t)(row0 + (pc >> 3)) * INW + RT_K + h * 64 + (pc & 7) * 8);
            vr[i] = *(const u32x4*)(P + (size_t)(row0 + (pc >> 3)) * INW + RT_V + h * 64 + (pc & 7) * 8);
            const int dir = pc >> 9, e = (pc >> 3) & 63, ch = pc & 7;
            if (CTXU) {
                if (dir == 0 ? n == 1 : n == 0) { const float* ur = U + ((size_t)((b * 4 + h) * 2 + dir) * NCH + (1 - n)) * 4096 + e * 64 + ch * 8; const f32x4 ua = *(const f32x4*)ur, ub = *(const f32x4*)(ur + 4);
                    sr[i].x = (unsigned)f2bf(ua[0]) | ((unsigned)f2bf(ua[1]) << 16); sr[i].y = (unsigned)f2bf(ua[2]) | ((unsigned)f2bf(ua[3]) << 16);
                    sr[i].z = (unsigned)f2bf(ub[0]) | ((unsigned)f2bf(ub[1]) << 16); sr[i].w = (unsigned)f2bf(ub[2]) | ((unsigned)f2bf(ub[3]) << 16); }
                else sr[i] = (u32x4){0u, 0u, 0u, 0u};
            } else sr[i] = *(const u32x4*)(ST + ((size_t)((b * 4 + h) * 2 + dir) * NCH + n) * 4096 + e * 64 + ch * 8);
        }
        bf16x8 qf[4];
#pragma unroll
        for (int ks = 0; ks < 4; ++ks) qf[ks] = *(const bf16x8*)(P + (size_t)qrow * INW + RT_Q + h * 64 + ks * 16 + hi * 8);
#pragma unroll
        for (int i = 0; i < 4; ++i) { const int pc = ht + 256 * i;
            *(LAS u32x4*)(img + RO_K + (pc >> 3) * RO_KP + (pc & 7) * 16) = kr[i];
            { LAS bf16_t* vd = (LAS bf16_t*)(img + RO_V) + ((pc & 7) * 8) * (RO_VP / 2) + (pc >> 3);
#pragma unroll
              for (int e = 0; e < 4; ++e) { vd[(2 * e) * (RO_VP / 2)] = (bf16_t)(vr[i][e] & 0xffffu); vd[(2 * e + 1) * (RO_VP / 2)] = (bf16_t)(vr[i][e] >> 16); } }
            *(LAS u32x4*)(img + RO_S + (pc >> 3) * RO_KP + (pc & 7) * 16) = sr[i]; }
        __syncthreads();
        bf16x8 pf[8];
#pragma unroll
        for (int jb = 0; jb < 4; ++jb) {
            f32x16 S;
#pragma unroll
            for (int r = 0; r < 16; ++r) S[r] = 0.f;
#pragma unroll
            for (int ks = 0; ks < 4; ++ks) { const bf16x8 kf = *(const LAS bf16x8*)(img + RO_K + (jb * 32 + l31) * RO_KP + ks * 32 + hi * 16); S = MFMA32(kf, qf[ks], S); }
#pragma unroll
            for (int r = 0; r < 16; ++r) { const int j = jb * 32 + (r & 3) + 8 * (r >> 2) + 4 * hi, dd = iq - j;
                S[r] *= 0.125f * __builtin_amdgcn_exp2f(dd >= 0 ? (float)dd * lf2 : (float)(-dd) * lb2); }
#pragma unroll
            for (int s = 0; s < 2; ++s) { u32x4 w; w.x = pk2(S[8 * s], S[8 * s + 1]); w.y = pk2(S[8 * s + 2], S[8 * s + 3]); w.z = pk2(S[8 * s + 4], S[8 * s + 5]); w.w = pk2(S[8 * s + 6], S[8 * s + 7]);
                pf[jb * 2 + s] = __builtin_bit_cast(bf16x8, w); }
        }
        const float xif = __builtin_amdgcn_exp2f((float)(iq + 1) * lf2), xib = __builtin_amdgcn_exp2f((float)(128 - iq) * lb2);
        f32x16 O[2];
#pragma unroll
        for (int eb = 0; eb < 2; ++eb) {
#pragma unroll
            for (int r = 0; r < 16; ++r) O[eb][r] = 0.f;
#pragma unroll
            for (int k8 = 0; k8 < 8; ++k8) { const LAS unsigned char* vp = img + RO_V + (eb * 32 + l31) * RO_VP + k8 * 32 + hi * 8;
                const u32x2 x0 = *(const LAS u32x2*)vp, x1 = *(const LAS u32x2*)(vp + 16);
                u32x4 wv; wv.x = x0.x; wv.y = x0.y; wv.z = x1.x; wv.w = x1.y;
                O[eb] = MFMA32(__builtin_bit_cast(bf16x8, wv), pf[k8], O[eb]); }
#pragma unroll
            for (int dir = 0; dir < 2; ++dir) {
                f32x16 C;
#pragma unroll
                for (int r = 0; r < 16; ++r) C[r] = 0.f;
#pragma unroll
                for (int ks = 0; ks < 4; ++ks) C = MFMA32(*(const LAS bf16x8*)(img + RO_S + (dir * 64 + eb * 32 + l31) * RO_KP + ks * 32 + hi * 16), qf[ks], C);
                const float xi = dir ? xib : xif;
#pragma unroll
                for (int r = 0; r < 16; ++r) O[eb][r] += xi * C[r];
            }
        }
        float ss = 0.f;
#pragma unroll
        for (int eb = 0; eb < 2; ++eb)
#pragma unroll
            for (int r = 0; r < 16; ++r) ss += O[eb][r] * O[eb][r];
        ss += shx(ss, 32, lane);
        const float rr = rsqrtf(ss * (1.f / 64.f) + EPS);
#pragma unroll
        for (int eb = 0; eb < 2; ++eb)
#pragma unroll
            for (int g = 0; g < 4; ++g) { const int e0 = eb * 32 + 8 * g + 4 * hi;
                const u32x2 gt = *(const u32x2*)(P + (size_t)qrow * INW + RT_G + h * 64 + e0);
                const float g0 = __uint_as_float(gt.x << 16), g1 = __uint_as_float(gt.x & 0xffff0000u), g2 = __uint_as_float(gt.y << 16), g3 = __uint_as_float(gt.y & 0xffff0000u);
                u32x2 w; w.x = pk2(O[eb][4 * g] * rr * silu_f(g0), O[eb][4 * g + 1] * rr * silu_f(g1)); w.y = pk2(O[eb][4 * g + 2] * rr * silu_f(g2), O[eb][4 * g + 3] * rr * silu_f(g3));
                *(u32x2*)(YC + (size_t)qrow * D + 768 + h * 64 + e0) = w; }
        __syncthreads();
    }
}
namespace da2 {
typedef short s16x4 __attribute__((ext_vector_type(4)));
typedef LAS const char* lcp;
constexpr int NSLOT = 3, SLOTB = 8192;
constexpr int L_K = 0, L_V = NSLOT * SLOTB, L_WS = 2 * NSLOT * SLOTB, L_ST = L_WS + 8 * 64 * 4;
constexpr int ST_P = 65, ST_W = 32 * ST_P;
DI int crow(int r, int hi) { return (r & 3) + 8 * (r >> 2) + 4 * hi; }
DI void glds16(const void* gsrc, unsigned lds_dst) { unsigned keep;
    asm volatile("s_mov_b32 %0, m0\n\ts_mov_b32 m0, %2\n\ts_nop 0\n\tglobal_load_lds_dwordx4 %1, off\n\ts_mov_b32 m0, %0" : "=&s"(keep) : "v"(gsrc), "s"(lds_dst) : "memory"); }
DI float max3f(float a, float b, float c) { float r; asm("v_max3_f32 %0, %1, %2, %3" : "=v"(r) : "v"(a), "v"(b), "v"(c)); return r; }
DI float max2f(float a, float b) { float r; asm("v_max_f32_e32 %0, %1, %2" : "=v"(r) : "v"(a), "v"(b)); return r; }
DI float fadd_s(float a, float b) { float r; asm("v_add_f32_e32 %0, %1, %2" : "=v"(r) : "v"(a), "v"(b)); return r; }
DI float fsub_s(float a, float b) { float r; asm("v_sub_f32_e32 %0, %1, %2" : "=v"(r) : "v"(a), "v"(b)); return r; }
#define SBAR() __builtin_amdgcn_sched_barrier(0)
#define WAIT_BAR(N) asm volatile("s_waitcnt vmcnt(" #N ") lgkmcnt(0)\n\ts_barrier" ::: "memory")
DI s16x4 vtr(lcp p) { return __builtin_bit_cast(s16x4, __builtin_amdgcn_ds_read_tr16_b64_v4i16((LAS s16x4*)p)); }
DI float rowmax(const f32x16& p0, const f32x16& p1) {
    float a = max3f(p0[0], p0[1], p1[0]), b = max3f(p0[2], p0[3], p1[1]); a = max3f(a, p1[2], p1[3]);
#pragma unroll
    for (int r = 4; r < 16; r += 4) { a = max3f(a, p0[r], p0[r + 1]); b = max3f(b, p0[r + 2], p0[r + 3]); a = max3f(a, p1[r], p1[r + 1]); b = max3f(b, p1[r + 2], p1[r + 3]); }
    const float m = max2f(a, b);
    auto rr = __builtin_amdgcn_permlane32_swap(__float_as_uint(m), __float_as_uint(m), false, false);
    return max2f(__uint_as_float(rr[0]), __uint_as_float(rr[1]));
}
DI void pv(f32x16* o, int vb, bf16x8 pa0, bf16x8 pa1, bf16x8 pa2, bf16x8 pa3) {
#pragma unroll
    for (int d0 = 0; d0 < 2; ++d0) { s16x4 lo[4], hi[4];
#pragma unroll
        for (int ks = 0; ks < 4; ++ks) {
            asm volatile("ds_read_b64_tr_b16 %0,%1 offset:%c2" : "=&v"(lo[ks]) : "v"(vb), "i"(d0 * 4096 + ks * 1024) : "memory");
            asm volatile("ds_read_b64_tr_b16 %0,%1 offset:%c2" : "=&v"(hi[ks]) : "v"(vb), "i"(d0 * 4096 + ks * 1024 + 512) : "memory"); }
        asm volatile("s_waitcnt lgkmcnt(0)" ::: "memory"); SBAR();
#define PK(k) (bf16x8){lo[k][0], lo[k][1], lo[k][2], lo[k][3], hi[k][0], hi[k][1], hi[k][2], hi[k][3]}
        o[d0] = MFMA32(pa0, PK(0), o[d0]);
        o[d0] = MFMA32(pa1, PK(1), o[d0]);
        o[d0] = MFMA32(pa2, PK(2), o[d0]);
        o[d0] = MFMA32(pa3, PK(3), o[d0]);
#undef PK
    }
}
DI int tile_row(int b, int t) { return t < CTXL / 64 ? TX + b * CTXL + 64 * t : b * SEQ + 64 * (t - CTXL / 64); }

template <int THRL>
DI void unit(const Params& p, const Cx& c, int layer, int b, int h, int qrow0, int NT, float lam, float lam_init) {
    const int lane = c.lane, r32 = lane & 31, hi = lane >> 5; const int wid = __builtin_amdgcn_readfirstlane(c.wave);
    const int mp = wid >> 2, qblk = wid & 3;
    const bf16_t* P = (const bf16_t*)(p.ws + OFF_A + A_P);
    bf16_t* YC = (bf16_t*)(p.ws + OFF_H);
    const unsigned lds0 = (unsigned)(uintptr_t)c.lds;
    LAS float* wsf = (LAS float*)(c.lds + L_WS) + wid * 64;
    const bf16_t* ksrc = P + (size_t)lane * INW + DA_K + h * 64 + wid * 8;
    const bf16_t* vsrc = P + (size_t)(16 * (wid & 3) + (lane >> 2)) * INW + DA_V + h * 64 + (wid >> 2) * 32 + (lane & 3) * 8;
    const unsigned kdst = lds0 + L_K + wid * 1024, vdst = lds0 + L_V + wid * 1024;
#define DMA_K(t, slot) glds16(ksrc + (size_t)tile_row(b, (t)) * INW, (unsigned)__builtin_amdgcn_readfirstlane(kdst + (slot)))
#define DMA_V(t, slot) glds16(vsrc + (size_t)tile_row(b, (t)) * INW, (unsigned)__builtin_amdgcn_readfirstlane(vdst + (slot)))
    const int vb0 = (int)(lds0 + L_V) + ((lane >> 4) & 1) * 32 + (lane & 3) * 8 + (4 * hi + ((lane & 15) >> 2)) * 64;
    bf16x8 kf[4];
    const lcp shm3 = (lcp)c.lds; const lcp kp0 = shm3 + L_K + mp * 4096 + hi * 1024 + r32 * 16;
    const lcp vp0 = shm3 + L_V + ((lane >> 4) & 1) * 32 + (lane & 3) * 8 + (4 * hi + ((lane & 15) >> 2)) * 64;
    asm volatile("s_waitcnt vmcnt(0)" ::: "memory");
    DMA_K(0, 0); DMA_V(0, 0); DMA_K(1, SLOTB);
    bf16x8 qr[2];
    { const bf16_t* Qw = P + (size_t)(qrow0 + qblk * 32 + r32) * INW + DA_Q + h * 64 + mp * 32 + hi * 8;
      qr[0] = *(const bf16x8*)(Qw); qr[1] = *(const bf16x8*)(Qw + 16); }
    float mhat = 0.f; f32x16 o[2], lacc;
#pragma unroll
    for (int r = 0; r < 16; ++r) { o[0][r] = 0.f; o[1][r] = 0.f; lacc[r] = 0.f; }
    bf16x8 ones;
#pragma unroll
    for (int j = 0; j < 8; ++j) ones[j] = (short)0x3F80;
    asm volatile("" : "+v"(ones));
    f32x16 negm;
#pragma unroll
    for (int r = 0; r < 16; ++r) negm[r] = 0.f;
    asm volatile("" : "+v"(negm));
    bool resc = false;
#define START(P0, P1) do { const float rm = rowmax(P0, P1); resc = false; \
    { const float dl = rm; mhat = fadd_s(mhat, dl); \
      _Pragma("unroll") for (int r = 0; r < 16; ++r) { P0[r] = fsub_s(P0[r], dl); P1[r] = fsub_s(P1[r], dl); } \
      _Pragma("unroll") for (int r = 0; r < 16; ++r) negm[r] = -mhat; asm volatile("" : "+v"(negm)); } \
    _Pragma("unroll") for (int r = 0; r < 16; ++r) P0[r] = __builtin_amdgcn_exp2f(P0[r]); } while (0)
#define RESC() do { if (resc) { asm volatile("s_waitcnt lgkmcnt(0)" ::: "memory"); \
      _Pragma("unroll") for (int r = 0; r < 16; ++r) { const float f_ = wsf[crow(r, hi)]; o[0][r] *= f_; o[1][r] *= f_; lacc[r] *= f_; } } } while (0)
    f32x16 pA0, pA1, pB0, pB1;
    int sl_prev = 0, sl_cur = 0, sl_next = SLOTB;
#define ROT() do { sl_prev = sl_cur; sl_cur = sl_next; sl_next = (sl_next == (NSLOT - 1) * SLOTB) ? 0 : sl_next + SLOTB; } while (0)
    DMA_K(2, 2 * SLOTB);
    WAIT_BAR(3);
    {
        const lcp kb = kp0;
        const bf16x8 b0 = *(const LAS bf16x8*)(kb), b1 = *(const LAS bf16x8*)(kb + 512), b2 = *(const LAS bf16x8*)(kb + 2048), b3 = *(const LAS bf16x8*)(kb + 2560);
        pA0 = MFMA32(b0, qr[0], negm); pA1 = MFMA32(b1, qr[0], negm); pA0 = MFMA32(b2, qr[1], pA0); pA1 = MFMA32(b3, qr[1], pA1);
        asm volatile("s_nop 15\n\ts_nop 7" : "+v"(pA0), "+v"(pA1));
    }
    START(pA0, pA1);
#pragma unroll
    for (int r = 0; r < 16; ++r) pA1[r] = __builtin_amdgcn_exp2f(pA1[r]);
    WAIT_BAR(0);
    DMA_K(3, 0); DMA_V(1, SLOTB);
    ROT();
#define KLOAD4(kp_) do { kf[0] = *(const LAS bf16x8*)(kp_); kf[1] = *(const LAS bf16x8*)((kp_) + 512); kf[2] = *(const LAS bf16x8*)((kp_) + 2048); kf[3] = *(const LAS bf16x8*)((kp_) + 2560); } while (0)
    KLOAD4(kp0 + sl_cur);
    WAIT_BAR(2);
    s16x4 vlo[8], vhi[8]; u32x4 pw0, pw1, pw2, pw3;
#define PKW(P_, B_) pk2(P_[B_], P_[B_ + 1])
#define PAF(k) __builtin_bit_cast(bf16x8, pw##k)
#define VFR(i) (bf16x8){vlo[i][0], vlo[i][1], vlo[i][2], vlo[i][3], vhi[i][0], vhi[i][1], vhi[i][2], vhi[i][3]}
#define PIN(x) asm volatile("" : "+v"(x))
#define MX3(a, b, c_) __builtin_fmaxf(__builtin_fmaxf((a), (b)), (c_))
#define GAPA(MF, PW, PS, B_) do { MF; PW[0] = PKW(PS, B_); PW[1] = PKW(PS, B_ + 2); PW[2] = PKW(PS, B_ + 4); PW[3] = PKW(PS, B_ + 6); PIN(PW); SBAR(); } while (0)
#define EX(v) __builtin_amdgcn_exp2f(v)
#define GAPB(MF, X, B_) do { MF; X[B_] = EX(X[B_]); X[B_ + 1] = EX(X[B_ + 1]); X[B_ + 2] = EX(X[B_ + 2]); X[B_ + 3] = EX(X[B_ + 3]); PIN(X); SBAR(); } while (0)
#define VRD(i) do { vlo[i] = vtr(vp_ + (((i) >> 2) * 4096 + ((i) & 3) * 1024)); vhi[i] = vtr(vp_ + (((i) >> 2) * 4096 + ((i) & 3) * 1024 + 512)); } while (0)
#define KRD(G_, j) do { if (G_) { const lcp kn_ = kp0 + sl_next; kf[2 * (j)] = *(const LAS bf16x8*)(kn_ + (j) * 2048); kf[2 * (j) + 1] = *(const LAS bf16x8*)(kn_ + (j) * 2048 + 512); SBAR(); } } while (0)
#define STEP(C0, C1, P0, P1, t, GK, GV, GL) do { SBAR(); \
    const lcp vp_ = vp0 + sl_prev; \
    VRD(0); VRD(4); SBAR(); GAPA(C0 = MFMA32(kf[0], qr[0], negm), pw0, P0, 0); \
    VRD(1); VRD(5); SBAR(); GAPA(C1 = MFMA32(kf[1], qr[0], negm), pw1, P0, 8); \
    VRD(2); VRD(6); SBAR(); GAPA(C0 = MFMA32(kf[2], qr[1], C0), pw2, P1, 0); \
    VRD(3); VRD(7); SBAR(); GAPA(C1 = MFMA32(kf[3], qr[1], C1), pw3, P1, 8); \
    if (GK) { DMA_K((t) + 3, sl_cur); } if (GV) { DMA_V((t) + 1, sl_next); } \
    { float a, b_; \
      lacc = MFMA32(PAF(0), ones, lacc); a = MX3(C0[0], C0[1], C0[2]); a = MX3(a, C0[3], C0[4]); a = MX3(a, C0[5], C0[6]); a = MX3(a, C0[7], C0[8]); a = MX3(a, C0[9], C0[10]); PIN(a); SBAR(); \
      lacc = MFMA32(PAF(1), ones, lacc); a = MX3(a, C0[11], C0[12]); a = MX3(a, C0[13], C0[14]); b_ = MX3(C0[15], C1[0], C1[1]); b_ = MX3(b_, C1[2], C1[3]); b_ = MX3(b_, C1[4], C1[5]); PIN(a); PIN(b_); SBAR(); \
      lacc = MFMA32(PAF(2), ones, lacc); b_ = MX3(b_, C1[6], C1[7]); b_ = MX3(b_, C1[8], C1[9]); b_ = MX3(b_, C1[10], C1[11]); b_ = MX3(b_, C1[12], C1[13]); b_ = MX3(b_, C1[14], C1[15]); PIN(b_); SBAR(); \
      lacc = MFMA32(PAF(3), ones, lacc); \
      float rm = __builtin_fmaxf(a, b_); { auto rr = __builtin_amdgcn_permlane32_swap(__float_as_uint(rm), __float_as_uint(rm), false, false); rm = __builtin_fmaxf(__uint_as_float(rr[0]), __uint_as_float(rr[1])); } \
      resc = false; \
      if (__builtin_expect(__builtin_amdgcn_ballot_w64(rm > (float)THRL) != 0ull, 0)) { const float dl = __builtin_fmaxf(rm, 0.f); mhat += dl; \
        _Pragma("unroll") for (int r = 0; r < 16; ++r) { C0[r] -= dl; C1[r] -= dl; } \
        _Pragma("unroll") for (int r = 0; r < 16; ++r) negm[r] = -mhat; asm volatile("" : "+v"(negm)); \
        const float f = __builtin_amdgcn_exp2f(-dl); if (hi == 0) wsf[r32] = f; resc = true; } } \
    SBAR(); \
    GAPB(o[0] = MFMA32(PAF(0), VFR(0), o[0]), C0, 0); \
    GAPB(o[1] = MFMA32(PAF(0), VFR(4), o[1]), C0, 4); \
    KRD(GL, 0); GAPB(o[0] = MFMA32(PAF(1), VFR(1), o[0]), C0, 8); \
    KRD(GL, 1); GAPB(o[1] = MFMA32(PAF(1), VFR(5), o[1]), C0, 12); \
    GAPB(o[0] = MFMA32(PAF(2), VFR(2), o[0]), C1, 0); \
    GAPB(o[1] = MFMA32(PAF(2), VFR(6), o[1]), C1, 4); \
    GAPB(o[0] = MFMA32(PAF(3), VFR(3), o[0]), C1, 8); \
    GAPB(o[1] = MFMA32(PAF(3), VFR(7), o[1]), C1, 12); \
    } while (0)
    int t = 1;
    for (; t + 5 < NT; t += 2) {
        STEP(pB0, pB1, pA0, pA1, t, true, true, true);       WAIT_BAR(2); RESC(); ROT();
        STEP(pA0, pA1, pB0, pB1, t + 1, true, true, true);   WAIT_BAR(2); RESC(); ROT();
    }
#define ENDW(tt) do { if ((tt) + 3 < NT) { WAIT_BAR(2); } else if ((tt) + 2 < NT) { WAIT_BAR(1); } else { WAIT_BAR(0); } } while (0)
    for (; t + 1 < NT; t += 2) {
        STEP(pB0, pB1, pA0, pA1, t, (t + 3 < NT), (t + 1 < NT), (t + 1 < NT));         ENDW(t);     RESC(); ROT();
        STEP(pA0, pA1, pB0, pB1, t + 1, (t + 4 < NT), (t + 2 < NT), (t + 2 < NT));     ENDW(t + 1); RESC(); ROT();
    }
    STEP(pB0, pB1, pA0, pA1, NT - 1, false, false, false); RESC();
    { pw0 = (u32x4){PKW(pB0, 0), PKW(pB0, 2), PKW(pB0, 4), PKW(pB0, 6)}; pw1 = (u32x4){PKW(pB0, 8), PKW(pB0, 10), PKW(pB0, 12), PKW(pB0, 14)};
      pw2 = (u32x4){PKW(pB1, 0), PKW(pB1, 2), PKW(pB1, 4), PKW(pB1, 6)}; pw3 = (u32x4){PKW(pB1, 8), PKW(pB1, 10), PKW(pB1, 12), PKW(pB1, 14)};
      SBAR(); lacc = MFMA32(PAF(0), ones, lacc); lacc = MFMA32(PAF(1), ones, lacc); lacc = MFMA32(PAF(2), ones, lacc); lacc = MFMA32(PAF(3), ones, lacc);
      pv(o, vb0 + sl_cur, PAF(0), PAF(1), PAF(2), PAF(3)); }
#undef PKW
#undef PAF
#undef VFR
#undef PIN
#undef MX3
#undef GAPA
#undef GAPB
#undef EX
#undef VRD
#undef KRD
#undef STEP
#undef ENDW
#undef KLOAD4
    const float osc = mp ? lam : 1.f;
    LAS float* stg = (LAS float*)(c.lds + L_ST) + wid * ST_W;
#pragma unroll
    for (int r = 0; r < 16; ++r) { const float rl = __builtin_amdgcn_rcpf(lacc[r]) * osc; const int orow = crow(r, hi);
        stg[orow * ST_P + r32] = o[0][r] * rl; stg[orow * ST_P + 32 + r32] = o[1][r] * rl; }
    __syncthreads();
    if (mp == 0) {
        const LAS float* s0 = stg + r32 * ST_P + 32 * hi; const LAS float* s1 = s0 + 4 * ST_W;
        float df[32]; float ss = 0.f;
#pragma unroll
        for (int j = 0; j < 32; ++j) { df[j] = s0[j] - s1[j]; ss += df[j] * df[j]; }
        { auto rr = __builtin_amdgcn_permlane32_swap(__float_as_uint(ss), __float_as_uint(ss), false, false); ss = __uint_as_float(rr[0]) + __uint_as_float(rr[1]); }
        const float rn = rsqrtf(ss * (1.f / 64.f) + EPS) * (1.f - lam_init);
        const float* sg = p.subln + layer * 64 + 32 * hi;
        bf16_t* yo = YC + (size_t)(qrow0 + qblk * 32 + r32) * D + h * 64 + 32 * hi;
#pragma unroll
        for (int g = 0; g < 4; ++g) { const f32x4 ga = *(const f32x4*)(sg + 8 * g), gb = *(const f32x4*)(sg + 8 * g + 4);
            u32x4 w; w.x = pk2(df[8 * g] * rn * ga[0], df[8 * g + 1] * rn * ga[1]); w.y = pk2(df[8 * g + 2] * rn * ga[2], df[8 * g + 3] * rn * ga[3]);
            w.z = pk2(df[8 * g + 4] * rn * gb[0], df[8 * g + 5] * rn * gb[1]); w.w = pk2(df[8 * g + 6] * rn * gb[2], df[8 * g + 7] * rn * gb[3]);
            *(u32x4*)(yo + 8 * g) = w; }
    }
    asm volatile("s_waitcnt lgkmcnt(0)\n\ts_barrier" ::: "memory");
#undef DMA_K
#undef DMA_V
#undef START
#undef RESC
#undef ROT
}
#undef SBAR
#undef WAIT_BAR
}

DI void phase_da2(const Params& p, const Cx& c0, int layer, int ctxq, int first_blk = 0) {
    const Cx c = fresh(c0);
    float s1 = 0.f, s2 = 0.f;
    for (int i = 0; i < 32; ++i) { s1 += p.lq1[layer * 32 + i] * p.lk1[layer * 32 + i]; s2 += p.lq2[layer * 32 + i] * p.lk2[layer * 32 + i]; }
    const float lam_init = 0.8f - 0.6f * expf(-0.3f * (float)layer);
    const float lam = expf(s1) - expf(s2) + lam_init;
    const int nunits = ctxq ? NB * 4 * 2 : NB * 4 * 64;
    __syncthreads();
    for (int unit = c.vcu >= first_blk ? c.vcu - first_blk : c.vcu - first_blk + c.G; unit < nunits; unit += c.G) {
        int b, h, qrow0, NT;
        if (ctxq) { b = unit >> 3; h = (unit >> 1) & 3; qrow0 = TX + b * CTXL + (unit & 1) * 128; NT = CTXL / 64; }
        else { b = unit >> 8; h = (unit >> 6) & 3; qrow0 = b * SEQ + (unit & 63) * 128; NT = NKEY / 64; }
        da2::unit<8>(p, c, layer, b, h, qrow0, NT, lam, lam_init);
    }
    __syncthreads();
}
namespace da2 {
#define SBAR() __builtin_amdgcn_sched_barrier(0)
#define WAIT_BAR(N) asm volatile("s_waitcnt vmcnt(" #N ") lgkmcnt(0)\n\ts_barrier" ::: "memory")
constexpr int F_OST = L_WS + 8 * 64 * 4;
constexpr int F_TAB = F_OST + 8 * 4096;
DI void glds16s(const void* sbase, unsigned voff, unsigned lds_dst) { unsigned keep;
    asm volatile("s_mov_b32 %0, m0\n\ts_mov_b32 m0, %3\n\ts_nop 0\n\tglobal_load_lds_dwordx4 %1, %2\n\ts_mov_b32 m0, %0" : "=&s"(keep) : "v"(voff), "s"(sbase), "s"(lds_dst) : "memory"); }
template <int MODE>
DI void fmask(f32x16& C0, f32x16& C1, int tl, int loc0, int qw0, const LAS float* tab) {
    const int ln = lane_id_fresh(), hi = ln >> 5, qpos = qw0 + (ln & 31), gc = qpos & 63, cstart = min(max(gc - 8, 0), 48);
    bool need, masked; int kpos0 = 0, dr = 0;
    if (MODE == 1) { kpos0 = loc0 + 64 * tl; need = (kpos0 + 63 >= qw0 - 128) && (kpos0 <= qw0 + 31 + 128); masked = !((kpos0 >= qw0 + 31 - 128) && (kpos0 + 63 <= qw0 + 128)); }
    else { const int kr = loc0 + tl, wr = qw0 >> 6, ws_ = min(max(wr - 4, 0), 120); need = (kr >= ws_) && (kr < ws_ + 8); masked = true; dr = kr - wr + 7; }
    if (!need) {
#pragma unroll
        for (int r = 0; r < 16; ++r) { C0[r] = -INFINITY; C1[r] = -INFINITY; }
    } else if (masked) {
#pragma unroll
        for (int r = 0; r < 16; ++r) {
#pragma unroll
            for (int kb = 0; kb < 2; ++kb) { const int kidx = kb * 32 + (r & 3) + 8 * (r >> 2) + 4 * hi; float bias;
                if (MODE == 1) { const int dd = qpos - (kpos0 + kidx); bias = (dd <= 128 && dd >= -128) ? 0.f : -INFINITY; }
                else { const bool ok = kidx >= cstart && kidx < cstart + 16; const int dc = min(max(kidx - gc, -15), 15) + 15; bias = ok ? tab[dr * 31 + dc] : -INFINITY; }
                if (kb == 0) C0[r] += bias; else C1[r] += bias; } }
    }
}

template <int MODE, int THRL>
DI void unit64(const Params& p, const Cx& c, int layer, int b, int h, int qb, int ctxq) {
    const int lane = c.lane, r32 = lane & 31, hi = lane >> 5; const int wid = __builtin_amdgcn_readfirstlane(c.wave);
    const bf16_t* P = (const bf16_t*)(p.ws + OFF_A + A_P);
    bf16_t* YC = (bf16_t*)(p.ws + OFF_H);
    const unsigned lds0 = (unsigned)(uintptr_t)c.lds;
    LAS float* wsf = (LAS float*)(c.lds + L_WS) + wid * 64;
    LAS float* tab = (LAS float*)(c.lds + F_TAB);
    const int qcolP = MODE == 1 ? SW_Q + h * 64 : NA_Q + h * 64, kcolP = MODE == 1 ? SW_K + (h >> 1) * 64 : NA_K + h * 64, vcolP = MODE == 1 ? SW_V + (h >> 1) * 64 : NA_V + h * 64;
    const int ycol = (MODE == 1 ? 256 : 512) + h * 64;
    int nloc = 0, loc0 = 0;
    if (!ctxq) {
        if (MODE == 1) { const int lo = qb == 0 ? 2 : 0, hi_t = qb == 31 ? 5 : 7; loc0 = qb * 256 - 128 + 64 * lo; nloc = hi_t - lo + 1; }
        else { const int rmin = min(max(4 * qb - 4, 0), 120), rmax = min(max(4 * qb - 1, 0), 120) + 8; loc0 = rmin; nloc = rmax - rmin; nloc += nloc & 1; }
    }
    const int NT = 4 + nloc;
#define TROW(t) ((t) < 4 ? TX + b * CTXL + 64 * (t) : (MODE == 1 ? b * SEQ + loc0 + 64 * ((t) - 4) : b * SEQ + 64 * (loc0 + (t) - 4)))
    const int qrow0 = (ctxq ? TX + b * CTXL : b * SEQ + qb * 256) + wid * 32;
    const int qw0 = qb * 256 + wid * 32;
    const unsigned koff = (unsigned)(lane * INW + kcolP + wid * 8) * 2u, voff = (unsigned)((16 * (wid & 3) + (lane >> 2)) * INW + vcolP + (wid >> 2) * 32 + (lane & 3) * 8) * 2u;
    const unsigned kdst = lds0 + L_K + wid * 1024, vdst = lds0 + L_V + wid * 1024;
#define DMA_K(t, slot) glds16s(P + (size_t)TROW(t) * INW, koff, (unsigned)__builtin_amdgcn_readfirstlane(kdst + (slot)))
#define DMA_V(t, slot) glds16s(P + (size_t)TROW(t) * INW, voff, (unsigned)__builtin_amdgcn_readfirstlane(vdst + (slot)))
    bf16x8 kf[8];
    const lcp shm3 = (lcp)c.lds; const lcp kp0 = shm3 + L_K + hi * 1024 + r32 * 16;
    const lcp vp0 = shm3 + L_V + ((lane >> 4) & 1) * 32 + (lane & 3) * 8 + (4 * hi + ((lane & 15) >> 2)) * 64;
    asm volatile("s_waitcnt vmcnt(0)" ::: "memory");
    DMA_K(0, 0); DMA_V(0, 0); DMA_K(1, SLOTB);
    if (MODE == 2) { for (int i = lane_id_fresh() + 64 * wid; i < 465; i += NTHREADS) tab[i] = p.rpb[(size_t)(layer * 4 + h) * 465 + i] * 1.4426950408889634f; }
    bf16x8 qr[4];
    { const bf16_t* Qw = P + (size_t)(qrow0 + r32) * INW + qcolP + hi * 8;
#pragma unroll
      for (int d0 = 0; d0 < 4; ++d0) qr[d0] = *(const bf16x8*)(Qw + d0 * 16); }
    float mhat = 0.f, l_reg = 0.f; f32x16 o[2];
#pragma unroll
    for (int r = 0; r < 16; ++r) { o[0][r] = 0.f; o[1][r] = 0.f; }
    f32x16 negm;
#pragma unroll
    for (int r = 0; r < 16; ++r) negm[r] = 0.f;
    asm volatile("" : "+v"(negm));
    bool resc = false;
#define CMASK(C0_, C1_, t) do { const int tl_ = (t) - 4; if (!ctxq && tl_ >= 0) fmask<MODE>(C0_, C1_, tl_, loc0, qw0, tab); } while (0)
#define START(P0, P1) do { const float rm = rowmax(P0, P1); resc = false; \
    { const float dl = rm; mhat = fadd_s(mhat, dl); \
      _Pragma("unroll") for (int r = 0; r < 16; ++r) { P0[r] = fsub_s(P0[r], dl); P1[r] = fsub_s(P1[r], dl); } \
      _Pragma("unroll") for (int r = 0; r < 16; ++r) negm[r] = -mhat; asm volatile("" : "+v"(negm)); } \
    _Pragma("unroll") for (int r = 0; r < 16; ++r) P0[r] = __builtin_amdgcn_exp2f(P0[r]); } while (0)
#define RESC() do { if (resc) { asm volatile("s_waitcnt lgkmcnt(0)" ::: "memory"); \
      _Pragma("unroll") for (int r = 0; r < 16; ++r) { const float f_ = wsf[crow(r, hi)]; o[0][r] *= f_; o[1][r] *= f_; } } } while (0)
    f32x16 pA0, pA1, pB0, pB1;
    int sl_prev = 0, sl_cur = 0, sl_next = SLOTB;
#define ROT() do { sl_prev = sl_cur; sl_cur = sl_next; sl_next = (sl_next == (NSLOT - 1) * SLOTB) ? 0 : sl_next + SLOTB; } while (0)
    DMA_K(2, 2 * SLOTB);
    WAIT_BAR(3);
    {
        const lcp kb = kp0;
#pragma unroll
        for (int d0 = 0; d0 < 4; ++d0) {
            const bf16x8 b0 = *(const LAS bf16x8*)(kb + d0 * 2048), b1 = *(const LAS bf16x8*)(kb + d0 * 2048 + 512);
            if (d0 == 0) { pA0 = MFMA32(b0, qr[0], negm); pA1 = MFMA32(b1, qr[0], negm); }
            else { pA0 = MFMA32(b0, qr[d0], pA0); pA1 = MFMA32(b1, qr[d0], pA1); } }
        asm volatile("s_nop 15\n\ts_nop 7" : "+v"(pA0), "+v"(pA1));
    }
    START(pA0, pA1);
#pragma unroll
    for (int r = 0; r < 16; ++r) pA1[r] = __builtin_amdgcn_exp2f(pA1[r]);
    WAIT_BAR(0);
    DMA_K(3, 0); DMA_V(1, SLOTB);
    ROT();
#define KLOAD8(kp_) do { kf[0] = *(const LAS bf16x8*)(kp_); kf[1] = *(const LAS bf16x8*)((kp_) + 512); kf[2] = *(const LAS bf16x8*)((kp_) + 2048); kf[3] = *(const LAS bf16x8*)((kp_) + 2560); \
        kf[4] = *(const LAS bf16x8*)((kp_) + 4096); kf[5] = *(const LAS bf16x8*)((kp_) + 4608); kf[6] = *(const LAS bf16x8*)((kp_) + 6144); kf[7] = *(const LAS bf16x8*)((kp_) + 6656); } while (0)
    KLOAD8(kp0 + sl_cur);
    WAIT_BAR(2);
    s16x4 vlo[8], vhi[8]; u32x4 pw0, pw1, pw2, pw3;
#define PKW(P_, B_) pk2(P_[B_], P_[B_ + 1])
#define PAF(k) __builtin_bit_cast(bf16x8, pw##k)
#define VFR(i) (bf16x8){vlo[i][0], vlo[i][1], vlo[i][2], vlo[i][3], vhi[i][0], vhi[i][1], vhi[i][2], vhi[i][3]}
#define PIN(x) asm volatile("" : "+v"(x))
#define MX3(a, b, c_) __builtin_fmaxf(__builtin_fmaxf((a), (b)), (c_))
#define GAPA(MF, A0, A1, A2, A3, W0, W1, PW) do { MF; sacc += A0; sacc += A1; sacc += A2; sacc += A3; PIN(sacc); W0; W1; PIN(PW); SBAR(); } while (0)
#define EX(v) __builtin_amdgcn_exp2f(v)
#define GAPB(MF, X, B_) do { MF; X[B_] = EX(X[B_]); X[B_ + 1] = EX(X[B_ + 1]); X[B_ + 2] = EX(X[B_ + 2]); X[B_ + 3] = EX(X[B_ + 3]); PIN(X); SBAR(); } while (0)
#define VRD(i) do { vlo[i] = vtr(vp_ + (((i) >> 2) * 4096 + ((i) & 3) * 1024)); vhi[i] = vtr(vp_ + (((i) >> 2) * 4096 + ((i) & 3) * 1024 + 512)); } while (0)
#define KRD(G_, j) do { if (G_) { const lcp kn_ = kp0 + sl_next; kf[2 * (j)] = *(const LAS bf16x8*)(kn_ + (j) * 2048); kf[2 * (j) + 1] = *(const LAS bf16x8*)(kn_ + (j) * 2048 + 512); SBAR(); } } while (0)
#define STEP(C0, C1, P0, P1, t, GK, GV, GL) do { SBAR(); \
    const lcp vp_ = vp0 + sl_prev; \
    VRD(0); SBAR(); float sacc = (P0[0] + P0[1]); \
    GAPA(C0 = MFMA32(kf[0], qr[0], negm), P0[2], P0[3], P0[4], P0[5],     pw0[0] = PKW(P0, 0), pw0[1] = PKW(P0, 2), pw0); \
    VRD(4); SBAR(); GAPA(C1 = MFMA32(kf[1], qr[0], negm), P0[6], P0[7], P0[8], P0[9],     pw0[2] = PKW(P0, 4), pw0[3] = PKW(P0, 6), pw0); \
    VRD(1); SBAR(); GAPA(C0 = MFMA32(kf[2], qr[1], C0),   P0[10], P0[11], P0[12], P0[13], pw1[0] = PKW(P0, 8), pw1[1] = PKW(P0, 10), pw1); \
    VRD(5); SBAR(); GAPA(C1 = MFMA32(kf[3], qr[1], C1),   P0[14], P0[15], P1[0], P1[1],   pw1[2] = PKW(P0, 12), pw1[3] = PKW(P0, 14), pw1); \
    VRD(2); SBAR(); GAPA(C0 = MFMA32(kf[4], qr[2], C0),   P1[2], P1[3], P1[4], P1[5],     pw2[0] = PKW(P1, 0), pw2[1] = PKW(P1, 2), pw2); \
    VRD(6); SBAR(); GAPA(C1 = MFMA32(kf[5], qr[2], C1),   P1[6], P1[7], P1[8], P1[9],     pw2[2] = PKW(P1, 4), pw2[3] = PKW(P1, 6), pw2); \
    VRD(3); SBAR(); GAPA(C0 = MFMA32(kf[6], qr[3], C0),   P1[10], P1[11], P1[12], P1[13], pw3[0] = PKW(P1, 8), pw3[1] = PKW(P1, 10), pw3); \
    VRD(7); SBAR(); GAPA(C1 = MFMA32(kf[7], qr[3], C1),   P1[14], P1[15], 0.f, 0.f,       pw3[2] = PKW(P1, 12), pw3[3] = PKW(P1, 14), pw3); \
    l_reg += sacc; \
    if (GK) { DMA_K((t) + 3, sl_cur); } if (GV) { DMA_V((t) + 1, sl_next); } \
    CMASK(C0, C1, t); \
    { float a = MX3(C0[0], C0[1], C1[0]), b_ = MX3(C0[2], C0[3], C1[1]); a = MX3(a, C1[2], C1[3]); \
      _Pragma("unroll") for (int r = 4; r < 16; r += 4) { a = MX3(a, C0[r], C0[r + 1]); b_ = MX3(b_, C0[r + 2], C0[r + 3]); a = MX3(a, C1[r], C1[r + 1]); b_ = MX3(b_, C1[r + 2], C1[r + 3]); } \
      float rm = __builtin_fmaxf(a, b_); { auto rr = __builtin_amdgcn_permlane32_swap(__float_as_uint(rm), __float_as_uint(rm), false, false); rm = __builtin_fmaxf(__uint_as_float(rr[0]), __uint_as_float(rr[1])); } \
      resc = false; \
      if (__builtin_expect(__builtin_amdgcn_ballot_w64(rm > (float)THRL) != 0ull, 0)) { const float dl = __builtin_fmaxf(rm, 0.f); mhat += dl; \
        _Pragma("unroll") for (int r = 0; r < 16; ++r) { C0[r] -= dl; C1[r] -= dl; } \
        _Pragma("unroll") for (int r = 0; r < 16; ++r) negm[r] = -mhat; asm volatile("" : "+v"(negm)); \
        const float f = __builtin_amdgcn_exp2f(-dl); l_reg *= f; if (hi == 0) wsf[r32] = f; resc = true; } } \
    SBAR(); \
    GAPB(o[0] = MFMA32(PAF(0), VFR(0), o[0]), C0, 0); \
    GAPB(o[1] = MFMA32(PAF(0), VFR(4), o[1]), C0, 4); \
    KRD(GL, 0); GAPB(o[0] = MFMA32(PAF(1), VFR(1), o[0]), C0, 8); \
    KRD(GL, 1); GAPB(o[1] = MFMA32(PAF(1), VFR(5), o[1]), C0, 12); \
    KRD(GL, 2); GAPB(o[0] = MFMA32(PAF(2), VFR(2), o[0]), C1, 0); \
    KRD(GL, 3); GAPB(o[1] = MFMA32(PAF(2), VFR(6), o[1]), C1, 4); \
    GAPB(o[0] = MFMA32(PAF(3), VFR(3), o[0]), C1, 8); \
    GAPB(o[1] = MFMA32(PAF(3), VFR(7), o[1]), C1, 12); \
    } while (0)
#define ENDW(tt) do { if ((tt) + 3 < NT) { WAIT_BAR(2); } else if ((tt) + 2 < NT) { WAIT_BAR(1); } else { WAIT_BAR(0); } } while (0)
    int t = 1;
    for (; t + 1 < NT; t += 2) {
        STEP(pB0, pB1, pA0, pA1, t, (t + 3 < NT), (t + 1 < NT), (t + 1 < NT));         ENDW(t);     RESC(); ROT();
        STEP(pA0, pA1, pB0, pB1, t + 1, (t + 4 < NT), (t + 2 < NT), (t + 2 < NT));     ENDW(t + 1); RESC(); ROT();
    }
    STEP(pB0, pB1, pA0, pA1, NT - 1, false, false, false); RESC();
    { float sacc = pB0[0] + pB0[1];
#pragma unroll
      for (int r = 2; r < 16; ++r) sacc += pB0[r];
#pragma unroll
      for (int r = 0; r < 16; ++r) sacc += pB1[r];
      l_reg += sacc;
      pw0 = (u32x4){PKW(pB0, 0), PKW(pB0, 2), PKW(pB0, 4), PKW(pB0, 6)}; pw1 = (u32x4){PKW(pB0, 8), PKW(pB0, 10), PKW(pB0, 12), PKW(pB0, 14)};
      pw2 = (u32x4){PKW(pB1, 0), PKW(pB1, 2), PKW(pB1, 4), PKW(pB1, 6)}; pw3 = (u32x4){PKW(pB1, 8), PKW(pB1, 10), PKW(pB1, 12), PKW(pB1, 14)};
      SBAR(); pv(o, (int)(uintptr_t)vp0 + sl_cur, PAF(0), PAF(1), PAF(2), PAF(3)); }
#undef PKW
#undef PAF
#undef VFR
#undef PIN
#undef MX3
#undef GAPA
#undef GAPB
#undef EX
#undef VRD
#undef KRD
#undef STEP
#undef ENDW
#undef KLOAD8
    { auto rr = __builtin_amdgcn_permlane32_swap(__float_as_uint(l_reg), __float_as_uint(l_reg), false, false); l_reg = __uint_as_float(rr[0]) + __uint_as_float(rr[1]); }
    if (MODE == 1) l_reg += __builtin_amdgcn_exp2f(p.sink[layer * 4 + h] * 1.4426950408889634f - mhat);
    {
        const int lnf = lane_id_fresh(), r32f = lnf & 31, hif = lnf >> 5;
        if (hif == 0) wsf[32 + r32f] = l_reg;
        asm volatile("s_waitcnt lgkmcnt(0)" ::: "memory");
        LAS bf16_t* stg = (LAS bf16_t*)(c.lds + F_OST) + wid * 2048;
#pragma unroll
        for (int r = 0; r < 16; ++r) { const int orow = crow(r, hif); const float rl = __builtin_amdgcn_rcpf(wsf[32 + orow]);
            stg[orow * 64 + r32f] = f2bf(o[0][r] * rl); stg[orow * 64 + 32 + r32f] = f2bf(o[1][r] * rl); }
        asm volatile("s_waitcnt lgkmcnt(0)" ::: "memory");
        bf16_t* Ow = YC + (size_t)qrow0 * D + ycol;
#pragma unroll
        for (int i = 0; i < 4; ++i) { const int row = i * 8 + (lnf >> 3), ch = lnf & 7; const u32x4 v = *(const LAS u32x4*)(stg + row * 64 + ch * 8); *(u32x4*)(Ow + (size_t)row * D + ch * 8) = v; } }
    asm volatile("s_waitcnt lgkmcnt(0)\n\ts_barrier" ::: "memory");
#undef DMA_K
#undef DMA_V
#undef CMASK
#undef START
#undef RESC
#undef ROT
#undef TROW
}
#undef SBAR
#undef WAIT_BAR
}

template <int MODE>
DI void phase_fa64(const Params& p, const Cx& c0, int layer, int ctxq, int first_blk = 0) {
    const Cx c = fresh(c0);
    const int nunits = ctxq ? NB * 4 : NB * 4 * 32;
    __syncthreads();
    for (int unit = c.vcu >= first_blk ? c.vcu - first_blk : c.vcu - first_blk + c.G; unit < nunits; unit += c.G) {
        const int qb = ctxq ? 0 : unit & 31, h = ctxq ? unit & 3 : (unit >> 5) & 3, b = ctxq ? unit >> 2 : unit >> 7;
        da2::unit64<MODE, 8>(p, c, layer, b, h, qb, ctxq);
    }
    __syncthreads();
}
template <int l>
DI void layer_body(const Params& p, const Cx& c, const XcdBarrier& bar) {
    unsigned char* ws = p.ws;
    bf16_t* H = (bf16_t*)(ws + OFF_H);
    bf16_t* P = (bf16_t*)(ws + OFF_A + A_P);
    bf16_t* ACT = (bf16_t*)(ws + OFF_A + A_ACT);
    const int bid = (int)blockIdx.x;
        if (l == 0) { phase_norm1(p, c, l); xcd_barrier(bar); }
        {
            pg8::Gemm g{H, (const bf16_t*)(ws + OFF_WIN) + (size_t)l * INW * D, D}; pg8::StaticOrder S; S.init(T, INW, D, c.G, bid);
            pg8::EpiWin E{P, (bf16_t*)(ws + OFF_A + A_VT), (const float2*)(ws + OFF_ROPE)};
            pg8::gemm_phase<pg8::EpiWin, pg8::StaticOrder, true, false>(c.lds, g, S, E, c.wave);
        }
        bg_convert<(l == 0 ? 0 : 3)>(p, c);
        xcd_barrier(bar);
        phase_ret_u_mfma(p, c, l);
        phase_fa64<1>(p, c, l, 0);
        phase_fa64<2>(p, c, l, 0);
        phase_da2(p, c, l, 0);
        xcd_barrier(bar);
        phase_ret_scan2(p, c, l);
        bg_convert<(l == 0 ? 4 : 5)>(p, c);
        if (l == 0) phase_ret_out_mfma<true>(p, c, l, 0, c.G >= 168 ? 160 : 0);
        if (l == 0 && c.G >= 160) { phase_fa64<1>(p, c, l, 1, 128); phase_fa64<2>(p, c, l, 1, 136); phase_da2(p, c, l, 1, 144); }
        else if (l == 0) { phase_fa64<1>(p, c, l, 1); phase_fa64<2>(p, c, l, 1); phase_da2(p, c, l, 1); }
        xcd_barrier(bar);
        phase_ret_out_mfma<false>(p, c, l, 2);
        xcd_barrier(bar);
        if (l == 0) {
            pg8::Gemm g{H, (const bf16_t*)(ws + OFF_WOUT) + (size_t)l * D * D, D}; pg8::SplitOrder S; S.init(TX, TC, D, D, WOUT_SPLIT, c.G, bid);
            pg8::EpiBf16 E{(bf16_t*)(ws + OFF_B), D, 0, 0, (float*)(ws + OFF_B + B_SLAB_Y), TX, TC, 1.f};
            pg8::gemm_phase<pg8::EpiBf16, pg8::SplitOrder, true, false>(c.lds, g, S, E, c.wave);
            bg_convert<1>(p, c);
        } else {
            pg8::Gemm g{H, (const bf16_t*)(ws + OFF_WOUT) + (size_t)l * D * D, D}; pg8::StaticOrder S; S.init(TX, D, D, c.G, bid);
            pg8::EpiBf16 E{(bf16_t*)(ws + OFF_B), D, 0, 0, nullptr, 0, 0, 1.f};
            pg8::gemm_phase<pg8::EpiBf16, pg8::StaticOrder, true, false>(c.lds, g, S, E, c.wave);
        }
        xcd_barrier(bar);
        phase_post_attn(p, c, l);
        xcd_barrier(bar);
        if (l == 0) {
            {
                pg8::Gemm g{(const bf16_t*)(ws + OFF_H8), (const bf16_t*)(ws + OFF_WGU), D}; pg8::StaticOrder S; S.init(T, 2 * FF, D / 2, c.G, bid);
                pg8::EpiSwiglu8 E{ws + OFF_A + A_ACT, FF, 0, W8_INV, ACT8_SCALE};
                pg8::gemm_phase<pg8::EpiSwiglu8, pg8::StaticOrder, true, false, true>(c.lds, g, S, E, c.wave); }
            bg_convert<2>(p, c);
            xcd_barrier(bar);
            {
                pg8::Gemm g{(const bf16_t*)(ws + OFF_A + A_ACT), (const bf16_t*)(ws + OFF_WD), FF}; pg8::SplitOrder S; S.init(TX, TC, D, FF / 2, FFD_SPLIT, c.G, bid);
                pg8::EpiBf16 E{(bf16_t*)(ws + OFF_B), D, 0, 0, (float*)(ws + OFF_B + B_SLAB_F), TX, TC, W8_INV / ACT8_SCALE};
                pg8::gemm_phase<pg8::EpiBf16, pg8::SplitOrder, true, false, true>(c.lds, g, S, E, c.wave); }
            xcd_barrier(bar);
        } else {
            {
                pg8::Gemm g{(const bf16_t*)(ws + OFF_H8), (const bf16_t*)(ws + OFF_MGU), D}; pg8::MoeOrder S; S.init((const unsigned*)(ws + OFF_CNT), (const int*)(ws + OFF_TLIST), 2 * ED / 256, D / 128, c.G, c.vcu);
                pg8::EpiSwiglu8 E{ws + OFF_A + A_ACT, ED, 2 * ED / 256, W8_INV, 1.f};
                pg8::gemm_phase<pg8::EpiSwiglu8, pg8::MoeOrder, true, true, true>(c.lds, g, S, E, c.wave); }
            xcd_barrier(bar);
            {
                pg8::Gemm g{(const bf16_t*)(ws + OFF_A + A_ACT), (const bf16_t*)(ws + OFF_MD), ED}; pg8::MoeOrder S; S.init((const unsigned*)(ws + OFF_CNT), (const int*)(ws + OFF_TLIST), D / 256, ED / 128, c.G, c.vcu);
                pg8::EpiBf16S E{(bf16_t*)(ws + OFF_B), D, D / 256, W8_INV};
                pg8::gemm_phase<pg8::EpiBf16S, pg8::MoeOrder, true, false, true>(c.lds, g, S, E, c.wave); }
            xcd_barrier(bar);
        }
        phase_post_ffn(p, c, l);
        if (l == 0) xcd_barrier(bar);
}

__global__ void __launch_bounds__(NTHREADS, 2) mega_fwd(Params p) {
    extern __shared__ __attribute__((aligned(16))) unsigned char lds_raw[];
    Cx c;
    c.lds = (LAS unsigned char*)lds_raw;
    c.tid = threadIdx.x; c.lane = c.tid & 63; c.wave = __builtin_amdgcn_readfirstlane(c.tid >> 6);
    c.G = gridDim.x; { const int bx = blockIdx.x; c.vcu = (c.G % 8 == 0) ? (bx % 8) * (c.G / 8) + bx / 8 : bx; }
    for (int u = c.tid; u < (LDS_BYTES - LDSCTL_OFF) / 4; u += NTHREADS) ((LAS unsigned*)(c.lds + LDSCTL_OFF))[u] = 0u;
    __syncthreads();
    XcdBarrier bar = xcd_barrier_post((unsigned*)(p.ws + OFF_BAR), (volatile LAS unsigned*)(c.lds + LDSCTL_OFF + 64));

    phase_convert(p, c);
    phase_mod(p, c);
    xcd_barrier(bar);
    layer_body<0>(p, c, bar);
    layer_body<1>(p, c, bar);
}

extern "C" void kernel_launch(void* const* d_in, const int* in_sizes, int n_in, void* d_out, int out_size, void* d_ws, size_t ws_size, hipStream_t stream) {
    static int grid = 0;
    if (grid == 0) {
        if (n_in != 28 || ws_size < WS_NEED) { fprintf(stderr, "kernel_launch: need 28 inputs and %zu bytes of workspace (got %d, %zu)\n", (size_t)WS_NEED, n_in, ws_size); grid = -1; return; }
        int dev = 0, cus = 0, per_cu = 0;
        if (hipGetDevice(&dev) != hipSuccess || hipDeviceGetAttribute(&cus, hipDeviceAttributeMultiprocessorCount, dev) != hipSuccess) { grid = -1; return; }
        if (hipFuncSetAttribute((const void*)mega_fwd, hipFuncAttributeMaxDynamicSharedMemorySize, LDS_BYTES) != hipSuccess) { fprintf(stderr, "kernel_launch: hipFuncSetAttribute failed\n"); grid = -1; return; }
        if (hipOccupancyMaxActiveBlocksPerMultiprocessor(&per_cu, (const void*)mega_fwd, NTHREADS, LDS_BYTES) != hipSuccess || per_cu < 1) { fprintf(stderr, "kernel_launch: occupancy query says %d\n", per_cu); }
        (void)hipGetLastError();
        grid = cus;
    }
    if (grid < 0) return;
    Params p{};
    const float* const* in = (const float* const*)d_in;
    p.x = in[0]; p.c = in[1]; p.ctx = in[2]; p.c_ctx = in[3]; p.w_mod = in[4]; p.b_mod = in[5]; p.g_attn_pre = in[6]; p.g_attn_post = in[7]; p.g_ffn_pre = in[8]; p.g_ffn_post = in[9];
    p.w_in = in[10]; p.w_out = in[11]; p.lq1 = in[12]; p.lk1 = in[13]; p.lq2 = in[14]; p.lk2 = in[15]; p.subln = in[16]; p.sink = in[17]; p.rpb = in[18]; p.gam_f = in[19]; p.gam_b = in[20];
    p.ffn_wg = in[21]; p.ffn_wu = in[22]; p.ffn_wd = in[23]; p.router = in[24]; p.moe_wg = in[25]; p.moe_wu = in[26]; p.moe_wd = in[27];
    p.out = (float*)d_out; p.ws = (unsigned char*)d_ws;
    if (hipMemsetAsync(d_ws, 0, CTL_ZERO_BYTES, stream) != hipSuccess) return;
    hipLaunchKernelGGL(mega_fwd, dim3(grid), dim3(NTHREADS), LDS_BYTES, stream, p);
}
```

```cpp
#include <hip/hip_runtime.h>
#include <stdint.h>
#include <stddef.h>
#include <stdio.h>

typedef unsigned short bf16_t;
typedef short bf16x8 __attribute__((ext_vector_type(8)));
typedef float f32x4 __attribute__((ext_vector_type(4)));
typedef unsigned u32x4 __attribute__((ext_vector_type(4)));
typedef unsigned u32x2 __attribute__((ext_vector_type(2)));
#define LAS __attribute__((address_space(3)))
#define DI __device__ __forceinline__
typedef LAS float lfloat;
typedef float f32x16 __attribute__((ext_vector_type(16)));
#define MFMA32(a, b, c) __builtin_amdgcn_mfma_f32_32x32x16_bf16((a), (b), (c), 0, 0, 0)

constexpr int D = 1024, SEQ = 8192, NB = 2, CTXL = 256;
constexpr int TX = NB * SEQ;
constexpr int TC = NB * CTXL;
constexpr int T = TX + TC;
constexpr int INW = 3072, FF = 2816, NE = 8, ED = 3584;
constexpr int NCH = 66;
constexpr float EPS = 1e-6f;
constexpr int MOE_ROWS = 34816;
constexpr int PASS_TILES = 64, PASS_ROWS = PASS_TILES * 256;
constexpr int PASS1_ROWS = MOE_ROWS - PASS_ROWS;
constexpr int NTHREADS = 512, NWAVES = 8;

constexpr int DA_Q = 0, DA_K = 256, DA_V = 512;
constexpr int SW_Q = 768, SW_K = 1024, SW_V = 1152;
constexpr int NA_Q = 1280, NA_K = 1536, NA_V = 1792;
constexpr int RT_Q = 2048, RT_K = 2304, RT_V = 2560, RT_G = 2816;

constexpr size_t al256(size_t x) { return (x + 255) & ~(size_t)255; }
constexpr size_t OFF_BAR = 0;
constexpr size_t OFF_CNT = 16384;
constexpr size_t CTL_ZERO_BYTES = 32768;
constexpr size_t OFF_MOD = 32768;
constexpr size_t OFF_ROPE = al256(OFF_MOD + 2 * 3 * 6144 * 4);
constexpr size_t OFF_TLIST = al256(OFF_ROPE + 128 * 24 * 8);
constexpr size_t OFF_TOKE = OFF_TLIST + 8 * 16384 * 4;
constexpr size_t OFF_TOKJ = OFF_TOKE + 16384 * 2 * 4;
constexpr size_t OFF_TOKW = OFF_TOKJ + 16384 * 2 * 4;
constexpr size_t OFF_XC = OFF_TOKW + 16384 * 2 * 4;
constexpr size_t OFF_WIN = OFF_XC + (size_t)TC * D * 4;
constexpr size_t OFF_WOUT = OFF_WIN + (size_t)2 * INW * D * 2;
constexpr size_t OFF_WGU = OFF_WOUT + (size_t)2 * D * D * 2;
constexpr size_t OFF_WD = OFF_WGU + (size_t)2 * FF * D * 2;
constexpr size_t OFF_MGU = OFF_WD + (size_t)D * FF * 2;
constexpr size_t OFF_MD = OFF_MGU + (size_t)NE * 2 * ED * D * 2;
constexpr size_t OFF_H8 = OFF_MD + (size_t)NE * D * ED;
constexpr size_t OFF_H = OFF_MD + (size_t)NE * D * ED * 2;
constexpr size_t OFF_A = OFF_H + (size_t)T * D * 2;
constexpr size_t A_P = 0;
constexpr size_t A_U = A_P + (size_t)T * INW * 2;
constexpr size_t A_S = A_U + (size_t)NB * 4 * 2 * NCH * 4096 * 4;
constexpr size_t A_VT = A_S + (size_t)NB * 4 * 2 * NCH * 4096 * 4;
constexpr int NKEY = CTXL + SEQ;
constexpr int VH_DA = 0, VH_SW = 4, VH_NA = 6, VH_RT = 10, NVH = 14;
constexpr size_t A_END = A_VT + (size_t)NB * NVH * 64 * NKEY * 2;
constexpr size_t A_ACT = 0;
constexpr size_t SZ_A = A_END > (size_t)MOE_ROWS * ED ? A_END : (size_t)MOE_ROWS * ED;
static_assert((size_t)T * D <= (size_t)NE * D * ED, "H8 fits behind MD8");
constexpr float ACT8_SCALE = 8.f;
constexpr float W8_SCALE = 64.f, W8_INV = 1.f / 64.f;
constexpr size_t OFF_B = OFF_A + al256(SZ_A);
constexpr size_t SZ_B = (size_t)MOE_ROWS * D * 2 > (size_t)T * D * 4 ? (size_t)MOE_ROWS * D * 2 : (size_t)T * D * 4;
constexpr size_t OFF_XS = OFF_B + al256(SZ_B);
constexpr size_t WS_NEED = OFF_XS + (size_t)T * D * 2;
constexpr int WOUT_SPLIT = 4, FFD_SPLIT = 11;
constexpr size_t B_SLAB_Y = (size_t)36 << 20;
constexpr size_t B_SLAB_F = B_SLAB_Y + (size_t)WOUT_SPLIT * TC * D * 4;
static_assert(B_SLAB_F + (size_t)FFD_SPLIT * TC * D * 4 <= SZ_B, "slabs fit");

constexpr int RING_BYTES = 131072, LDSCTL_OFF = RING_BYTES, LDS_BYTES = 147456;

struct Params {
    const float *x, *c, *ctx, *c_ctx, *w_mod, *b_mod, *g_attn_pre, *g_attn_post, *g_ffn_pre, *g_ffn_post, *w_in, *w_out;
    const float *lq1, *lk1, *lq2, *lk2, *subln, *sink, *rpb, *gam_f, *gam_b, *ffn_wg, *ffn_wu, *ffn_wd, *router, *moe_wg, *moe_wu, *moe_wd;
    float* out;
    unsigned char* ws;
};

DI float bf2f(bf16_t v) { return __uint_as_float(((unsigned)v) << 16); }
DI bf16_t f2bf(float f) { unsigned u = __float_as_uint(f); u += 0x7fffu + ((u >> 16) & 1u); return (bf16_t)(u >> 16); }
typedef __bf16 v2bf_t __attribute__((ext_vector_type(2)));
typedef float v2f_t __attribute__((ext_vector_type(2)));
DI unsigned pk2(float lo, float hi) { const v2f_t x = {lo, hi}; return __builtin_bit_cast(unsigned, __builtin_convertvector(x, v2bf_t)); }
DI float silu_f(float v) { return v / (1.f + __expf(-v)); }
DI int lane_id_fresh() { int ln; asm volatile("v_mbcnt_lo_u32_b32 %0, -1, 0\n\tv_mbcnt_hi_u32_b32 %0, -1, %0" : "=v"(ln)); return ln; }
DI float shx(float v, int mask, int lane) { return __int_as_float(__builtin_amdgcn_ds_bpermute((lane ^ mask) << 2, __float_as_int(v))); }
DI float wave_sum(float v, int lane) {
#pragma unroll
    for (int o = 1; o < 64; o <<= 1) v += shx(v, o, lane);
    return v;
}

DI const float* xin0_row(const Params& p, int row) { return row < TX ? p.x + (size_t)row * D : p.ctx + (size_t)(row - TX) * D; }
DI const float* mod_row(const Params& p, int layer, int row) {
    const int v = row < TX ? (row >> 13) : 2;
    return (const float*)(p.ws + OFF_MOD) + (size_t)(layer * 3 + v) * 6144;
}
#define XB_TMO      128
#define XB_XCNT(j)  (256  + 64 * (j))
#define XB_XSUB(j)  (1280 + 64 * (j))
#define XB_XGEN(j)  (2304 + 64 * (j))
#define XB_TOP      3328
#define XB_TOPGEN   3392
#define XCD_BAR_WORDS 3456
#define XB_SPIN_CAP (1u << 23)

__device__ __forceinline__ unsigned xb_ld(unsigned* p)              { return __hip_atomic_load(p, __ATOMIC_RELAXED, __HIP_MEMORY_SCOPE_AGENT); }
__device__ __forceinline__ unsigned xb_add(unsigned* p, unsigned v) { return __hip_atomic_fetch_add(p, v, __ATOMIC_RELAXED, __HIP_MEMORY_SCOPE_AGENT); }
__device__ __forceinline__ unsigned xb_xcc_id() { return (unsigned)__builtin_amdgcn_s_getreg((3 << 11) | 20) & 0xFu; }
#define XB_SPIN(cond, bar) do { unsigned _sp = 0; while (cond) { __builtin_amdgcn_s_sleep(1); \
    if ((++_sp & 255u) == 0u) { if (xb_ld(&(bar)[XB_TMO])) break; if (_sp > XB_SPIN_CAP) { atomicAdd(&(bar)[XB_TMO], 1u); break; } } } } while (0)

struct XcdBarrier {
    unsigned* bar; unsigned x;
    volatile LAS unsigned* st;
};

__device__ __forceinline__ XcdBarrier xcd_barrier_post(unsigned* bar, volatile LAS unsigned* st) {
    XcdBarrier b; b.bar = bar; b.x = xb_xcc_id(); b.st = st;
    if (threadIdx.x == 0) (void)xb_add(&bar[XB_XCNT(b.x)], 1u);
    return b;
}
__device__ __forceinline__ void xcd_barrier_complete(unsigned* bar, unsigned x, unsigned& nloc, unsigned& nx) {
    const unsigned G = gridDim.x * gridDim.y * gridDim.z;
    unsigned sum, cnt, mine, sp = 0u;
    for (;;) {
        sum = 0u; cnt = 0u; mine = 0u;
#pragma unroll
        for (unsigned j = 0; j < 16; ++j) { const unsigned c = xb_ld(&bar[XB_XCNT(j)]); sum += c; cnt += (c > 0u) ? 1u : 0u; mine = (j == x) ? c : mine; }
        if (sum == G) break;
        __builtin_amdgcn_s_sleep(1);
        if ((++sp & 255u) == 0u) { if (xb_ld(&bar[XB_TMO])) break; if (sp > XB_SPIN_CAP) { atomicAdd(&bar[XB_TMO], 1u); break; } }
    }
    nloc = mine > 0u ? mine : 1u; nx = cnt > 0u ? cnt : 1u;
}

__device__ __forceinline__ void xcd_barrier(const XcdBarrier& b) {
    asm volatile("s_waitcnt vmcnt(0)" ::: "memory");
    __syncthreads();
    if (threadIdx.x == 0) {
        unsigned* bar = b.bar;
        __builtin_amdgcn_s_waitcnt(0);
        unsigned nloc = b.st[0], nx = b.st[1];
        if (nloc == 0u) { xcd_barrier_complete(bar, b.x, nloc, nx); b.st[0] = nloc; b.st[1] = nx; }
        const unsigned old = xb_add(&bar[XB_XSUB(b.x)], 1u);
        const unsigned gen = old / nloc;
        if (old + 1u == (gen + 1u) * nloc) {
            __builtin_amdgcn_fence(__ATOMIC_RELEASE, "agent");
            asm volatile("s_waitcnt vmcnt(0)" ::: "memory");
            const unsigned og = xb_add(&bar[XB_TOP], 1u);
            const unsigned tg = og / nx;
            if (og + 1u == (tg + 1u) * nx) xb_add(&bar[XB_TOPGEN], 1u);
            else XB_SPIN(xb_ld(&bar[XB_TOPGEN]) == tg, bar);
            __builtin_amdgcn_fence(__ATOMIC_ACQUIRE, "agent");
            xb_add(&bar[XB_XGEN(b.x)], 1u);
            asm volatile("s_waitcnt vmcnt(0)" ::: "memory");
        } else {
            XB_SPIN(xb_ld(&bar[XB_XGEN(b.x)]) == gen, bar);
            __builtin_amdgcn_fence(__ATOMIC_ACQUIRE, "agent");
            asm volatile("s_waitcnt vmcnt(0)" ::: "memory");
        }
    }
    __syncthreads();
}
namespace pg8 {
typedef int v4i_t __attribute__((ext_vector_type(4)));
typedef int v8i_t __attribute__((ext_vector_type(8)));
constexpr int BM = 256, BK = 64, HALF = 128, HTB = HALF * BK * 2  , STAGE_BYTES = 8 * HTB, NXCD = 8, WGM = 8;
__host__ __device__ __forceinline__ int lds_byte(int r, int c) { const int st = (r >> 4) * 2 + (c >> 5), rr = r & 15, cc = c & 31, ob = rr * 64 + cc * 2; return st * 1024 + (ob ^ (((ob >> 9) & 1) << 5)); }
__host__ __device__ __forceinline__ void stage_rc(int b, int& R, int& C) { const int st = b / 1024, sb = b % 1024, swz = sb ^ (((sb >> 9) & 1) << 5); R = (st >> 1) * 16 + swz / 64; C = (st & 1) * 32 + (swz % 64) / 2; }
__host__ __device__ __forceinline__ int perm32(int rho) { const int n = rho >> 4, i = rho & 15; return 8 * (i >> 2) + 4 * n + (i & 3); }

struct Unit { int pm, pn, e, j0, kt0, nkt, slice; };
struct Gemm { const bf16_t* A; const bf16_t* Bt; int K; };

struct StaticOrder {
    int nM, nN, nwg, G, c, nkt;
    __device__ void init(int M, int N, int K, int G_, int c_) { nM = M / BM; nN = N / BM; nwg = nM * nN; G = G_; c = c_; nkt = K / BK; }
    __device__ bool next(int i, Unit& u) const {
        const long L = (long)i * G + c; if (L >= nwg) return false;
        int wgid = (int)L; { const int q = nwg / NXCD, r = nwg % NXCD, xcd = wgid % NXCD, off = wgid / NXCD; wgid = (xcd < r ? xcd * (q + 1) : r * (q + 1) + (xcd - r) * q) + off; }
        const int nig = WGM * nN, gid = wgid / nig, fm = gid * WGM, gsz = (nM - fm) < WGM ? (nM - fm) : WGM;
        u.pm = fm + ((wgid % nig) % gsz); u.pn = (wgid % nig) / gsz; u.e = 0; u.j0 = 0; u.kt0 = 0; u.nkt = nkt; u.slice = -1; return true;
    }
    __device__ __forceinline__ int arow(const Unit&, int) const { return 0; }
};
struct SplitOrder {
    StaticOrder main; int nExtra, S, nN, nktS;
    __device__ void init(int Mmain, int Mextra, int N, int K, int S_, int G_, int c_) { main.init(Mmain, N, K, G_, c_); nExtra = Mextra / BM; S = S_; nN = N / BM; nktS = (K / BK) / S_; }
    __device__ bool next(int i, Unit& u) const {
        const long L = (long)i * main.G + main.c;
        if (L < main.nwg) return main.next(i, u);
        const int idx = (int)(L - main.nwg); if (idx >= nExtra * nN * S) return false;
        const int sl = idx % S, r = idx / S;
        u.pm = main.nM + r / nN; u.pn = r % nN; u.e = 0; u.j0 = 0; u.kt0 = sl * nktS; u.nkt = nktS; u.slice = sl; return true;
    }
    __device__ __forceinline__ int arow(const Unit&, int) const { return 0; }
};

struct MoeOrder {
    int G, c, nN, t0, ntp, S, nktS; int tc[NE]; int cnt[NE]; const int* tlist;
    __device__ void init(const unsigned* cntp, const int* tl, int nN_, int nkt_, int G_, int c_) {
        G = G_; c = c_; nN = nN_; tlist = tl; S = 1; nktS = nkt_; int tot = 0;
#pragma unroll
        for (int e = 0; e < NE; ++e) { cnt[e] = (int)cntp[e]; tc[e] = (cnt[e] + 255) >> 8; tot += tc[e]; }
        t0 = 0; ntp = tot;
    }
    __device__ bool next(int i, Unit& u) const {
        const int L0 = i * G + c; if (L0 >= ntp * nN * S) return false;
        const int sl = L0 % S, L = L0 / S;
        const int g = L / (8 * nN), r = L - g * 8 * nN, gsz = (ntp - 8 * g) < 8 ? (ntp - 8 * g) : 8;
        const int pml = 8 * g + r % gsz, pnl = r / gsz, gt = t0 + pml;
        int e = 0, base = 0, run = 0; bool found = false;
#pragma unroll
        for (int k = 0; k < NE; ++k) { if (!found && gt < run + tc[k]) { e = k; base = run; found = true; } run += tc[k]; }
        u.pm = pml; u.pn = e * nN + pnl; u.e = e; u.j0 = (gt - base) * 256; u.kt0 = sl * nktS; u.nkt = nktS; u.slice = S > 1 ? sl : -1; return true;
    }
    __device__ __forceinline__ int arow(const Unit& u, int r) const {
        int j = u.j0 + r; int ce = 0;
#pragma unroll
        for (int k = 0; k < NE; ++k) ce = (u.e == k) ? cnt[k] : ce;
        if (j > ce - 1) j = ce - 1;
        return tlist[u.e * 16384 + j];
    }
};

struct EpiBf16 {
    bf16_t* O; int ldc; int row_off; int pn_mod; float* slab; int slab_row0, slab_rows; float scale;
    DI void operator()(const f32x4 (&acc)[2][2][4][2], const Unit& u, int wr, int wc, int fr, int fq) const {
        const int pn = pn_mod ? u.pn % pn_mod : u.pn;
        const int row0 = row_off + u.pm * BM + wr * 64 + fr, col0 = pn * BM + wc * 32 + 8 * fq;
        if (u.slice >= 0) {
#pragma unroll
            for (int ai = 0; ai < 2; ++ai)
#pragma unroll
                for (int m = 0; m < 4; ++m) { float* rowp = slab + ((size_t)u.slice * slab_rows + (row0 - slab_row0 + ai * HALF + m * 16)) * ldc + col0;
#pragma unroll
                    for (int bj = 0; bj < 2; ++bj) { *(f32x4*)(rowp + bj * HALF) = acc[ai][bj][m][0] * scale; *(f32x4*)(rowp + bj * HALF + 4) = acc[ai][bj][m][1] * scale; } }
            return;
        }
#pragma unroll
        for (int ai = 0; ai < 2; ++ai)
#pragma unroll
            for (int m = 0; m < 4; ++m) { bf16_t* rowp = O + (size_t)(row0 + ai * HALF + m * 16) * ldc + col0;
#pragma unroll
                for (int bj = 0; bj < 2; ++bj) { const f32x4 v0 = acc[ai][bj][m][0] * scale, v1 = acc[ai][bj][m][1] * scale;
                    u32x4 w; w.x = pk2(v0[0], v0[1]); w.y = pk2(v0[2], v0[3]); w.z = pk2(v1[0], v1[1]); w.w = pk2(v1[2], v1[3]);
                    *(u32x4*)(rowp + bj * HALF) = w; } }
    }
};
DI float clamp8(float x) { return fminf(fmaxf(x, -448.f), 448.f); }
DI unsigned pk4_fp8(float a, float b, float c_, float d) { int w = 0; w = __builtin_amdgcn_cvt_pk_fp8_f32(a, b, w, false); w = __builtin_amdgcn_cvt_pk_fp8_f32(c_, d, w, true); return (unsigned)w; }
struct EpiSwiglu8 {
    unsigned char* O; int ldc; int pn_mod; float sc, asc;
    DI void operator()(const f32x4 (&acc)[2][2][4][2], const Unit& u, int wr, int wc, int fr, int fq) const {
        const int pn = pn_mod ? u.pn % pn_mod : u.pn;
        const int row0 = u.pm * BM + wr * 64 + fr, col0 = pn * HALF + wc * 32 + 8 * fq;
        const float k1 = -sc * 1.4426950408889634f, k2 = sc * sc * asc;
#pragma unroll
        for (int ai = 0; ai < 2; ++ai)
#pragma unroll
            for (int m = 0; m < 4; ++m) {
                float o[8];
#pragma unroll
                for (int n = 0; n < 2; ++n)
#pragma unroll
                    for (int k = 0; k < 4; ++k) { const float ag = acc[ai][0][m][n][k], au = acc[ai][1][m][n][k];
                        const float r = __builtin_amdgcn_rcpf(1.f + __builtin_amdgcn_exp2f(ag * k1));
                        o[n * 4 + k] = __builtin_amdgcn_fmed3f((ag * k2) * au * r, -448.f, 448.f); }
                u32x2 w; w.x = pk4_fp8(o[0], o[1], o[2], o[3]); w.y = pk4_fp8(o[4], o[5], o[6], o[7]);
                *(u32x2*)(O + (size_t)(row0 + ai * HALF + m * 16) * ldc + col0) = w; }
    }
};
struct EpiBf16S {
    bf16_t* O; int ldc; int pn_mod; float scale;
    DI void operator()(const f32x4 (&acc)[2][2][4][2], const Unit& u, int wr, int wc, int fr, int fq) const {
        const int pn = pn_mod ? u.pn % pn_mod : u.pn;
        const int row0 = u.pm * BM + wr * 64 + fr, col0 = pn * BM + wc * 32 + 8 * fq;
#pragma unroll
        for (int ai = 0; ai < 2; ++ai)
#pragma unroll
            for (int m = 0; m < 4; ++m) { bf16_t* rowp = O + (size_t)(row0 + ai * HALF + m * 16) * ldc + col0;
#pragma unroll
                for (int bj = 0; bj < 2; ++bj) { const f32x4 v0 = acc[ai][bj][m][0] * scale, v1 = acc[ai][bj][m][1] * scale;
                    u32x4 w; w.x = pk2(v0[0], v0[1]); w.y = pk2(v0[2], v0[3]); w.z = pk2(v1[0], v1[1]); w.w = pk2(v1[2], v1[3]);
                    *(u32x4*)(rowp + bj * HALF) = w; } }
    }
};
struct EpiF32 {
    float* O; int ldc;
    DI void operator()(const f32x4 (&acc)[2][2][4][2], const Unit& u, int wr, int wc, int fr, int fq) const {
        const int row0 = u.pm * BM + wr * 64 + fr, col0 = u.pn * BM + wc * 32 + 8 * fq;
#pragma unroll
        for (int ai = 0; ai < 2; ++ai)
#pragma unroll
            for (int m = 0; m < 4; ++m) { float* rowp = O + (size_t)(row0 + ai * HALF + m * 16) * ldc + col0;
#pragma unroll
                for (int bj = 0; bj < 2; ++bj) { *(f32x4*)(rowp + bj * HALF) = acc[ai][bj][m][0]; *(f32x4*)(rowp + bj * HALF + 4) = acc[ai][bj][m][1]; } }
    }
};
struct EpiSwiglu {
    bf16_t* O; int ldc; int pn_mod;
    DI void operator()(const f32x4 (&acc)[2][2][4][2], const Unit& u, int wr, int wc, int fr, int fq) const {
        const int pn = pn_mod ? u.pn % pn_mod : u.pn;
        const int row0 = u.pm * BM + wr * 64 + fr, col0 = pn * HALF + wc * 32 + 8 * fq;
#pragma unroll
        for (int ai = 0; ai < 2; ++ai)
#pragma unroll
            for (int m = 0; m < 4; ++m) {
                float o[8];
#pragma unroll
                for (int n = 0; n < 2; ++n)
#pragma unroll
                    for (int k = 0; k < 4; ++k) { const float g = acc[ai][0][m][n][k], up = acc[ai][1][m][n][k]; o[n * 4 + k] = g * __builtin_amdgcn_rcpf(1.f + __expf(-g)) * up; }
                u32x4 w; w.x = pk2(o[0], o[1]); w.y = pk2(o[2], o[3]); w.z = pk2(o[4], o[5]); w.w = pk2(o[6], o[7]);
                *(u32x4*)(O + (size_t)(row0 + ai * HALF + m * 16) * ldc + col0) = w; }
    }
};


__host__ __device__ __forceinline__ int win_col_pos(int c) {
    if (c < 512) { const int g = (c >> 2) & 3; return (c & ~12) | ((g == 1 ? 2 : g == 2 ? 1 : g) << 2); }
    if ((c >= 768 && c < 1152) || (c >= 2048 && c < 2560)) { const int g = (c >> 2) & 7; return (c & ~28) | ((g < 4 ? 2 * g : 2 * (g - 4) + 1) << 2); }
    return c;
}
constexpr float DA_QSCALE = 0.17677669529663687f * 1.4426950408889634f, FA_QSCALE = 0.125f * 1.4426950408889634f;
struct EpiWin {
    bf16_t* P; bf16_t* VT; const float2* tab;
    DI void operator()(const f32x4 (&acc)[2][2][4][2], const Unit& u, int wr, int wc, int fr, int fq) const {
        const int lane = fq * 16 + fr;
        const bool xrows = u.pm < TX / BM;
#pragma unroll
        for (int bj = 0; bj < 2; ++bj) {
            const int cg = u.pn * BM + bj * HALF + wc * 32;
            int cls = 0;
            if (cg < 512) cls = 1;
            else if (cg < 768) cls = 0;
            else if (cg < 1152) cls = 2;
            else if (cg >= 2048 && cg < 2560) cls = 2;
            if (!xrows) cls = 0;
#pragma unroll
            for (int ai = 0; ai < 2; ++ai)
#pragma unroll
                for (int m = 0; m < 4; ++m) {
                    const int r = u.pm * BM + ai * HALF + wr * 64 + m * 16 + fr;
                    f32x4 v0 = acc[ai][bj][m][0], v1 = acc[ai][bj][m][1];
                    if (cg < 256) { v0 *= DA_QSCALE; v1 *= DA_QSCALE; }
                    else if ((cg >= 768 && cg < 1024) || (cg >= 1280 && cg < 1536)) { v0 *= FA_QSCALE; v1 *= FA_QSCALE; }
                    if (cls != 0) {
                        const int s = r & (SEQ - 1);
                        const int ax = cls == 1 ? (fq >> 1) : ((cg >> 5) & 1);
                        const int pos = ax ? (s & 63) : (s >> 6);
                        const float2* tb = tab + pos * 24 + (cls == 1 ? 4 * (fq & 1) : 8 + 4 * fq);
                        const f32x4 c01 = *(const f32x4*)(tb), c23 = *(const f32x4*)(tb + 2);
                        const f32x4 cs = (f32x4){c01[0], c01[2], c23[0], c23[2]}, sn = (f32x4){c01[1], c01[3], c23[1], c23[3]};
                        const f32x4 a = v0, b = v1;
                        v0 = a * cs - b * sn; v1 = b * cs + a * sn;
                    }
                    u32x4 w; w.x = pk2(v0[0], v0[1]); w.y = pk2(v0[2], v0[3]); w.z = pk2(v1[0], v1[1]); w.w = pk2(v1[2], v1[3]);
                    *(u32x4*)(P + (size_t)r * INW + cg + 8 * fq) = w;
                }
        }
    }
};

template <class Epi, class Sched, bool ALIGN_EPI, bool GATHER, bool FP8 = false>
DI void gemm_phase(LAS unsigned char* lds, const Gemm g, const Sched& S, const Epi& E, int wave_in) {
    int wv_ = wave_in; asm volatile("" : "+s"(wv_)); const int tid = lane_id_fresh() + 64 * wv_;
    const int wid = __builtin_amdgcn_readfirstlane(tid >> 6), lane = tid & 63, wr = wid >> 2, wc = wid & 3, fr = lane & 15, fq = lane >> 4;
    const int K = FP8 ? g.K / 2 : g.K;
    unsigned voffB[2]; int RA[2], CA[2];
#pragma unroll
    for (int i = 0; i < 2; ++i) { int R, C; stage_rc(tid * 16 + i * 8192, R, C); const int Rb = (R & ~31) + perm32(R & 31);
        RA[i] = R; CA[i] = C; voffB[i] = (unsigned)(Rb * K + C) * 2u; }
    const size_t kstep = (size_t)(BK * 2);
    const size_t hstep = (size_t)HALF * K * 2;
    const size_t tstep = 2 * hstep;
    const unsigned ldsw = (unsigned)wid * 1024u;
    const int aoff = lds_byte(wr * 64 + fr, fq * 8), boff = lds_byte(wc * 32 + fr, fq * 8);
#define PG8_SA(b, h) (((b) * 2 + (h)) * HTB)
#define PG8_SB(b, h) ((4 + (b) * 2 + (h)) * HTB)
#define PG8_STAGE(bufoff, gbase, voff) do { _Pragma("unroll") for (int _i = 0; _i < 2; ++_i) \
        __builtin_amdgcn_global_load_lds((const unsigned*)((const char*)(gbase) + (voff)[_i]), (LAS unsigned*)(lds + (bufoff) + ldsw + _i * 8192), 16, 0, 0); } while (0)
#define PG8_LDA(dst, b, h) do { _Pragma("unroll") for (int m = 0; m < 4; ++m) { \
        if constexpr (FP8) dst##8[m] = __builtin_shufflevector(*(const LAS v4i_t*)(lds + PG8_SA(b, h) + aoff + m * 2048), *(const LAS v4i_t*)(lds + PG8_SA(b, h) + aoff + m * 2048 + 1024), 0, 1, 2, 3, 4, 5, 6, 7); \
        else { _Pragma("unroll") for (int k = 0; k < 2; ++k) dst[m][k] = *(const LAS bf16x8*)(lds + PG8_SA(b, h) + aoff + m * 2048 + k * 1024); } } } while (0)
#define PG8_LDB(dst, b, h) do { _Pragma("unroll") for (int n = 0; n < 2; ++n) { \
        if constexpr (FP8) dst##8[n] = __builtin_shufflevector(*(const LAS v4i_t*)(lds + PG8_SB(b, h) + boff + n * 2048), *(const LAS v4i_t*)(lds + PG8_SB(b, h) + boff + n * 2048 + 1024), 0, 1, 2, 3, 4, 5, 6, 7); \
        else { _Pragma("unroll") for (int k = 0; k < 2; ++k) dst[n][k] = *(const LAS bf16x8*)(lds + PG8_SB(b, h) + boff + n * 2048 + k * 1024); } } } while (0)
#define PG8_MMA(ai, bj, At, Bt) do { __builtin_amdgcn_s_setprio(1); _Pragma("unroll") for (int m = 0; m < 4; ++m) _Pragma("unroll") for (int n = 0; n < 2; ++n) { \
        if constexpr (FP8) asm volatile("v_mfma_f32_16x16x128_f8f6f4 %0, %1, %2, %0" : "+v"(acc[ai][bj][m][n]) : "v"(Bt##8[n]), "v"(At##8[m]));   \
        else { _Pragma("unroll") for (int k = 0; k < 2; ++k) acc[ai][bj][m][n] = __builtin_amdgcn_mfma_f32_16x16x32_bf16(Bt[n][k], At[m][k], acc[ai][bj][m][n], 0, 0, 0); } } \
        __builtin_amdgcn_s_setprio(0); } while (0)
#define PG8_WAIT_V(n) asm volatile("s_waitcnt vmcnt(" #n ")" ::: "memory")
#define PG8_WAIT_L(n) asm volatile("s_waitcnt lgkmcnt(" #n ")" ::: "memory")
#define PG8_BAR __builtin_amdgcn_s_barrier()
#define PG8_SCHED __builtin_amdgcn_sched_barrier(0)
#define PG8_SETV(V, u) do { _Pragma("unroll") for (int _h = 0; _h < 2; ++_h) _Pragma("unroll") for (int _i = 0; _i < 2; ++_i) \
        V[_h][_i] = GATHER ? (unsigned)S.arow(u, _h * HALF + RA[_i]) * (unsigned)(K * 2) + (unsigned)(CA[_i] * 2) : (unsigned)(_h * (int)hstep) + (unsigned)(RA[_i] * K + CA[_i]) * 2u; } while (0)
    Unit cur, nxt; int ui = 0;
    if (!S.next(0, cur)) return;
    f32x4 acc[2][2][4][2];
#pragma unroll
    for (int a = 0; a < 2; ++a)
#pragma unroll
        for (int b = 0; b < 2; ++b)
#pragma unroll
            for (int m = 0; m < 4; ++m)
#pragma unroll
                for (int n = 0; n < 2; ++n) acc[a][b][m][n] = (f32x4){0.f, 0.f, 0.f, 0.f};
    bf16x8 At[4][2], B0[2][2], B1[2][2];
    v8i_t At8[4], B08[2], B18[2];
    unsigned vA[2][2], vN[2][2];
    PG8_SETV(vA, cur);
    if (GATHER) PG8_WAIT_V(0);
    int nt = cur.nkt;
    const char* cA = (GATHER ? (const char*)g.A : (const char*)g.A + (size_t)cur.pm * tstep) + (size_t)cur.kt0 * kstep; const char* cB = (const char*)g.Bt + (size_t)cur.pn * tstep + (size_t)cur.kt0 * kstep;
    PG8_STAGE(PG8_SB(0, 0), cB, voffB); PG8_STAGE(PG8_SB(0, 1), cB + hstep, voffB); PG8_STAGE(PG8_SA(0, 0), cA, vA[0]); PG8_STAGE(PG8_SA(0, 1), cA, vA[1]);
    if (wr == 1) PG8_BAR;
    PG8_WAIT_V(2); PG8_BAR;
    PG8_STAGE(PG8_SB(1, 0), cB + kstep, voffB); PG8_STAGE(PG8_SA(1, 0), cA + kstep, vA[0]); PG8_STAGE(PG8_SB(1, 1), cB + hstep + kstep, voffB);
    PG8_WAIT_V(6); PG8_BAR;
    for (;;) {
        const bool has_next = S.next(ui + 1, nxt);
        if constexpr (GATHER) {
            if (has_next) { PG8_SETV(vN, nxt); }
            else {
#pragma unroll
                for (int h = 0; h < 2; ++h)
#pragma unroll
                    for (int i = 0; i < 2; ++i) vN[h][i] = vA[h][i]; }
        }
        const char* nA = has_next ? (GATHER ? (const char*)g.A : (const char*)g.A + (size_t)nxt.pm * tstep) + (size_t)nxt.kt0 * kstep : cA; const char* nB = has_next ? (const char*)g.Bt + (size_t)nxt.pn * tstep + (size_t)nxt.kt0 * kstep : cB;
        for (int t = 0; t < nt; t += 2) {
            const bool last = (t == nt - 2);
            const char* a1 = cA + (size_t)(t + 1) * kstep;
            const char* a2 = last ? nA : cA + (size_t)(t + 2) * kstep; const char* b2 = last ? nB : cB + (size_t)(t + 2) * kstep;
            const char* a3 = a2 + kstep; const char* b3 = b2 + kstep;
            unsigned w0[2], w1[2];
#pragma unroll
            for (int i = 0; i < 2; ++i) { w0[i] = (GATHER && last) ? vN[0][i] : vA[0][i]; w1[i] = (GATHER && last) ? vN[1][i] : vA[1][i]; }
            PG8_LDB(B0, 0, 0); PG8_LDB(B1, 0, 1); PG8_SCHED; PG8_LDA(At, 0, 0); PG8_STAGE(PG8_SA(1, 1), a1, vA[1]);
            PG8_WAIT_V(8); PG8_WAIT_L(0); PG8_BAR; PG8_MMA(0, 0, At, B0); PG8_MMA(0, 1, At, B1); PG8_BAR; PG8_SCHED;
            PG8_LDA(At, 0, 1); PG8_STAGE(PG8_SB(0, 0), b2, voffB); PG8_STAGE(PG8_SB(0, 1), b2 + hstep, voffB); PG8_STAGE(PG8_SA(0, 0), a2, w0);
            PG8_WAIT_V(8); PG8_WAIT_L(0); PG8_BAR; PG8_MMA(1, 0, At, B0); PG8_MMA(1, 1, At, B1); PG8_BAR; PG8_SCHED;
            PG8_LDB(B0, 1, 0); PG8_LDB(B1, 1, 1); PG8_SCHED; PG8_LDA(At, 1, 0); PG8_STAGE(PG8_SA(0, 1), a2, w1);
            PG8_WAIT_V(8); PG8_WAIT_L(0); PG8_BAR; PG8_MMA(0, 0, At, B0); PG8_MMA(0, 1, At, B1); PG8_BAR; PG8_SCHED;
            PG8_LDA(At, 1, 1); PG8_STAGE(PG8_SB(1, 0), b3, voffB); PG8_STAGE(PG8_SB(1, 1), b3 + hstep, voffB); PG8_STAGE(PG8_SA(1, 0), a3, w0);
            PG8_WAIT_V(8); PG8_WAIT_L(0); PG8_BAR; PG8_MMA(1, 0, At, B0); PG8_MMA(1, 1, At, B1); PG8_BAR; PG8_SCHED;
        }
        if constexpr (ALIGN_EPI) { if (wr == 0) PG8_BAR; }
        if constexpr (FP8) asm volatile("s_nop 15\n\ts_nop 15" ::: "memory");
        E(acc, cur, wr, wc, fr, fq);
        if (!has_next) break;
#pragma unroll
        for (int a = 0; a < 2; ++a)
#pragma unroll
            for (int b = 0; b < 2; ++b)
#pragma unroll
                for (int m = 0; m < 4; ++m)
#pragma unroll
                    for (int n = 0; n < 2; ++n) acc[a][b][m][n] = (f32x4){0.f, 0.f, 0.f, 0.f};
        cur = nxt; cA = nA; cB = nB; ++ui; nt = cur.nkt;
        if constexpr (GATHER) {
#pragma unroll
            for (int h = 0; h < 2; ++h)
#pragma unroll
                for (int i = 0; i < 2; ++i) vA[h][i] = vN[h][i]; }
        if constexpr (ALIGN_EPI) { if (wr == 1) PG8_BAR; }
    }
    PG8_WAIT_V(0);
    if constexpr (!ALIGN_EPI) { if (wr == 0) PG8_BAR; }
    PG8_BAR;
#undef PG8_SA
#undef PG8_SB
#undef PG8_STAGE
#undef PG8_LDA
#undef PG8_LDB
#undef PG8_MMA
#undef PG8_WAIT_V
#undef PG8_WAIT_L
#undef PG8_BAR
#undef PG8_SCHED
#undef PG8_SETV
}
}
DI f32x4 ld_bf4(const bf16_t* p) { const u32x2 a = *(const u32x2*)p; f32x4 r; r.x = __uint_as_float(a.x << 16); r.y = __uint_as_float(a.x & 0xffff0000u); r.z = __uint_as_float(a.y << 16); r.w = __uint_as_float(a.y & 0xffff0000u); return r; }
struct Cx { LAS unsigned char* lds; int tid, lane, wave, vcu, G; };
DI Cx fresh(const Cx& c0) { Cx c; int g = c0.G, v = c0.vcu, w = c0.wave; asm volatile("" : "+s"(g), "+s"(v), "+s"(w));
    const int ln = lane_id_fresh();
    c.lds = c0.lds; c.wave = w; c.lane = ln; c.tid = w * 64 + ln; c.vcu = v; c.G = g; return c; }

template <bool WINPERM = false>
DI void tcvt_item(const float* W, int K, int N, bf16_t* WT, int rstride, int roff, LAS float* scr, int item, int lane) {
    const int nblk = N / 32, kb = item / nblk, nb = item % nblk, k0 = 64 * kb, n0 = 32 * nb;
#pragma unroll 8
    for (int i = 0; i < 32; ++i) { const int kk = 2 * i + (lane >> 5); scr[kk * 33 + (lane & 31)] = W[(size_t)(k0 + kk) * N + n0 + (lane & 31)]; }
    asm volatile("s_waitcnt lgkmcnt(0)" ::: "memory");
    const int c = lane & 7;
#pragma unroll
    for (int j = 0; j < 4; ++j) { const int n = (lane >> 3) + 8 * j; const LAS float* s = scr + (8 * c) * 33 + n;
        u32x4 o; o.x = pk2(s[0 * 33], s[1 * 33]); o.y = pk2(s[2 * 33], s[3 * 33]); o.z = pk2(s[4 * 33], s[5 * 33]); o.w = pk2(s[6 * 33], s[7 * 33]);
        const int ncol = WINPERM ? pg8::win_col_pos(n0 + n) : n0 + n, drow = (ncol >> 7) * rstride + roff + (ncol & 127);
        *(u32x4*)(WT + (size_t)drow * K + k0 + 8 * c) = o; }
    asm volatile("s_waitcnt lgkmcnt(0)" ::: "memory");
}
DI void tcvt_item8(const float* W, int K, int N, unsigned char* WT, int rstride, int roff, LAS float* scr, int item, int lane) {
    const int nblk = N / 32, kb = item / nblk, nb = item % nblk, k0 = 64 * kb, n0 = 32 * nb;
#pragma unroll 8
    for (int i = 0; i < 32; ++i) { const int kk = 2 * i + (lane >> 5); scr[kk * 33 + (lane & 31)] = W[(size_t)(k0 + kk) * N + n0 + (lane & 31)]; }
    asm volatile("s_waitcnt lgkmcnt(0)" ::: "memory");
    const int c = lane & 7;
#pragma unroll
    for (int j = 0; j < 4; ++j) { const int n = (lane >> 3) + 8 * j; const LAS float* s = scr + (8 * c) * 33 + n;
        u32x2 o; o.x = pg8::pk4_fp8(s[0 * 33] * W8_SCALE, s[1 * 33] * W8_SCALE, s[2 * 33] * W8_SCALE, s[3 * 33] * W8_SCALE); o.y = pg8::pk4_fp8(s[4 * 33] * W8_SCALE, s[5 * 33] * W8_SCALE, s[6 * 33] * W8_SCALE, s[7 * 33] * W8_SCALE);
        const int ncol = n0 + n, drow = (ncol >> 7) * rstride + roff + (ncol & 127);
        *(u32x2*)(WT + (size_t)drow * K + k0 + 8 * c) = o; }
    asm volatile("s_waitcnt lgkmcnt(0)" ::: "memory");
}
constexpr int I_IN = 16 * 96, I_OUT = 16 * 32, I_FG = 16 * 88, I_FD = 44 * 32, I_MG = 16 * 112, I_MD = 56 * 32, MOE_ITEMS = 16 * I_MG + 8 * I_MD;
constexpr int BG_N = 6;
constexpr int bg_cu0(int w) { return w == 0 ? 24 : w == 1 ? 32 : w == 2 ? 172 : w == 3 ? 24 : w == 4 ? 168 : 128; }
constexpr int bg_pw(int w) { return w == 0 ? 5 : w == 1 ? 2 : w == 2 ? 4 : w == 3 ? 5 : 2; }
constexpr int bg_count(int w) { return (256 - bg_cu0(w)) * NWAVES * bg_pw(w); }
constexpr int bg_base(int w) { return w >= BG_N ? MOE_ITEMS : bg_base(w + 1) - bg_count(w); }
DI void moe_item(const Params& p, LAS float* scr, int r, int lane) {
    unsigned char* ws = p.ws;
    if (r < 16 * I_MG) { const int q = r / I_MG, u = q >> 3, e = q & 7;
        tcvt_item8((u ? p.moe_wu : p.moe_wg) + (size_t)e * D * ED, D, ED, ws + OFF_MGU + (size_t)e * 2 * ED * D, 256, u * 128, scr, r % I_MG, lane); return; }
    r -= 16 * I_MG;
    { const int e = r / I_MD; tcvt_item8(p.moe_wd + (size_t)e * ED * D, ED, D, ws + OFF_MD + (size_t)e * D * ED, 128, 0, scr, r % I_MD, lane); }
}
template <int W>
DI void bg_convert(const Params& p, const Cx& c0) {
    constexpr int CU0 = bg_cu0(W), PW = bg_pw(W), BASE = bg_base(W);
    if (c0.G != 256) return;
    const int bid = (int)blockIdx.x;
    if (bid < CU0) return;
    const Cx c = fresh(c0);
    LAS float* scr = (LAS float*)(c.lds + c.wave * 16384);
    const int first = BASE + ((bid - CU0) * NWAVES + c.wave) * PW;
    for (int k = 0; k < PW; ++k) moe_item(p, scr, first + k, c.lane);
}
DI void phase_convert(const Params& p, const Cx& c0) {
    const Cx c = fresh(c0);
    LAS float* scr = (LAS float*)(c.lds + c.wave * 16384);
    unsigned char* ws = p.ws;
    const int gw = c.vcu * NWAVES + c.wave, NGW = c.G * NWAVES;
    constexpr int NFIX = 2 * I_IN + 2 * I_OUT + 2 * I_FG + I_FD;
    constexpr int MOE_PRO = bg_base(0);
    const int NITEMS = NFIX + (c.G == 256 ? MOE_PRO : MOE_ITEMS);
    for (int it = gw; it < NITEMS; it += NGW) {
        int r = it;
        if (r < 2 * I_IN) { const int l = r / I_IN; tcvt_item<true>(p.w_in + (size_t)l * D * INW, D, INW, (bf16_t*)(ws + OFF_WIN) + (size_t)l * INW * D, 128, 0, scr, r % I_IN, c.lane); continue; } r -= 2 * I_IN;
        if (r < 2 * I_OUT) { const int l = r / I_OUT; tcvt_item(p.w_out + (size_t)l * D * D, D, D, (bf16_t*)(ws + OFF_WOUT) + (size_t)l * D * D, 128, 0, scr, r % I_OUT, c.lane); continue; } r -= 2 * I_OUT;
        if (r < 2 * I_FG) { const int u = r / I_FG; tcvt_item8(u ? p.ffn_wu : p.ffn_wg, D, FF, ws + OFF_WGU, 256, u * 128, scr, r % I_FG, c.lane); continue; } r -= 2 * I_FG;
        if (r < I_FD) { tcvt_item8(p.ffn_wd, FF, D, ws + OFF_WD, 128, 0, scr, r, c.lane); continue; } r -= I_FD;
        moe_item(p, scr, r, c.lane);
    }
}
DI void phase_mod(const Params& p, const Cx& c0) {
    const Cx c = fresh(c0);
    for (int i = c.vcu * NTHREADS + c.tid; i < 128 * 24; i += c.G * NTHREADS) {
        const int pos = i / 24, e = i % 24;
        const float inv = e < 8 ? powf(10000.f, -(float)e * 2.0f / 16.0f) : powf(10000.f, -(float)(e - 8) * 2.0f / 32.0f);
        float sn, cs; sincosf((float)pos * inv, &sn, &cs);
        ((float2*)(p.ws + OFF_ROPE))[i] = make_float2(cs, sn);
    }
    LAS float* red = (LAS float*)(c.lds);
    LAS float* sl = red + 8 * 48 * 3;
    __syncthreads();
    for (int i = c.tid; i < 3 * 1024; i += NTHREADS) sl[i] = silu_f(i < 1024 ? p.c[i] : i < 2048 ? p.c[i] : p.c_ctx[i - 2048]);
    for (int cb = c.vcu; cb < 256; cb += c.G) {
        __syncthreads();
        if (c.tid < 384) {
            const int cl = c.tid % 48, kg = c.tid / 48, gc = cb * 48 + cl, layer = gc / 6144, col = gc % 6144;
            const float* w = p.w_mod + (size_t)layer * D * 6144 + col;
            float a0 = 0.f, a1 = 0.f, a2 = 0.f;
#pragma unroll 16
            for (int k = kg * 128; k < kg * 128 + 128; ++k) { const float wv = w[(size_t)k * 6144]; a0 += sl[k] * wv; a1 += sl[1024 + k] * wv; a2 += sl[2048 + k] * wv; }
            red[(kg * 48 + cl) * 3 + 0] = a0; red[(kg * 48 + cl) * 3 + 1] = a1; red[(kg * 48 + cl) * 3 + 2] = a2;
        }
        __syncthreads();
        if (c.tid < 144) {
            const int cl = c.tid % 48, v = c.tid / 48, gc = cb * 48 + cl, layer = gc / 6144, col = gc % 6144;
            float s = p.b_mod[layer * 6144 + col];
#pragma unroll
            for (int kg = 0; kg < 8; ++kg) s += red[(kg * 48 + cl) * 3 + v];
            ((float*)(p.ws + OFF_MOD))[(size_t)(layer * 3 + v) * 6144 + col] = s;
        }
    }
    __syncthreads();
}
DI void phase_norm1(const Params& p, const Cx& c0, int layer) {
    const Cx c = fresh(c0);
    const int gw = c.vcu * NWAVES + c.wave, NGW = c.G * NWAVES;
    f32x4 v[4], vn[4];
    if (gw < T) { const f32x4* xr = (const f32x4*)xin0_row(p, gw) + c.lane;
#pragma unroll
        for (int j = 0; j < 4; ++j) v[j] = xr[64 * j]; }
    for (int row = gw; row < T; row += NGW) {
        if (row + NGW < T) { const f32x4* xn = (const f32x4*)xin0_row(p, row + NGW) + c.lane;
#pragma unroll
            for (int j = 0; j < 4; ++j) vn[j] = xn[64 * j]; }
        float s = 0.f;
#pragma unroll
        for (int j = 0; j < 4; ++j) s += (v[j].x * v[j].x + v[j].y * v[j].y) + (v[j].z * v[j].z + v[j].w * v[j].w);
        const float r = rsqrtf(wave_sum(s, c.lane) * (1.f / D) + EPS);
        const float* mod = mod_row(p, layer, row);
        const float* g = p.g_attn_pre + layer * D;
        bf16_t* h = (bf16_t*)(p.ws + OFF_H) + (size_t)row * D;
#pragma unroll
        for (int j = 0; j < 4; ++j) { const int idx = (c.lane + 64 * j) * 4;
            const f32x4 gg = *(const f32x4*)(g + idx), sh = *(const f32x4*)(mod + idx), sc = *(const f32x4*)(mod + 1024 + idx);
            const f32x4 o = v[j] * r * gg * (sc + 1.f) + sh;
            uint2 w; w.x = pk2(o.x, o.y); w.y = pk2(o.z, o.w); *(uint2*)(h + idx) = w; }
#pragma unroll
        for (int j = 0; j < 4; ++j) v[j] = vn[j];
    }
}
DI int ret_row(int b, int n) { return n < 2 ? TX + b * CTXL + n * 128 : b * SEQ + (n - 2) * 128; }
DI float logsig(float g) { return -log1pf(expf(-g)); }

DI void phase_post_attn(const Params& p, const Cx& c0, int layer) {
    const Cx c = fresh(c0);
    const int gw = c.vcu * NWAVES + c.wave, NGW = c.G * NWAVES, rows = layer == 0 ? T : TX;
    constexpr int RT_MAXSEL = 512;
    LAS int* rsel = (LAS int*)(c.lds + c.wave * (RT_MAXSEL * 16 + 64));
    int nsel = 0;
    f32x4 y[4], x1[4], yn[4], xn[4];
    auto load_row = [&](int row, f32x4 (&yy)[4], f32x4 (&xx)[4]) {
        const bf16_t* yr = (const bf16_t*)(p.ws + OFF_B) + (size_t)row * D + c.lane * 4;
        const f32x4* xr = (const f32x4*)xin0_row(p, row) + c.lane;
        const bf16_t* xsr = (const bf16_t*)(p.ws + OFF_XS) + (size_t)row * D;
#pragma unroll
        for (int j = 0; j < 4; ++j) {
            if (layer == 0 && row >= TX) { const float* sl = (const float*)(p.ws + OFF_B + B_SLAB_Y) + (size_t)(row - TX) * D + (c.lane + 64 * j) * 4;
                yy[j] = *(const f32x4*)sl;
#pragma unroll
                for (int k = 1; k < WOUT_SPLIT; ++k) yy[j] = yy[j] + *(const f32x4*)(sl + (size_t)k * TC * D); }
            else yy[j] = ld_bf4(yr + 256 * j);
            xx[j] = layer == 0 ? xr[64 * j] : ld_bf4(xsr + (c.lane + 64 * j) * 4); }
    };
    if (gw < rows) load_row(gw, y, x1);
    for (int row = gw; row < rows; row += NGW) {
        if (row + NGW < rows) load_row(row + NGW, yn, xn);
        bf16_t* xs = (bf16_t*)(p.ws + OFF_XS) + (size_t)row * D;
        float s = 0.f;
#pragma unroll
        for (int j = 0; j < 4; ++j) s += (y[j].x * y[j].x + y[j].y * y[j].y) + (y[j].z * y[j].z + y[j].w * y[j].w);
        const float r = rsqrtf(wave_sum(s, c.lane) * (1.f / D) + EPS);
        const float* mod = mod_row(p, layer, row);
        float s2 = 0.f;
#pragma unroll
        for (int j = 0; j < 4; ++j) { const int idx = (c.lane + 64 * j) * 4;
            const f32x4 gp = *(const f32x4*)(p.g_attn_post + layer * D + idx), gt = *(const f32x4*)(mod + 2048 + idx);
            x1[j] = x1[j] + gt * (y[j] * r * gp);
            { u32x2 w; w.x = pk2(x1[j].x, x1[j].y); w.y = pk2(x1[j].z, x1[j].w); *(u32x2*)(xs + idx) = w; }
            s2 += (x1[j].x * x1[j].x + x1[j].y * x1[j].y) + (x1[j].z * x1[j].z + x1[j].w * x1[j].w); }
        const float r2 = rsqrtf(wave_sum(s2, c.lane) * (1.f / D) + EPS);
        bf16_t* h = (bf16_t*)(p.ws + OFF_H) + (size_t)row * D;
        float l8[8];
#pragma unroll
        for (int e = 0; e < 8; ++e) l8[e] = 0.f;
#pragma unroll
        for (int j = 0; j < 4; ++j) { const int idx = (c.lane + 64 * j) * 4;
            const f32x4 g2 = *(const f32x4*)(p.g_ffn_pre + layer * D + idx), sh = *(const f32x4*)(mod + 3072 + idx), sc = *(const f32x4*)(mod + 4096 + idx);
            const f32x4 hv = x1[j] * r2 * g2 * (sc + 1.f) + sh;
            *(unsigned*)(p.ws + OFF_H8 + (size_t)row * D + idx) = pg8::pk4_fp8(pg8::clamp8(hv.x), pg8::clamp8(hv.y), pg8::clamp8(hv.z), pg8::clamp8(hv.w));
            if (layer == 1) {
#pragma unroll
                for (int i = 0; i < 4; ++i) { const f32x4 ra = *(const f32x4*)(p.router + (size_t)(idx + i) * 8), rb = *(const f32x4*)(p.router + (size_t)(idx + i) * 8 + 4);
                    const float hh = hv[i];
                    l8[0] += hh * ra.x; l8[1] += hh * ra.y; l8[2] += hh * ra.z; l8[3] += hh * ra.w; l8[4] += hh * rb.x; l8[5] += hh * rb.y; l8[6] += hh * rb.z; l8[7] += hh * rb.w; }
            } }
        if (layer == 1) {
#pragma unroll
            for (int e = 0; e < 8; ++e) l8[e] = wave_sum(l8[e], c.lane);
            if (c.lane == 0) {
                int i0 = 0; float v0 = l8[0];
#pragma unroll
                for (int e = 1; e < 8; ++e) if (l8[e] > v0) { v0 = l8[e]; i0 = e; }
                int i1 = -1; float v1 = -3.0e38f;
#pragma unroll
                for (int e = 0; e < 8; ++e) if (e != i0 && l8[e] > v1) { v1 = l8[e]; i1 = e; }
                const float e1 = expf(v1 - v0); const float w0 = 1.f / (1.f + e1), w1 = e1 / (1.f + e1);
                if (nsel < RT_MAXSEL) { rsel[nsel * 4] = row; rsel[nsel * 4 + 1] = i0 | (i1 << 8); rsel[nsel * 4 + 2] = __float_as_int(w0); rsel[nsel * 4 + 3] = __float_as_int(w1); }
            }
            ++nsel;
        }
#pragma unroll
        for (int j = 0; j < 4; ++j) { y[j] = yn[j]; x1[j] = xn[j]; }
    }
    if (layer == 1) {
        asm volatile("s_waitcnt lgkmcnt(0)" ::: "memory");
        unsigned* cnt = (unsigned*)(p.ws + OFF_CNT);
        int* tl = (int*)(p.ws + OFF_TLIST); int* te = (int*)(p.ws + OFF_TOKE); int* tj = (int*)(p.ws + OFF_TOKJ); float* tw = (float*)(p.ws + OFF_TOKW);
        LAS int* rbase = rsel + RT_MAXSEL * 4;
        if (c.lane < 8) { int n = 0;
            for (int k = 0; k < nsel; ++k) { const int ee = rsel[k * 4 + 1]; n += ((ee & 255) == c.lane) + ((ee >> 8) == c.lane); }
            rbase[c.lane] = n > 0 ? (int)atomicAdd(&cnt[c.lane], (unsigned)n) : 0; }
        asm volatile("s_waitcnt vmcnt(0) lgkmcnt(0)" ::: "memory");
        if (c.lane == 0) {
            for (int k = 0; k < nsel; ++k) { const int row = rsel[k * 4], ee = rsel[k * 4 + 1], i0 = ee & 255, i1 = ee >> 8;
                const int j0 = rbase[i0]; rbase[i0] = j0 + 1; const int j1 = rbase[i1]; rbase[i1] = j1 + 1;
                tl[i0 * 16384 + j0] = row; tl[i1 * 16384 + j1] = row;
                te[row * 2] = i0; te[row * 2 + 1] = i1; tj[row * 2] = j0; tj[row * 2 + 1] = j1; tw[row * 2] = __int_as_float(rsel[k * 4 + 2]); tw[row * 2 + 1] = __int_as_float(rsel[k * 4 + 3]); }
        }
    }
}
DI void phase_post_ffn(const Params& p, const Cx& c0, int layer) {
    const Cx c = fresh(c0);
    const int gw = c.vcu * NWAVES + c.wave, NGW = c.G * NWAVES, rows = layer == 0 ? T : TX;
    int off[8];
    if (layer == 1) { const unsigned* cnt = (const unsigned*)(p.ws + OFF_CNT); int a = 0;
#pragma unroll
        for (int e = 0; e < 8; ++e) { off[e] = a; a += ((int)cnt[e] + 255) & ~255; } }
    f32x4 f[4], xr1[4], fn[4], xn[4];
    u32x2 ea[4], eb_[4], ean[4], ebn[4]; float mw0 = 0.f, mw1 = 0.f, mw0n = 0.f, mw1n = 0.f; int ms0 = 0, ms1 = 0; float mq0 = 0.f, mq1 = 0.f;
    auto load_meta = [&](int row) {
        const int* te = (const int*)(p.ws + OFF_TOKE); const int* tj = (const int*)(p.ws + OFF_TOKJ); const float* tw = (const float*)(p.ws + OFF_TOKW);
        const int e0 = te[row * 2], e1 = te[row * 2 + 1];
        int s0 = 0, s1 = 0;
#pragma unroll
        for (int e = 0; e < 8; ++e) { if (e0 == e) s0 = off[e]; if (e1 == e) s1 = off[e]; }
        ms0 = s0 + tj[row * 2]; ms1 = s1 + tj[row * 2 + 1]; mq0 = tw[row * 2]; mq1 = tw[row * 2 + 1];
    };
    auto load_row1 = [&](int row, u32x2 (&a)[4], u32x2 (&b)[4], float& w0, float& w1, f32x4 (&xx)[4]) {
        const bf16_t* xsr = (const bf16_t*)(p.ws + OFF_XS) + (size_t)row * D;
        const bf16_t* O = (const bf16_t*)(p.ws + OFF_B);
#pragma unroll
        for (int j = 0; j < 4; ++j) { const int idx = (c.lane + 64 * j) * 4; xx[j] = ld_bf4(xsr + idx); a[j] = *(const u32x2*)(O + (size_t)ms0 * D + idx); b[j] = *(const u32x2*)(O + (size_t)ms1 * D + idx); }
        w0 = mq0; w1 = mq1;
    };
    auto load_row = [&](int row, f32x4 (&f)[4], f32x4 (&xx)[4]) {
        const bf16_t* xsr = (const bf16_t*)(p.ws + OFF_XS) + (size_t)row * D;
#pragma unroll
        for (int j = 0; j < 4; ++j) xx[j] = ld_bf4(xsr + (c.lane + 64 * j) * 4);
        if (layer == 0) {
            const bf16_t* fr = (const bf16_t*)(p.ws + OFF_B) + (size_t)row * D + c.lane * 4;
#pragma unroll
            for (int j = 0; j < 4; ++j) {
                if (row >= TX) { const float* sl = (const float*)(p.ws + OFF_B + B_SLAB_F) + (size_t)(row - TX) * D + (c.lane + 64 * j) * 4;
                    f[j] = *(const f32x4*)sl;
#pragma unroll
                    for (int k = 1; k < FFD_SPLIT; ++k) f[j] = f[j] + *(const f32x4*)(sl + (size_t)k * TC * D); }
                else f[j] = ld_bf4(fr + 256 * j); }
        } else {
            const int* te = (const int*)(p.ws + OFF_TOKE); const int* tj = (const int*)(p.ws + OFF_TOKJ); const float* tw = (const float*)(p.ws + OFF_TOKW);
            const int e0 = te[row * 2], e1 = te[row * 2 + 1];
            int s0 = 0, s1 = 0;
#pragma unroll
            for (int e = 0; e < 8; ++e) { if (e0 == e) s0 = off[e]; if (e1 == e) s1 = off[e]; }
            s0 += tj[row * 2]; s1 += tj[row * 2 + 1];
            const float w0 = tw[row * 2], w1 = tw[row * 2 + 1];
            const bf16_t* O = (const bf16_t*)(p.ws + OFF_B);
#pragma unroll
            for (int j = 0; j < 4; ++j) { const int idx = (c.lane + 64 * j) * 4;
                const f32x4 a = ld_bf4(O + (size_t)s0 * D + idx), bq = ld_bf4(O + (size_t)s1 * D + idx);
                f[j] = a * w0 + bq * w1; }
        }
    };
    if (layer == 0) { if (gw < rows) load_row(gw, f, xr1); }
    else if (gw < rows) { load_meta(gw); load_row1(gw, ea, eb_, mw0, mw1, xr1); if (gw + NGW < rows) load_meta(gw + NGW); }
    for (int row = gw; row < rows; row += NGW) {
        if (layer == 0) { if (row + NGW < rows) load_row(row + NGW, fn, xn); }
        else {
            if (row + NGW < rows) load_row1(row + NGW, ean, ebn, mw0n, mw1n, xn);
            if (row + 2 * NGW < rows) load_meta(row + 2 * NGW);
#pragma unroll
            for (int j = 0; j < 4; ++j) { const u32x2 a = ea[j], b = eb_[j];
                f[j] = (f32x4){__uint_as_float(a.x << 16), __uint_as_float(a.x & 0xffff0000u), __uint_as_float(a.y << 16), __uint_as_float(a.y & 0xffff0000u)} * mw0
                     + (f32x4){__uint_as_float(b.x << 16), __uint_as_float(b.x & 0xffff0000u), __uint_as_float(b.y << 16), __uint_as_float(b.y & 0xffff0000u)} * mw1; }
        }
        float s = 0.f;
#pragma unroll
        for (int j = 0; j < 4; ++j) s += (f[j].x * f[j].x + f[j].y * f[j].y) + (f[j].z * f[j].z + f[j].w * f[j].w);
        const float r = rsqrtf(wave_sum(s, c.lane) * (1.f / D) + EPS);
        const float* mod = mod_row(p, layer, row);
        bf16_t* xs = (bf16_t*)(p.ws + OFF_XS) + (size_t)row * D;
        float s3 = 0.f;
#pragma unroll
        for (int j = 0; j < 4; ++j) { const int idx = (c.lane + 64 * j) * 4;
            const f32x4 g = *(const f32x4*)(p.g_ffn_post + layer * D + idx), gt = *(const f32x4*)(mod + 5120 + idx), x1 = xr1[j];
            f[j] = x1 + gt * (f[j] * r * g);
            if (layer == 0) { u32x2 w; w.x = pk2(f[j].x, f[j].y); w.y = pk2(f[j].z, f[j].w); *(u32x2*)(xs + idx) = w; } else *(f32x4*)(p.out + (size_t)row * D + idx) = f[j];
            s3 += (f[j].x * f[j].x + f[j].y * f[j].y) + (f[j].z * f[j].z + f[j].w * f[j].w); }
        if (layer == 0) {
            const float r3 = rsqrtf(wave_sum(s3, c.lane) * (1.f / D) + EPS);
            const float* mod1 = mod_row(p, 1, row);
            bf16_t* h = (bf16_t*)(p.ws + OFF_H) + (size_t)row * D;
#pragma unroll
            for (int j = 0; j < 4; ++j) { const int idx = (c.lane + 64 * j) * 4;
                const f32x4 gg = *(const f32x4*)(p.g_attn_pre + D + idx), sh = *(const f32x4*)(mod1 + idx), sc = *(const f32x4*)(mod1 + 1024 + idx);
                const f32x4 o = f[j] * r3 * gg * (sc + 1.f) + sh;
                u32x2 w; w.x = pk2(o.x, o.y); w.y = pk2(o.z, o.w); *(u32x2*)(h + idx) = w; }
        }
#pragma unroll
        for (int j = 0; j < 4; ++j) { xr1[j] = xn[j]; if (layer == 0) f[j] = fn[j]; else { ea[j] = ean[j]; eb_[j] = ebn[j]; } }
        mw0 = mw0n; mw1 = mw1n;
    }
}
DI int key_row(int b, int u) { return u < CTXL ? TX + b * CTXL + u : b * SEQ + u - CTXL; }
DI void phase_ret_u_mfma(const Params& p, const Cx& c0, int layer) {
    const Cx c = fresh(c0);
    const int lane = c.lane, wave = c.wave, l31 = lane & 31, hi = lane >> 5;
    const bf16_t* P = (const bf16_t*)(p.ws + OFF_A + A_P);
    float* U = (float*)(p.ws + OFF_A + A_U);
    LAS bf16_t* VL = (LAS bf16_t*)c.lds + 3 * 64 * 136;
    LAS bf16_t* KT = (LAS bf16_t*)c.lds;
    const int nunits = NB * 4 * (NCH / 3);
    const float LOG2E = 1.4426950408889634f;
    for (int unit = c.vcu; unit < nunits; unit += c.G) {
        const int n3 = unit % (NCH / 3), h = (unit / (NCH / 3)) & 3, b = unit / ((NCH / 3) * 4);
        __syncthreads();
#pragma unroll
        for (int cc = 0; cc < 3; ++cc) { const int row0 = ret_row(b, 3 * n3 + cc);
#pragma unroll
            for (int ps = 0; ps < 2; ++ps) { const int j = ps * 64 + (c.tid >> 3), ch = c.tid & 7;
                const u32x4 v = *(const u32x4*)(P + (size_t)(row0 + j) * INW + RT_K + h * 64 + ch * 8);
#pragma unroll
                for (int e = 0; e < 4; ++e) { KT[cc * 64 * 136 + (ch * 8 + 2 * e) * 136 + j] = (bf16_t)(v[e] & 0xffffu); KT[cc * 64 * 136 + (ch * 8 + 2 * e + 1) * 136 + j] = (bf16_t)(v[e] >> 16); }
                const u32x4 vv = *(const u32x4*)(P + (size_t)(row0 + j) * INW + RT_V + h * 64 + ch * 8);
#pragma unroll
                for (int e = 0; e < 4; ++e) { VL[cc * 64 * 136 + (ch * 8 + 2 * e) * 136 + j] = (bf16_t)(vv[e] & 0xffffu); VL[cc * 64 * 136 + (ch * 8 + 2 * e + 1) * 136 + j] = (bf16_t)(vv[e] >> 16); } } }
        __syncthreads();
        const int eb = wave & 1, db = (wave >> 1) & 1, dir = wave >> 2;
        const float lg2 = logsig(dir ? p.gam_b[layer * 4 + h] : p.gam_f[layer * 4 + h]) * LOG2E;
#pragma unroll
        for (int cc = 0; cc < 3; ++cc) { const int n = 3 * n3 + cc;
            const LAS bf16_t* vrow = VL + cc * 64 * 136 + (eb * 32 + l31) * 136 + hi * 8;
            f32x16 acc;
#pragma unroll
            for (int r = 0; r < 16; ++r) acc[r] = 0.f;
#pragma unroll
            for (int s = 0; s < 8; ++s) {
                const bf16x8 af = *(const LAS bf16x8*)(vrow + s * 16);
                const u32x4 kv = *(const LAS u32x4*)(KT + cc * 64 * 136 + (db * 32 + l31) * 136 + s * 16 + hi * 8);
                u32x4 kw;
#pragma unroll
                for (int e = 0; e < 4; ++e) { const int j = s * 16 + hi * 8 + 2 * e;
                    const float w0 = __builtin_amdgcn_exp2f((float)(dir ? j : 127 - j) * lg2), w1 = __builtin_amdgcn_exp2f((float)(dir ? j + 1 : 126 - j) * lg2);
                    kw[e] = pk2(__uint_as_float(kv[e] << 16) * w0, __uint_as_float(kv[e] & 0xffff0000u) * w1); }
                acc = MFMA32(af, __builtin_bit_cast(bf16x8, kw), acc);
            }
            float* Uo = U + ((size_t)((b * 4 + h) * 2 + dir) * NCH + n) * 4096 + db * 32 + l31;
#pragma unroll
            for (int r = 0; r < 16; ++r) Uo[(eb * 32 + (r & 3) + 8 * (r >> 2) + 4 * hi) * 64] = acc[r] * 0.125f;
        }
    }
    __syncthreads();
}
DI void phase_ret_scan2(const Params& p, const Cx& c0, int layer) {
    const Cx c = fresh(c0);
    const float* U = (const float*)(p.ws + OFF_A + A_U);
    bf16_t* S = (bf16_t*)(p.ws + OFF_A + A_S);
    for (int gid = c.vcu * NTHREADS + c.tid; gid < NB * 4 * 2 * 4096; gid += c.G * NTHREADS) {
        const int de = gid & 4095, dir = (gid >> 12) & 1, h = (gid >> 13) & 3;
        const size_t base = (size_t)(gid >> 12) * NCH * 4096 + de;
        const float lg = logsig(dir ? p.gam_b[layer * 4 + h] : p.gam_f[layer * 4 + h]);
        const float gch = expf(128.f * lg);
        float s = 0.f;
#pragma unroll
        for (int i0 = 0; i0 < NCH; i0 += 33) {
            float u[33];
#pragma unroll
            for (int k = 0; k < 33; ++k) { const int i = i0 + k, n = dir == 0 ? i : (i < 2 ? 1 - i : 67 - i); u[k] = U[base + (size_t)n * 4096]; }
#pragma unroll
            for (int k = 0; k < 33; ++k) { const int i = i0 + k, n = dir == 0 ? i : (i < 2 ? 1 - i : 67 - i); S[base + (size_t)n * 4096] = f2bf(s); s = gch * s + u[k]; }
        }
    }
}
constexpr int RO_KP = 144, RO_VP = 272, RO_K = 0, RO_V = 128 * RO_KP, RO_S = RO_V + 64 * RO_VP, RO_HALF = RO_S + 128 * RO_KP;
template <bool CTXU>
DI void phase_ret_out_mfma(const Params& p, const Cx& c0, int layer, int n0, int first_blk = 0) {
    const Cx c = fresh(c0);
    const int lane = c.lane, l31 = lane & 31, hi = lane >> 5, half = c.wave >> 2, ht = (c.wave & 3) * 64 + lane;
    const bf16_t* P = (const bf16_t*)(p.ws + OFF_A + A_P);
    const bf16_t* ST = (const bf16_t*)(p.ws + OFF_A + A_S);
    bf16_t* YC = (bf16_t*)(p.ws + OFF_H);
    const float* U = (const float*)(p.ws + OFF_A + A_U);
    const int nn = CTXU ? 2 : NCH - n0, nunits = NB * 4 * nn * 4, NGW = c.G * NWAVES;
    const int gw = (c.vcu >= first_blk ? c.vcu - first_blk : c.vcu - first_blk + c.G) * NWAVES + c.wave;
    const float LOG2E = 1.4426950408889634f;
    LAS unsigned char* img = c.lds + half * RO_HALF;
    __syncthreads();
    for (int unit = gw; unit < nunits; unit += NGW) {
        const int ib = unit & 3, n = n0 + (unit >> 2) % nn, h = ((unit >> 2) / nn) & 3, b = (unit >> 2) / (nn * 4);
        const int row0 = ret_row(b, n), u0 = n < 2 ? n * 128 : CTXL + (n - 2) * 128;
        const int iq = ib * 32 + l31, qrow = row0 + iq;
        const float lf2 = logsig(p.gam_f[layer * 4 + h]) * LOG2E, lb2 = logsig(p.gam_b[layer * 4 + h]) * LOG2E;
        u32x4 kr[4], vr[4], sr[4];
#pragma unroll
        for (int i = 0; i < 4; ++i) { const int pc = ht + 256 * i;
            kr[i] = *(const u32x4*)(P + (size_t)(row0 + (pc >> 3)) * INW + RT_K + h * 64 + (pc & 7) * 8);
            vr[i] = *(const u32x4*)(P + (size_t)(row0 + (pc >> 3)) * INW + RT_V + h * 64 + (pc & 7) * 8);
            const int dir = pc >> 9, e = (pc >> 3) & 63, ch = pc & 7;
            if (CTXU) {
                if (dir == 0 ? n == 1 : n == 0) { const float* ur = U + ((size_t)((b * 4 + h) * 2 + dir) * NCH + (1 - n)) * 4096 + e * 64 + ch * 8; const f32x4 ua = *(const f32x4*)ur, ub = *(const f32x4*)(ur + 4);
                    sr[i].x = (unsigned)f2bf(ua[0]) | ((unsigned)f2bf(ua[1]) << 16); sr[i].y = (unsigned)f2bf(ua[2]) | ((unsigned)f2bf(ua[3]) << 16);
                    sr[i].z = (unsigned)f2bf(ub[0]) | ((unsigned)f2bf(ub[1]) << 16); sr[i].w = (unsigned)f2bf(ub[2]) | ((unsigned)f2bf(ub[3]) << 16); }
                else sr[i] = (u32x4){0u, 0u, 0u, 0u};
            } else sr[i] = *(const u32x4*)(ST + ((size_t)((b * 4 + h) * 2 + dir) * NCH + n) * 4096 + e * 64 + ch * 8);
        }
        bf16x8 qf[4];
#pragma unroll
        for (int ks = 0; ks < 4; ++ks) qf[ks] = *(const bf16x8*)(P + (size_t)qrow * INW + RT_Q + h * 64 + ks * 16 + hi * 8);
#pragma unroll
        for (int i = 0; i < 4; ++i) { const int pc = ht + 256 * i;
            *(LAS u32x4*)(img + RO_K + (pc >> 3) * RO_KP + (pc & 7) * 16) = kr[i];
            { LAS bf16_t* vd = (LAS bf16_t*)(img + RO_V) + ((pc & 7) * 8) * (RO_VP / 2) + (pc >> 3);
#pragma unroll
              for (int e = 0; e < 4; ++e) { vd[(2 * e) * (RO_VP / 2)] = (bf16_t)(vr[i][e] & 0xffffu); vd[(2 * e + 1) * (RO_VP / 2)] = (bf16_t)(vr[i][e] >> 16); } }
            *(LAS u32x4*)(img + RO_S + (pc >> 3) * RO_KP + (pc & 7) * 16) = sr[i]; }
        __syncthreads();
        bf16x8 pf[8];
#pragma unroll
        for (int jb = 0; jb < 4; ++jb) {
            f32x16 S;
#pragma unroll
            for (int r = 0; r < 16; ++r) S[r] = 0.f;
#pragma unroll
            for (int ks = 0; ks < 4; ++ks) { const bf16x8 kf = *(const LAS bf16x8*)(img + RO_K + (jb * 32 + l31) * RO_KP + ks * 32 + hi * 16); S = MFMA32(kf, qf[ks], S); }
#pragma unroll
            for (int r = 0; r < 16; ++r) { const int j = jb * 32 + (r & 3) + 8 * (r >> 2) + 4 * hi, dd = iq - j;
                S[r] *= 0.125f * __builtin_amdgcn_exp2f(dd >= 0 ? (float)dd * lf2 : (float)(-dd) * lb2); }
#pragma unroll
            for (int s = 0; s < 2; ++s) { u32x4 w; w.x = pk2(S[8 * s], S[8 * s + 1]); w.y = pk2(S[8 * s + 2], S[8 * s + 3]); w.z = pk2(S[8 * s + 4], S[8 * s + 5]); w.w = pk2(S[8 * s + 6], S[8 * s + 7]);
                pf[jb * 2 + s] = __builtin_bit_cast(bf16x8, w); }
        }
        const float xif = __builtin_amdgcn_exp2f((float)(iq + 1) * lf2), xib = __builtin_amdgcn_exp2f((float)(128 - iq) * lb2);
        f32x16 O[2];
#pragma unroll
        for (int eb = 0; eb < 2; ++eb) {
#pragma unroll
            for (int r = 0; r < 16; ++r) O[eb][r] = 0.f;
#pragma unroll
            for (int k8 = 0; k8 < 8; ++k8) { const LAS unsigned char* vp = img + RO_V + (eb * 32 + l31) * RO_VP + k8 * 32 + hi * 8;
                const u32x2 x0 = *(const LAS u32x2*)vp, x1 = *(const LAS u32x2*)(vp + 16);
                u32x4 wv; wv.x = x0.x; wv.y = x0.y; wv.z = x1.x; wv.w = x1.y;
                O[eb] = MFMA32(__builtin_bit_cast(bf16x8, wv), pf[k8], O[eb]); }
#pragma unroll
            for (int dir = 0; dir < 2; ++dir) {
                f32x16 C;
#pragma unroll
                for (int r = 0; r < 16; ++r) C[r] = 0.f;
#pragma unroll
                for (int ks = 0; ks < 4; ++ks) C = MFMA32(*(const LAS bf16x8*)(img + RO_S + (dir * 64 + eb * 32 + l31) * RO_KP + ks * 32 + hi * 16), qf[ks], C);
                const float xi = dir ? xib : xif;
#pragma unroll
                for (int r = 0; r < 16; ++r) O[eb][r] += xi * C[r];
            }
        }
        float ss = 0.f;
#pragma unroll
        for (int eb = 0; eb < 2; ++eb)
#pragma unroll
            for (int r = 0; r < 16; ++r) ss += O[eb][r] * O[eb][r];
        ss += shx(ss, 32, lane);
        const float rr = rsqrtf(ss * (1.f / 64.f) + EPS);
#pragma unroll
        for (int eb = 0; eb < 2; ++eb)
#pragma unroll
            for (int g = 0; g < 4; ++g) { const int e0 = eb * 32 + 8 * g + 4 * hi;
                const u32x2 gt = *(const u32x2*)(P + (size_t)qrow * INW + RT_G + h * 64 + e0);
                const float g0 = __uint_as_float(gt.x << 16), g1 = __uint_as_float(gt.x & 0xffff0000u), g2 = __uint_as_float(gt.y << 16), g3 = __uint_as_float(gt.y & 0xffff0000u);
                u32x2 w; w.x = pk2(O[eb][4 * g] * rr * silu_f(g0), O[eb][4 * g + 1] * rr * silu_f(g1)); w.y = pk2(O[eb][4 * g + 2] * rr * silu_f(g2), O[eb][4 * g + 3] * rr * silu_f(g3));
                *(u32x2*)(YC + (size_t)qrow * D + 768 + h * 64 + e0) = w; }
        __syncthreads();
    }
}
namespace da2 {
typedef short s16x4 __attribute__((ext_vector_type(4)));
typedef LAS const char* lcp;
constexpr int NSLOT = 3, SLOTB = 8192;
constexpr int L_K = 0, L_V = NSLOT * SLOTB, L_WS = 2 * NSLOT * SLOTB, L_ST = L_WS + 8 * 64 * 4;
constexpr int ST_P = 65, ST_W = 32 * ST_P;
DI int crow(int r, int hi) { return (r & 3) + 8 * (r >> 2) + 4 * hi; }
DI void glds16(const void* gsrc, unsigned lds_dst) { unsigned keep;
    asm volatile("s_mov_b32 %0, m0\n\ts_mov_b32 m0, %2\n\ts_nop 0\n\tglobal_load_lds_dwordx4 %1, off\n\ts_mov_b32 m0, %0" : "=&s"(keep) : "v"(gsrc), "s"(lds_dst) : "memory"); }
DI float max3f(float a, float b, float c) { float r; asm("v_max3_f32 %0, %1, %2, %3" : "=v"(r) : "v"(a), "v"(b), "v"(c)); return r; }
DI float max2f(float a, float b) { float r; asm("v_max_f32_e32 %0, %1, %2" : "=v"(r) : "v"(a), "v"(b)); return r; }
DI float fadd_s(float a, float b) { float r; asm("v_add_f32_e32 %0, %1, %2" : "=v"(r) : "v"(a), "v"(b)); return r; }
DI float fsub_s(float a, float b) { float r; asm("v_sub_f32_e32 %0, %1, %2" : "=v"(r) : "v"(a), "v"(b)); return r; }
#define SBAR() __builtin_amdgcn_sched_barrier(0)
#define WAIT_BAR(N) asm volatile("s_waitcnt vmcnt(" #N ") lgkmcnt(0)\n\ts_barrier" ::: "memory")
DI s16x4 vtr(lcp p) { return __builtin_bit_cast(s16x4, __builtin_amdgcn_ds_read_tr16_b64_v4i16((LAS s16x4*)p)); }
DI float rowmax(const f32x16& p0, const f32x16& p1) {
    float a = max3f(p0[0], p0[1], p1[0]), b = max3f(p0[2], p0[3], p1[1]); a = max3f(a, p1[2], p1[3]);
#pragma unroll
    for (int r = 4; r < 16; r += 4) { a = max3f(a, p0[r], p0[r + 1]); b = max3f(b, p0[r + 2], p0[r + 3]); a = max3f(a, p1[r], p1[r + 1]); b = max3f(b, p1[r + 2], p1[r + 3]); }
    const float m = max2f(a, b);
    auto rr = __builtin_amdgcn_permlane32_swap(__float_as_uint(m), __float_as_uint(m), false, false);
    return max2f(__uint_as_float(rr[0]), __uint_as_float(rr[1]));
}
DI void pv(f32x16* o, int vb, bf16x8 pa0, bf16x8 pa1, bf16x8 pa2, bf16x8 pa3) {
#pragma unroll
    for (int d0 = 0; d0 < 2; ++d0) { s16x4 lo[4], hi[4];
#pragma unroll
        for (int ks = 0; ks < 4; ++ks) {
            asm volatile("ds_read_b64_tr_b16 %0,%1 offset:%c2" : "=&v"(lo[ks]) : "v"(vb), "i"(d0 * 4096 + ks * 1024) : "memory");
            asm volatile("ds_read_b64_tr_b16 %0,%1 offset:%c2" : "=&v"(hi[ks]) : "v"(vb), "i"(d0 * 4096 + ks * 1024 + 512) : "memory"); }
        asm volatile("s_waitcnt lgkmcnt(0)" ::: "memory"); SBAR();
#define PK(k) (bf16x8){lo[k][0], lo[k][1], lo[k][2], lo[k][3], hi[k][0], hi[k][1], hi[k][2], hi[k][3]}
        o[d0] = MFMA32(pa0, PK(0), o[d0]);
        o[d0] = MFMA32(pa1, PK(1), o[d0]);
        o[d0] = MFMA32(pa2, PK(2), o[d0]);
        o[d0] = MFMA32(pa3, PK(3), o[d0]);
#undef PK
    }
}
DI int tile_row(int b, int t) { return t < CTXL / 64 ? TX + b * CTXL + 64 * t : b * SEQ + 64 * (t - CTXL / 64); }

template <int THRL>
DI void unit(const Params& p, const Cx& c, int layer, int b, int h, int qrow0, int NT, float lam, float lam_init) {
    const int lane = c.lane, r32 = lane & 31, hi = lane >> 5; const int wid = __builtin_amdgcn_readfirstlane(c.wave);
    const int mp = wid >> 2, qblk = wid & 3;
    const bf16_t* P = (const bf16_t*)(p.ws + OFF_A + A_P);
    bf16_t* YC = (bf16_t*)(p.ws + OFF_H);
    const unsigned lds0 = (unsigned)(uintptr_t)c.lds;
    LAS float* wsf = (LAS float*)(c.lds + L_WS) + wid * 64;
    const bf16_t* ksrc = P + (size_t)lane * INW + DA_K + h * 64 + wid * 8;
    const bf16_t* vsrc = P + (size_t)(16 * (wid & 3) + (lane >> 2)) * INW + DA_V + h * 64 + (wid >> 2) * 32 + (lane & 3) * 8;
    const unsigned kdst = lds0 + L_K + wid * 1024, vdst = lds0 + L_V + wid * 1024;
#define DMA_K(t, slot) glds16(ksrc + (size_t)tile_row(b, (t)) * INW, (unsigned)__builtin_amdgcn_readfirstlane(kdst + (slot)))
#define DMA_V(t, slot) glds16(vsrc + (size_t)tile_row(b, (t)) * INW, (unsigned)__builtin_amdgcn_readfirstlane(vdst + (slot)))
    const int vb0 = (int)(lds0 + L_V) + ((lane >> 4) & 1) * 32 + (lane & 3) * 8 + (4 * hi + ((lane & 15) >> 2)) * 64;
    bf16x8 kf[4];
    const lcp shm3 = (lcp)c.lds; const lcp kp0 = shm3 + L_K + mp * 4096 + hi * 1024 + r32 * 16;
    const lcp vp0 = shm3 + L_V + ((lane >> 4) & 1) * 32 + (lane & 3) * 8 + (4 * hi + ((lane & 15) >> 2)) * 64;
    asm volatile("s_waitcnt vmcnt(0)" ::: "memory");
    DMA_K(0, 0); DMA_V(0, 0); DMA_K(1, SLOTB);
    bf16x8 qr[2];
    { const bf16_t* Qw = P + (size_t)(qrow0 + qblk * 32 + r32) * INW + DA_Q + h * 64 + mp * 32 + hi * 8;
      qr[0] = *(const bf16x8*)(Qw); qr[1] = *(const bf16x8*)(Qw + 16); }
    float mhat = 0.f; f32x16 o[2], lacc;
#pragma unroll
    for (int r = 0; r < 16; ++r) { o[0][r] = 0.f; o[1][r] = 0.f; lacc[r] = 0.f; }
    bf16x8 ones;
#pragma unroll
    for (int j = 0; j < 8; ++j) ones[j] = (short)0x3F80;
    asm volatile("" : "+v"(ones));
    f32x16 negm;
#pragma unroll
    for (int r = 0; r < 16; ++r) negm[r] = 0.f;
    asm volatile("" : "+v"(negm));
    bool resc = false;
#define START(P0, P1) do { const float rm = rowmax(P0, P1); resc = false; \
    { const float dl = rm; mhat = fadd_s(mhat, dl); \
      _Pragma("unroll") for (int r = 0; r < 16; ++r) { P0[r] = fsub_s(P0[r], dl); P1[r] = fsub_s(P1[r], dl); } \
      _Pragma("unroll") for (int r = 0; r < 16; ++r) negm[r] = -mhat; asm volatile("" : "+v"(negm)); } \
    _Pragma("unroll") for (int r = 0; r < 16; ++r) P0[r] = __builtin_amdgcn_exp2f(P0[r]); } while (0)
#define RESC() do { if (resc) { asm volatile("s_waitcnt lgkmcnt(0)" ::: "memory"); \
      _Pragma("unroll") for (int r = 0; r < 16; ++r) { const float f_ = wsf[crow(r, hi)]; o[0][r] *= f_; o[1][r] *= f_; lacc[r] *= f_; } } } while (0)
    f32x16 pA0, pA1, pB0, pB1;
    int sl_prev = 0, sl_cur = 0, sl_next = SLOTB;
#define ROT() do { sl_prev = sl_cur; sl_cur = sl_next; sl_next = (sl_next == (NSLOT - 1) * SLOTB) ? 0 : sl_next + SLOTB; } while (0)
    DMA_K(2, 2 * SLOTB);
    WAIT_BAR(3);
    {
        const lcp kb = kp0;
        const bf16x8 b0 = *(const LAS bf16x8*)(kb), b1 = *(const LAS bf16x8*)(kb + 512), b2 = *(const LAS bf16x8*)(kb + 2048), b3 = *(const LAS bf16x8*)(kb + 2560);
        pA0 = MFMA32(b0, qr[0], negm); pA1 = MFMA32(b1, qr[0], negm); pA0 = MFMA32(b2, qr[1], pA0); pA1 = MFMA32(b3, qr[1], pA1);
        asm volatile("s_nop 15\n\ts_nop 7" : "+v"(pA0), "+v"(pA1));
    }
    START(pA0, pA1);
#pragma unroll
    for (int r = 0; r < 16; ++r) pA1[r] = __builtin_amdgcn_exp2f(pA1[r]);
    WAIT_BAR(0);
    DMA_K(3, 0); DMA_V(1, SLOTB);
    ROT();
#define KLOAD4(kp_) do { kf[0] = *(const LAS bf16x8*)(kp_); kf[1] = *(const LAS bf16x8*)((kp_) + 512); kf[2] = *(const LAS bf16x8*)((kp_) + 2048); kf[3] = *(const LAS bf16x8*)((kp_) + 2560); } while (0)
    KLOAD4(kp0 + sl_cur);
    WAIT_BAR(2);
    s16x4 vlo[8], vhi[8]; u32x4 pw0, pw1, pw2, pw3;
#define PKW(P_, B_) pk2(P_[B_], P_[B_ + 1])
#define PAF(k) __builtin_bit_cast(bf16x8, pw##k)
#define VFR(i) (bf16x8){vlo[i][0], vlo[i][1], vlo[i][2], vlo[i][3], vhi[i][0], vhi[i][1], vhi[i][2], vhi[i][3]}
#define PIN(x) asm volatile("" : "+v"(x))
#define MX3(a, b, c_) __builtin_fmaxf(__builtin_fmaxf((a), (b)), (c_))
#define GAPA(MF, PW, PS, B_) do { MF; PW[0] = PKW(PS, B_); PW[1] = PKW(PS, B_ + 2); PW[2] = PKW(PS, B_ + 4); PW[3] = PKW(PS, B_ + 6); PIN(PW); SBAR(); } while (0)
#define EX(v) __builtin_amdgcn_exp2f(v)
#define GAPB(MF, X, B_) do { MF; X[B_] = EX(X[B_]); X[B_ + 1] = EX(X[B_ + 1]); X[B_ + 2] = EX(X[B_ + 2]); X[B_ + 3] = EX(X[B_ + 3]); PIN(X); SBAR(); } while (0)
#define VRD(i) do { vlo[i] = vtr(vp_ + (((i) >> 2) * 4096 + ((i) & 3) * 1024)); vhi[i] = vtr(vp_ + (((i) >> 2) * 4096 + ((i) & 3) * 1024 + 512)); } while (0)
#define KRD(G_, j) do { if (G_) { const lcp kn_ = kp0 + sl_next; kf[2 * (j)] = *(const LAS bf16x8*)(kn_ + (j) * 2048); kf[2 * (j) + 1] = *(const LAS bf16x8*)(kn_ + (j) * 2048 + 512); SBAR(); } } while (0)
#define STEP(C0, C1, P0, P1, t, GK, GV, GL) do { SBAR(); \
    const lcp vp_ = vp0 + sl_prev; \
    VRD(0); VRD(4); SBAR(); GAPA(C0 = MFMA32(kf[0], qr[0], negm), pw0, P0, 0); \
    VRD(1); VRD(5); SBAR(); GAPA(C1 = MFMA32(kf[1], qr[0], negm), pw1, P0, 8); \
    VRD(2); VRD(6); SBAR(); GAPA(C0 = MFMA32(kf[2], qr[1], C0), pw2, P1, 0); \
    VRD(3); VRD(7); SBAR(); GAPA(C1 = MFMA32(kf[3], qr[1], C1), pw3, P1, 8); \
    if (GK) { DMA_K((t) + 3, sl_cur); } if (GV) { DMA_V((t) + 1, sl_next); } \
    { float a, b_; \
      lacc = MFMA32(PAF(0), ones, lacc); a = MX3(C0[0], C0[1], C0[2]); a = MX3(a, C0[3], C0[4]); a = MX3(a, C0[5], C0[6]); a = MX3(a, C0[7], C0[8]); a = MX3(a, C0[9], C0[10]); PIN(a); SBAR(); \
      lacc = MFMA32(PAF(1), ones, lacc); a = MX3(a, C0[11], C0[12]); a = MX3(a, C0[13], C0[14]); b_ = MX3(C0[15], C1[0], C1[1]); b_ = MX3(b_, C1[2], C1[3]); b_ = MX3(b_, C1[4], C1[5]); PIN(a); PIN(b_); SBAR(); \
      lacc = MFMA32(PAF(2), ones, lacc); b_ = MX3(b_, C1[6], C1[7]); b_ = MX3(b_, C1[8], C1[9]); b_ = MX3(b_, C1[10], C1[11]); b_ = MX3(b_, C1[12], C1[13]); b_ = MX3(b_, C1[14], C1[15]); PIN(b_); SBAR(); \
      lacc = MFMA32(PAF(3), ones, lacc); \
      float rm = __builtin_fmaxf(a, b_); { auto rr = __builtin_amdgcn_permlane32_swap(__float_as_uint(rm), __float_as_uint(rm), false, false); rm = __builtin_fmaxf(__uint_as_float(rr[0]), __uint_as_float(rr[1])); } \
      resc = false; \
      if (__builtin_expect(__builtin_amdgcn_ballot_w64(rm > (float)THRL) != 0ull, 0)) { const float dl = __builtin_fmaxf(rm, 0.f); mhat += dl; \
        _Pragma("unroll") for (int r = 0; r < 16; ++r) { C0[r] -= dl; C1[r] -= dl; } \
        _Pragma("unroll") for (int r = 0; r < 16; ++r) negm[r] = -mhat; asm volatile("" : "+v"(negm)); \
        const float f = __builtin_amdgcn_exp2f(-dl); if (hi == 0) wsf[r32] = f; resc = true; } } \
    SBAR(); \
    GAPB(o[0] = MFMA32(PAF(0), VFR(0), o[0]), C0, 0); \
    GAPB(o[1] = MFMA32(PAF(0), VFR(4), o[1]), C0, 4); \
    KRD(GL, 0); GAPB(o[0] = MFMA32(PAF(1), VFR(1), o[0]), C0, 8); \
    KRD(GL, 1); GAPB(o[1] = MFMA32(PAF(1), VFR(5), o[1]), C0, 12); \
    GAPB(o[0] = MFMA32(PAF(2), VFR(2), o[0]), C1, 0); \
    GAPB(o[1] = MFMA32(PAF(2), VFR(6), o[1]), C1, 4); \
    GAPB(o[0] = MFMA32(PAF(3), VFR(3), o[0]), C1, 8); \
    GAPB(o[1] = MFMA32(PAF(3), VFR(7), o[1]), C1, 12); \
    } while (0)
    int t = 1;
    for (; t + 5 < NT; t += 2) {
        STEP(pB0, pB1, pA0, pA1, t, true, true, true);       WAIT_BAR(2); RESC(); ROT();
        STEP(pA0, pA1, pB0, pB1, t + 1, true, true, true);   WAIT_BAR(2); RESC(); ROT();
    }
#define ENDW(tt) do { if ((tt) + 3 < NT) { WAIT_BAR(2); } else if ((tt) + 2 < NT) { WAIT_BAR(1); } else { WAIT_BAR(0); } } while (0)
    for (; t + 1 < NT; t += 2) {
        STEP(pB0, pB1, pA0, pA1, t, (t + 3 < NT), (t + 1 < NT), (t + 1 < NT));         ENDW(t);     RESC(); ROT();
        STEP(pA0, pA1, pB0, pB1, t + 1, (t + 4 < NT), (t + 2 < NT), (t + 2 < NT));     ENDW(t + 1); RESC(); ROT();
    }
    STEP(pB0, pB1, pA0, pA1, NT - 1, false, false, false); RESC();
    { pw0 = (u32x4){PKW(pB0, 0), PKW(pB0, 2), PKW(pB0, 4), PKW(pB0, 6)}; pw1 = (u32x4){PKW(pB0, 8), PKW(pB0, 10), PKW(pB0, 12), PKW(pB0, 14)};
      pw2 = (u32x4){PKW(pB1, 0), PKW(pB1, 2), PKW(pB1, 4), PKW(pB1, 6)}; pw3 = (u32x4){PKW(pB1, 8), PKW(pB1, 10), PKW(pB1, 12), PKW(pB1, 14)};
      SBAR(); lacc = MFMA32(PAF(0), ones, lacc); lacc = MFMA32(PAF(1), ones, lacc); lacc = MFMA32(PAF(2), ones, lacc); lacc = MFMA32(PAF(3), ones, lacc);
      pv(o, vb0 + sl_cur, PAF(0), PAF(1), PAF(2), PAF(3)); }
#undef PKW
#undef PAF
#undef VFR
#undef PIN
#undef MX3
#undef GAPA
#undef GAPB
#undef EX
#undef VRD
#undef KRD
#undef STEP
#undef ENDW
#undef KLOAD4
    const float osc = mp ? lam : 1.f;
    LAS float* stg = (LAS float*)(c.lds + L_ST) + wid * ST_W;
#pragma unroll
    for (int r = 0; r < 16; ++r) { const float rl = __builtin_amdgcn_rcpf(lacc[r]) * osc; const int orow = crow(r, hi);
        stg[orow * ST_P + r32] = o[0][r] * rl; stg[orow * ST_P + 32 + r32] = o[1][r] * rl; }
    __syncthreads();
    if (mp == 0) {
        const LAS float* s0 = stg + r32 * ST_P + 32 * hi; const LAS float* s1 = s0 + 4 * ST_W;
        float df[32]; float ss = 0.f;
#pragma unroll
        for (int j = 0; j < 32; ++j) { df[j] = s0[j] - s1[j]; ss += df[j] * df[j]; }
        { auto rr = __builtin_amdgcn_permlane32_swap(__float_as_uint(ss), __float_as_uint(ss), false, false); ss = __uint_as_float(rr[0]) + __uint_as_float(rr[1]); }
        const float rn = rsqrtf(ss * (1.f / 64.f) + EPS) * (1.f - lam_init);
        const float* sg = p.subln + layer * 64 + 32 * hi;
        bf16_t* yo = YC + (size_t)(qrow0 + qblk * 32 + r32) * D + h * 64 + 32 * hi;
#pragma unroll
        for (int g = 0; g < 4; ++g) { const f32x4 ga = *(const f32x4*)(sg + 8 * g), gb = *(const f32x4*)(sg + 8 * g + 4);
            u32x4 w; w.x = pk2(df[8 * g] * rn * ga[0], df[8 * g + 1] * rn * ga[1]); w.y = pk2(df[8 * g + 2] * rn * ga[2], df[8 * g + 3] * rn * ga[3]);
            w.z = pk2(df[8 * g + 4] * rn * gb[0], df[8 * g + 5] * rn * gb[1]); w.w = pk2(df[8 * g + 6] * rn * gb[2], df[8 * g + 7] * rn * gb[3]);
            *(u32x4*)(yo + 8 * g) = w; }
    }
    asm volatile("s_waitcnt lgkmcnt(0)\n\ts_barrier" ::: "memory");
#undef DMA_K
#undef DMA_V
#undef START
#undef RESC
#undef ROT
}
#undef SBAR
#undef WAIT_BAR
}

DI void phase_da2(const Params& p, const Cx& c0, int layer, int ctxq, int first_blk = 0) {
    const Cx c = fresh(c0);
    float s1 = 0.f, s2 = 0.f;
    for (int i = 0; i < 32; ++i) { s1 += p.lq1[layer * 32 + i] * p.lk1[layer * 32 + i]; s2 += p.lq2[layer * 32 + i] * p.lk2[layer * 32 + i]; }
    const float lam_init = 0.8f - 0.6f * expf(-0.3f * (float)layer);
    const float lam = expf(s1) - expf(s2) + lam_init;
    const int nunits = ctxq ? NB * 4 * 2 : NB * 4 * 64;
    __syncthreads();
    for (int unit = c.vcu >= first_blk ? c.vcu - first_blk : c.vcu - first_blk + c.G; unit < nunits; unit += c.G) {
        int b, h, qrow0, NT;
        if (ctxq) { b = unit >> 3; h = (unit >> 1) & 3; qrow0 = TX + b * CTXL + (unit & 1) * 128; NT = CTXL / 64; }
        else { b = unit >> 8; h = (unit >> 6) & 3; qrow0 = b * SEQ + (unit & 63) * 128; NT = NKEY / 64; }
        da2::unit<8>(p, c, layer, b, h, qrow0, NT, lam, lam_init);
    }
    __syncthreads();
}
namespace da2 {
#define SBAR() __builtin_amdgcn_sched_barrier(0)
#define WAIT_BAR(N) asm volatile("s_waitcnt vmcnt(" #N ") lgkmcnt(0)\n\ts_barrier" ::: "memory")
constexpr int F_OST = L_WS + 8 * 64 * 4;
constexpr int F_TAB = F_OST + 8 * 4096;
DI void glds16s(const void* sbase, unsigned voff, unsigned lds_dst) { unsigned keep;
    asm volatile("s_mov_b32 %0, m0\n\ts_mov_b32 m0, %3\n\ts_nop 0\n\tglobal_load_lds_dwordx4 %1, %2\n\ts_mov_b32 m0, %0" : "=&s"(keep) : "v"(voff), "s"(sbase), "s"(lds_dst) : "memory"); }
template <int MODE>
DI void fmask(f32x16& C0, f32x16& C1, int tl, int loc0, int qw0, const LAS float* tab) {
    const int ln = lane_id_fresh(), hi = ln >> 5, qpos = qw0 + (ln & 31), gc = qpos & 63, cstart = min(max(gc - 8, 0), 48);
    bool need, masked; int kpos0 = 0, dr = 0;
    if (MODE == 1) { kpos0 = loc0 + 64 * tl; need = (kpos0 + 63 >= qw0 - 128) && (kpos0 <= qw0 + 31 + 128); masked = !((kpos0 >= qw0 + 31 - 128) && (kpos0 + 63 <= qw0 + 128)); }
    else { const int kr = loc0 + tl, wr = qw0 >> 6, ws_ = min(max(wr - 4, 0), 120); need = (kr >= ws_) && (kr < ws_ + 8); masked = true; dr = kr - wr + 7; }
    if (!need) {
#pragma unroll
        for (int r = 0; r < 16; ++r) { C0[r] = -INFINITY; C1[r] = -INFINITY; }
    } else if (masked) {
#pragma unroll
        for (int r = 0; r < 16; ++r) {
#pragma unroll
            for (int kb = 0; kb < 2; ++kb) { const int kidx = kb * 32 + (r & 3) + 8 * (r >> 2) + 4 * hi; float bias;
                if (MODE == 1) { const int dd = qpos - (kpos0 + kidx); bias = (dd <= 128 && dd >= -128) ? 0.f : -INFINITY; }
                else { const bool ok = kidx >= cstart && kidx < cstart + 16; const int dc = min(max(kidx - gc, -15), 15) + 15; bias = ok ? tab[dr * 31 + dc] : -INFINITY; }
                if (kb == 0) C0[r] += bias; else C1[r] += bias; } }
    }
}

template <int MODE, int THRL>
DI void unit64(const Params& p, const Cx& c, int layer, int b, int h, int qb, int ctxq) {
    const int lane = c.lane, r32 = lane & 31, hi = lane >> 5; const int wid = __builtin_amdgcn_readfirstlane(c.wave);
    const bf16_t* P = (const bf16_t*)(p.ws + OFF_A + A_P);
    bf16_t* YC = (bf16_t*)(p.ws + OFF_H);
    const unsigned lds0 = (unsigned)(uintptr_t)c.lds;
    LAS float* wsf = (LAS float*)(c.lds + L_WS) + wid * 64;
    LAS float* tab = (LAS float*)(c.lds + F_TAB);
    const int qcolP = MODE == 1 ? SW_Q + h * 64 : NA_Q + h * 64, kcolP = MODE == 1 ? SW_K + (h >> 1) * 64 : NA_K + h * 64, vcolP = MODE == 1 ? SW_V + (h >> 1) * 64 : NA_V + h * 64;
    const int ycol = (MODE == 1 ? 256 : 512) + h * 64;
    int nloc = 0, loc0 = 0;
    if (!ctxq) {
        if (MODE == 1) { const int lo = qb == 0 ? 2 : 0, hi_t = qb == 31 ? 5 : 7; loc0 = qb * 256 - 128 + 64 * lo; nloc = hi_t - lo + 1; }
        else { const int rmin = min(max(4 * qb - 4, 0), 120), rmax = min(max(4 * qb - 1, 0), 120) + 8; loc0 = rmin; nloc = rmax - rmin; nloc += nloc & 1; }
    }
    const int NT = 4 + nloc;
#define TROW(t) ((t) < 4 ? TX + b * CTXL + 64 * (t) : (MODE == 1 ? b * SEQ + loc0 + 64 * ((t) - 4) : b * SEQ + 64 * (loc0 + (t) - 4)))
    const int qrow0 = (ctxq ? TX + b * CTXL : b * SEQ + qb * 256) + wid * 32;
    const int qw0 = qb * 256 + wid * 32;
    const unsigned koff = (unsigned)(lane * INW + kcolP + wid * 8) * 2u, voff = (unsigned)((16 * (wid & 3) + (lane >> 2)) * INW + vcolP + (wid >> 2) * 32 + (lane & 3) * 8) * 2u;
    const unsigned kdst = lds0 + L_K + wid * 1024, vdst = lds0 + L_V + wid * 1024;
#define DMA_K(t, slot) glds16s(P + (size_t)TROW(t) * INW, koff, (unsigned)__builtin_amdgcn_readfirstlane(kdst + (slot)))
#define DMA_V(t, slot) glds16s(P + (size_t)TROW(t) * INW, voff, (unsigned)__builtin_amdgcn_readfirstlane(vdst + (slot)))
    bf16x8 kf[8];
    const lcp shm3 = (lcp)c.lds; const lcp kp0 = shm3 + L_K + hi * 1024 + r32 * 16;
    const lcp vp0 = shm3 + L_V + ((lane >> 4) & 1) * 32 + (lane & 3) * 8 + (4 * hi + ((lane & 15) >> 2)) * 64;
    asm volatile("s_waitcnt vmcnt(0)" ::: "memory");
    DMA_K(0, 0); DMA_V(0, 0); DMA_K(1, SLOTB);
    if (MODE == 2) { for (int i = lane_id_fresh() + 64 * wid; i < 465; i += NTHREADS) tab[i] = p.rpb[(size_t)(layer * 4 + h) * 465 + i] * 1.4426950408889634f; }
    bf16x8 qr[4];
    { const bf16_t* Qw = P + (size_t)(qrow0 + r32) * INW + qcolP + hi * 8;
#pragma unroll
      for (int d0 = 0; d0 < 4; ++d0) qr[d0] = *(const bf16x8*)(Qw + d0 * 16); }
    float mhat = 0.f, l_reg = 0.f; f32x16 o[2];
#pragma unroll
    for (int r = 0; r < 16; ++r) { o[0][r] = 0.f; o[1][r] = 0.f; }
    f32x16 negm;
#pragma unroll
    for (int r = 0; r < 16; ++r) negm[r] = 0.f;
    asm volatile("" : "+v"(negm));
    bool resc = false;
#define CMASK(C0_, C1_, t) do { const int tl_ = (t) - 4; if (!ctxq && tl_ >= 0) fmask<MODE>(C0_, C1_, tl_, loc0, qw0, tab); } while (0)
#define START(P0, P1) do { const float rm = rowmax(P0, P1); resc = false; \
    { const float dl = rm; mhat = fadd_s(mhat, dl); \
      _Pragma("unroll") for (int r = 0; r < 16; ++r) { P0[r] = fsub_s(P0[r], dl); P1[r] = fsub_s(P1[r], dl); } \
      _Pragma("unroll") for (int r = 0; r < 16; ++r) negm[r] = -mhat; asm volatile("" : "+v"(negm)); } \
    _Pragma("unroll") for (int r = 0; r < 16; ++r) P0[r] = __builtin_amdgcn_exp2f(P0[r]); } while (0)
#define RESC() do { if (resc) { asm volatile("s_waitcnt lgkmcnt(0)" ::: "memory"); \
      _Pragma("unroll") for (int r = 0; r < 16; ++r) { const float f_ = wsf[crow(r, hi)]; o[0][r] *= f_; o[1][r] *= f_; } } } while (0)
    f32x16 pA0, pA1, pB0, pB1;
    int sl_prev = 0, sl_cur = 0, sl_next = SLOTB;
#define ROT() do { sl_prev = sl_cur; sl_cur = sl_next; sl_next = (sl_next == (NSLOT - 1) * SLOTB) ? 0 : sl_next + SLOTB; } while (0)
    DMA_K(2, 2 * SLOTB);
    WAIT_BAR(3);
    {
        const lcp kb = kp0;
#pragma unroll
        for (int d0 = 0; d0 < 4; ++d0) {
            const bf16x8 b0 = *(const LAS bf16x8*)(kb + d0 * 2048), b1 = *(const LAS bf16x8*)(kb + d0 * 2048 + 512);
            if (d0 == 0) { pA0 = MFMA32(b0, qr[0], negm); pA1 = MFMA32(b1, qr[0], negm); }
            else { pA0 = MFMA32(b0, qr[d0], pA0); pA1 = MFMA32(b1, qr[d0], pA1); } }
        asm volatile("s_nop 15\n\ts_nop 7" : "+v"(pA0), "+v"(pA1));
    }
    START(pA0, pA1);
#pragma unroll
    for (int r = 0; r < 16; ++r) pA1[r] = __builtin_amdgcn_exp2f(pA1[r]);
    WAIT_BAR(0);
    DMA_K(3, 0); DMA_V(1, SLOTB);
    ROT();
#define KLOAD8(kp_) do { kf[0] = *(const LAS bf16x8*)(kp_); kf[1] = *(const LAS bf16x8*)((kp_) + 512); kf[2] = *(const LAS bf16x8*)((kp_) + 2048); kf[3] = *(const LAS bf16x8*)((kp_) + 2560); \
        kf[4] = *(const LAS bf16x8*)((kp_) + 4096); kf[5] = *(const LAS bf16x8*)((kp_) + 4608); kf[6] = *(const LAS bf16x8*)((kp_) + 6144); kf[7] = *(const LAS bf16x8*)((kp_) + 6656); } while (0)
    KLOAD8(kp0 + sl_cur);
    WAIT_BAR(2);
    s16x4 vlo[8], vhi[8]; u32x4 pw0, pw1, pw2, pw3;
#define PKW(P_, B_) pk2(P_[B_], P_[B_ + 1])
#define PAF(k) __builtin_bit_cast(bf16x8, pw##k)
#define VFR(i) (bf16x8){vlo[i][0], vlo[i][1], vlo[i][2], vlo[i][3], vhi[i][0], vhi[i][1], vhi[i][2], vhi[i][3]}
#define PIN(x) asm volatile("" : "+v"(x))
#define MX3(a, b, c_) __builtin_fmaxf(__builtin_fmaxf((a), (b)), (c_))
#define GAPA(MF, A0, A1, A2, A3, W0, W1, PW) do { MF; sacc += A0; sacc += A1; sacc += A2; sacc += A3; PIN(sacc); W0; W1; PIN(PW); SBAR(); } while (0)
#define EX(v) __builtin_amdgcn_exp2f(v)
#define GAPB(MF, X, B_) do { MF; X[B_] = EX(X[B_]); X[B_ + 1] = EX(X[B_ + 1]); X[B_ + 2] = EX(X[B_ + 2]); X[B_ + 3] = EX(X[B_ + 3]); PIN(X); SBAR(); } while (0)
#define VRD(i) do { vlo[i] = vtr(vp_ + (((i) >> 2) * 4096 + ((i) & 3) * 1024)); vhi[i] = vtr(vp_ + (((i) >> 2) * 4096 + ((i) & 3) * 1024 + 512)); } while (0)
#define KRD(G_, j) do { if (G_) { const lcp kn_ = kp0 + sl_next; kf[2 * (j)] = *(const LAS bf16x8*)(kn_ + (j) * 2048); kf[2 * (j) + 1] = *(const LAS bf16x8*)(kn_ + (j) * 2048 + 512); SBAR(); } } while (0)
#define STEP(C0, C1, P0, P1, t, GK, GV, GL) do { SBAR(); \
    const lcp vp_ = vp0 + sl_prev; \
    VRD(0); SBAR(); float sacc = (P0[0] + P0[1]); \
    GAPA(C0 = MFMA32(kf[0], qr[0], negm), P0[2], P0[3], P0[4], P0[5],     pw0[0] = PKW(P0, 0), pw0[1] = PKW(P0, 2), pw0); \
    VRD(4); SBAR(); GAPA(C1 = MFMA32(kf[1], qr[0], negm), P0[6], P0[7], P0[8], P0[9],     pw0[2] = PKW(P0, 4), pw0[3] = PKW(P0, 6), pw0); \
    VRD(1); SBAR(); GAPA(C0 = MFMA32(kf[2], qr[1], C0),   P0[10], P0[11], P0[12], P0[13], pw1[0] = PKW(P0, 8), pw1[1] = PKW(P0, 10), pw1); \
    VRD(5); SBAR(); GAPA(C1 = MFMA32(kf[3], qr[1], C1),   P0[14], P0[15], P1[0], P1[1],   pw1[2] = PKW(P0, 12), pw1[3] = PKW(P0, 14), pw1); \
    VRD(2); SBAR(); GAPA(C0 = MFMA32(kf[4], qr[2], C0),   P1[2], P1[3], P1[4], P1[5],     pw2[0] = PKW(P1, 0), pw2[1] = PKW(P1, 2), pw2); \
    VRD(6); SBAR(); GAPA(C1 = MFMA32(kf[5], qr[2], C1),   P1[6], P1[7], P1[8], P1[9],     pw2[2] = PKW(P1, 4), pw2[3] = PKW(P1, 6), pw2); \
    VRD(3); SBAR(); GAPA(C0 = MFMA32(kf[6], qr[3], C0),   P1[10], P1[11], P1[12], P1[13], pw3[0] = PKW(P1, 8), pw3[1] = PKW(P1, 10), pw3); \
    VRD(7); SBAR(); GAPA(C1 = MFMA32(kf[7], qr[3], C1),   P1[14], P1[15], 0.f, 0.f,       pw3[2] = PKW(P1, 12), pw3[3] = PKW(P1, 14), pw3); \
    l_reg += sacc; \
    if (GK) { DMA_K((t) + 3, sl_cur); } if (GV) { DMA_V((t) + 1, sl_next); } \
    CMASK(C0, C1, t); \
    { float a = MX3(C0[0], C0[1], C1[0]), b_ = MX3(C0[2], C0[3], C1[1]); a = MX3(a, C1[2], C1[3]); \
      _Pragma("unroll") for (int r = 4; r < 16; r += 4) { a = MX3(a, C0[r], C0[r + 1]); b_ = MX3(b_, C0[r + 2], C0[r + 3]); a = MX3(a, C1[r], C1[r + 1]); b_ = MX3(b_, C1[r + 2], C1[r + 3]); } \
      float rm = __builtin_fmaxf(a, b_); { auto rr = __builtin_amdgcn_permlane32_swap(__float_as_uint(rm), __float_as_uint(rm), false, false); rm = __builtin_fmaxf(__uint_as_float(rr[0]), __uint_as_float(rr[1])); } \
      resc = false; \
      if (__builtin_expect(__builtin_amdgcn_ballot_w64(rm > (float)THRL) != 0ull, 0)) { const float dl = __builtin_fmaxf(rm, 0.f); mhat += dl; \
        _Pragma("unroll") for (int r = 0; r < 16; ++r) { C0[r] -= dl; C1[r] -= dl; } \
        _Pragma("unroll") for (int r = 0; r < 16; ++r) negm[r] = -mhat; asm volatile("" : "+v"(negm)); \
        const float f = __builtin_amdgcn_exp2f(-dl); l_reg *= f; if (hi == 0) wsf[r32] = f; resc = true; } } \
    SBAR(); \
    GAPB(o[0] = MFMA32(PAF(0), VFR(0), o[0]), C0, 0); \
    GAPB(o[1] = MFMA32(PAF(0), VFR(4), o[1]), C0, 4); \
    KRD(GL, 0); GAPB(o[0] = MFMA32(PAF(1), VFR(1), o[0]), C0, 8); \
    KRD(GL, 1); GAPB(o[1] = MFMA32(PAF(1), VFR(5), o[1]), C0, 12); \
    KRD(GL, 2); GAPB(o[0] = MFMA32(PAF(2), VFR(2), o[0]), C1, 0); \
    KRD(GL, 3); GAPB(o[1] = MFMA32(PAF(2), VFR(6), o[1]), C1, 4); \
    GAPB(o[0] = MFMA32(PAF(3), VFR(3), o[0]), C1, 8); \
    GAPB(o[1] = MFMA32(PAF(3), VFR(7), o[1]), C1, 12); \
    } while (0)
#define ENDW(tt) do { if ((tt) + 3 < NT) { WAIT_BAR(2); } else if ((tt) + 2 < NT) { WAIT_BAR(1); } else { WAIT_BAR(0); } } while (0)
    int t = 1;
    for (; t + 1 < NT; t += 2) {
        STEP(pB0, pB1, pA0, pA1, t, (t + 3 < NT), (t + 1 < NT), (t + 1 < NT));         ENDW(t);     RESC(); ROT();
        STEP(pA0, pA1, pB0, pB1, t + 1, (t + 4 < NT), (t + 2 < NT), (t + 2 < NT));     ENDW(t + 1); RESC(); ROT();
    }
    STEP(pB0, pB1, pA0, pA1, NT - 1, false, false, false); RESC();
    { float sacc = pB0[0] + pB0[1];
#pragma unroll
      for (int r = 2; r < 16; ++r) sacc += pB0[r];
#pragma unroll
      for (int r = 0; r < 16; ++r) sacc += pB1[r];
      l_reg += sacc;
      pw0 = (u32x4){PKW(pB0, 0), PKW(pB0, 2), PKW(pB0, 4), PKW(pB0, 6)}; pw1 = (u32x4){PKW(pB0, 8), PKW(pB0, 10), PKW(pB0, 12), PKW(pB0, 14)};
      pw2 = (u32x4){PKW(pB1, 0), PKW(pB1, 2), PKW(pB1, 4), PKW(pB1, 6)}; pw3 = (u32x4){PKW(pB1, 8), PKW(pB1, 10), PKW(pB1, 12), PKW(pB1, 14)};
      SBAR(); pv(o, (int)(uintptr_t)vp0 + sl_cur, PAF(0), PAF(1), PAF(2), PAF(3)); }
#undef PKW
#undef PAF
#undef VFR
#undef PIN
#undef MX3
#undef GAPA
#undef GAPB
#undef EX
#undef VRD
#undef KRD
#undef STEP
#undef ENDW
#undef KLOAD8
    { auto rr = __builtin_amdgcn_permlane32_swap(__float_as_uint(l_reg), __float_as_uint(l_reg), false, false); l_reg = __uint_as_float(rr[0]) + __uint_as_float(rr[1]); }
    if (MODE == 1) l_reg += __builtin_amdgcn_exp2f(p.sink[layer * 4 + h] * 1.4426950408889634f - mhat);
    {
        const int lnf = lane_id_fresh(), r32f = lnf & 31, hif = lnf >> 5;
        if (hif == 0) wsf[32 + r32f] = l_reg;
        asm volatile("s_waitcnt lgkmcnt(0)" ::: "memory");
        LAS bf16_t* stg = (LAS bf16_t*)(c.lds + F_OST) + wid * 2048;
#pragma unroll
        for (int r = 0; r < 16; ++r) { const int orow = crow(r, hif); const float rl = __builtin_amdgcn_rcpf(wsf[32 + orow]);
            stg[orow * 64 + r32f] = f2bf(o[0][r] * rl); stg[orow * 64 + 32 + r32f] = f2bf(o[1][r] * rl); }
        asm volatile("s_waitcnt lgkmcnt(0)" ::: "memory");
        bf16_t* Ow = YC + (size_t)qrow0 * D + ycol;
#pragma unroll
        for (int i = 0; i < 4; ++i) { const int row = i * 8 + (lnf >> 3), ch = lnf & 7; const u32x4 v = *(const LAS u32x4*)(stg + row * 64 + ch * 8); *(u32x4*)(Ow + (size_t)row * D + ch * 8) = v; } }
    asm volatile("s_waitcnt lgkmcnt(0)\n\ts_barrier" ::: "memory");
#undef DMA_K
#undef DMA_V
#undef CMASK
#undef START
#undef RESC
#undef ROT
#undef TROW
}
#undef SBAR
#undef WAIT_BAR
}

template <int MODE>
DI void phase_fa64(const Params& p, const Cx& c0, int layer, int ctxq, int first_blk = 0) {
    const Cx c = fresh(c0);
    const int nunits = ctxq ? NB * 4 : NB * 4 * 32;
    __syncthreads();
    for (int unit = c.vcu >= first_blk ? c.vcu - first_blk : c.vcu - first_blk + c.G; unit < nunits; unit += c.G) {
        const int qb = ctxq ? 0 : unit & 31, h = ctxq ? unit & 3 : (unit >> 5) & 3, b = ctxq ? unit >> 2 : unit >> 7;
        da2::unit64<MODE, 8>(p, c, layer, b, h, qb, ctxq);
    }
    __syncthreads();
}
template <int l>
DI void layer_body(const Params& p, const Cx& c, const XcdBarrier& bar) {
    unsigned char* ws = p.ws;
    bf16_t* H = (bf16_t*)(ws + OFF_H);
    bf16_t* P = (bf16_t*)(ws + OFF_A + A_P);
    bf16_t* ACT = (bf16_t*)(ws + OFF_A + A_ACT);
    const int bid = (int)blockIdx.x;
        if (l == 0) { phase_norm1(p, c, l); xcd_barrier(bar); }
        {
            pg8::Gemm g{H, (const bf16_t*)(ws + OFF_WIN) + (size_t)l * INW * D, D}; pg8::StaticOrder S; S.init(T, INW, D, c.G, bid);
            pg8::EpiWin E{P, (bf16_t*)(ws + OFF_A + A_VT), (const float2*)(ws + OFF_ROPE)};
            pg8::gemm_phase<pg8::EpiWin, pg8::StaticOrder, true, false>(c.lds, g, S, E, c.wave);
        }
        bg_convert<(l == 0 ? 0 : 3)>(p, c);
        xcd_barrier(bar);
        phase_ret_u_mfma(p, c, l);
        phase_fa64<1>(p, c, l, 0);
        phase_fa64<2>(p, c, l, 0);
        phase_da2(p, c, l, 0);
        xcd_barrier(bar);
        phase_ret_scan2(p, c, l);
        bg_convert<(l == 0 ? 4 : 5)>(p, c);
        if (l == 0) phase_ret_out_mfma<true>(p, c, l, 0, c.G >= 168 ? 160 : 0);
        if (l == 0 && c.G >= 160) { phase_fa64<1>(p, c, l, 1, 128); phase_fa64<2>(p, c, l, 1, 136); phase_da2(p, c, l, 1, 144); }
        else if (l == 0) { phase_fa64<1>(p, c, l, 1); phase_fa64<2>(p, c, l, 1); phase_da2(p, c, l, 1); }
        xcd_barrier(bar);
        phase_ret_out_mfma<false>(p, c, l, 2);
        xcd_barrier(bar);
        if (l == 0) {
            pg8::Gemm g{H, (const bf16_t*)(ws + OFF_WOUT) + (size_t)l * D * D, D}; pg8::SplitOrder S; S.init(TX, TC, D, D, WOUT_SPLIT, c.G, bid);
            pg8::EpiBf16 E{(bf16_t*)(ws + OFF_B), D, 0, 0, (float*)(ws + OFF_B + B_SLAB_Y), TX, TC, 1.f};
            pg8::gemm_phase<pg8::EpiBf16, pg8::SplitOrder, true, false>(c.lds, g, S, E, c.wave);
            bg_convert<1>(p, c);
        } else {
            pg8::Gemm g{H, (const bf16_t*)(ws + OFF_WOUT) + (size_t)l * D * D, D}; pg8::StaticOrder S; S.init(TX, D, D, c.G, bid);
            pg8::EpiBf16 E{(bf16_t*)(ws + OFF_B), D, 0, 0, nullptr, 0, 0, 1.f};
            pg8::gemm_phase<pg8::EpiBf16, pg8::StaticOrder, true, false>(c.lds, g, S, E, c.wave);
        }
        xcd_barrier(bar);
        phase_post_attn(p, c, l);
        xcd_barrier(bar);
        if (l == 0) {
            {
                pg8::Gemm g{(const bf16_t*)(ws + OFF_H8), (const bf16_t*)(ws + OFF_WGU), D}; pg8::StaticOrder S; S.init(T, 2 * FF, D / 2, c.G, bid);
                pg8::EpiSwiglu8 E{ws + OFF_A + A_ACT, FF, 0, W8_INV, ACT8_SCALE};
                pg8::gemm_phase<pg8::EpiSwiglu8, pg8::StaticOrder, true, false, true>(c.lds, g, S, E, c.wave); }
            bg_convert<2>(p, c);
            xcd_barrier(bar);
            {
                pg8::Gemm g{(const bf16_t*)(ws + OFF_A + A_ACT), (const bf16_t*)(ws + OFF_WD), FF}; pg8::SplitOrder S; S.init(TX, TC, D, FF / 2, FFD_SPLIT, c.G, bid);
                pg8::EpiBf16 E{(bf16_t*)(ws + OFF_B), D, 0, 0, (float*)(ws + OFF_B + B_SLAB_F), TX, TC, W8_INV / ACT8_SCALE};
                pg8::gemm_phase<pg8::EpiBf16, pg8::SplitOrder, true, false, true>(c.lds, g, S, E, c.wave); }
            xcd_barrier(bar);
        } else {
            {
                pg8::Gemm g{(const bf16_t*)(ws + OFF_H8), (const bf16_t*)(ws + OFF_MGU), D}; pg8::MoeOrder S; S.init((const unsigned*)(ws + OFF_CNT), (const int*)(ws + OFF_TLIST), 2 * ED / 256, D / 128, c.G, c.vcu);
                pg8::EpiSwiglu8 E{ws + OFF_A + A_ACT, ED, 2 * ED / 256, W8_INV, 1.f};
                pg8::gemm_phase<pg8::EpiSwiglu8, pg8::MoeOrder, true, true, true>(c.lds, g, S, E, c.wave); }
            xcd_barrier(bar);
            {
                pg8::Gemm g{(const bf16_t*)(ws + OFF_A + A_ACT), (const bf16_t*)(ws + OFF_MD), ED}; pg8::MoeOrder S; S.init((const unsigned*)(ws + OFF_CNT), (const int*)(ws + OFF_TLIST), D / 256, ED / 128, c.G, c.vcu);
                pg8::EpiBf16S E{(bf16_t*)(ws + OFF_B), D, D / 256, W8_INV};
                pg8::gemm_phase<pg8::EpiBf16S, pg8::MoeOrder, true, false, true>(c.lds, g, S, E, c.wave); }
            xcd_barrier(bar);
        }
        phase_post_ffn(p, c, l);
        if (l == 0) xcd_barrier(bar);
}

__global__ void __launch_bounds__(NTHREADS, 2) mega_fwd(Params p) {
    extern __shared__ __attribute__((aligned(16))) unsigned char lds_raw[];
    Cx c;
    c.lds = (LAS unsigned char*)lds_raw;
    c.tid = threadIdx.x; c.lane = c.tid & 63; c.wave = __builtin_amdgcn_readfirstlane(c.tid >> 6);
    c.G = gridDim.x; { const int bx = blockIdx.x; c.vcu = (c.G % 8 == 0) ? (bx % 8) * (c.G / 8) + bx / 8 : bx; }
    for (int u = c.tid; u < (LDS_BYTES - LDSCTL_OFF) / 4; u += NTHREADS) ((LAS unsigned*)(c.lds + LDSCTL_OFF))[u] = 0u;
    __syncthreads();
    XcdBarrier bar = xcd_barrier_post((unsigned*)(p.ws + OFF_BAR), (volatile LAS unsigned*)(c.lds + LDSCTL_OFF + 64));

    phase_convert(p, c);
    phase_mod(p, c);
    xcd_barrier(bar);
    layer_body<0>(p, c, bar);
    layer_body<1>(p, c, bar);
}

extern "C" void kernel_launch(void* const* d_in, const int* in_sizes, int n_in, void* d_out, int out_size, void* d_ws, size_t ws_size, hipStream_t stream) {
    static int grid = 0;
    if (grid == 0) {
        if (n_in != 28 || ws_size < WS_NEED) { fprintf(stderr, "kernel_launch: need 28 inputs and %zu bytes of workspace (got %d, %zu)\n", (size_t)WS_NEED, n_in, ws_size); grid = -1; return; }
        int dev = 0, cus = 0, per_cu = 0;
        if (hipGetDevice(&dev) != hipSuccess || hipDeviceGetAttribute(&cus, hipDeviceAttributeMultiprocessorCount, dev) != hipSuccess) { grid = -1; return; }
        if (hipFuncSetAttribute((const void*)mega_fwd, hipFuncAttributeMaxDynamicSharedMemorySize, LDS_BYTES) != hipSuccess) { fprintf(stderr, "kernel_launch: hipFuncSetAttribute failed\n"); grid = -1; return; }
        if (hipOccupancyMaxActiveBlocksPerMultiprocessor(&per_cu, (const void*)mega_fwd, NTHREADS, LDS_BYTES) != hipSuccess || per_cu < 1) { fprintf(stderr, "kernel_launch: occupancy query says %d\n", per_cu); }
        (void)hipGetLastError();
        grid = cus;
    }
    if (grid < 0) return;
    Params p{};
    const float* const* in = (const float* const*)d_in;
    p.x = in[0]; p.c = in[1]; p.ctx = in[2]; p.c_ctx = in[3]; p.w_mod = in[4]; p.b_mod = in[5]; p.g_attn_pre = in[6]; p.g_attn_post = in[7]; p.g_ffn_pre = in[8]; p.g_ffn_post = in[9];
    p.w_in = in[10]; p.w_out = in[11]; p.lq1 = in[12]; p.lk1 = in[13]; p.lq2 = in[14]; p.lk2 = in[15]; p.subln = in[16]; p.sink = in[17]; p.rpb = in[18]; p.gam_f = in[19]; p.gam_b = in[20];
    p.ffn_wg = in[21]; p.ffn_wu = in[22]; p.ffn_wd = in[23]; p.router = in[24]; p.moe_wg = in[25]; p.moe_wu = in[26]; p.moe_wd = in[27];
    p.out = (float*)d_out; p.ws = (unsigned char*)d_ws;
    if (hipMemsetAsync(d_ws, 0, CTL_ZERO_BYTES, stream) != hipSuccess) return;
    hipLaunchKernelGGL(mega_fwd, dim3(grid), dim3(NTHREADS), LDS_BYTES, stream, p);
}
```

```cpp
#include <hip/hip_runtime.h>
#include <stdint.h>
#include <stddef.h>
#include <stdio.h>

typedef unsigned short bf16_t;
typedef short bf16x8 __attribute__((ext_vector_type(8)));
typedef float f32x4 __attribute__((ext_vector_type(4)));
typedef unsigned u32x4 __attribute__((ext_vector_type(4)));
typedef unsigned u32x2 __attribute__((ext_vector_type(2)));
#define LAS __attribute__((address_space(3)))
#define DI __device__ __forceinline__
typedef LAS float lfloat;
typedef float f32x16 __attribute__((ext_vector_type(16)));
#define MFMA32(a, b, c) __builtin_amdgcn_mfma_f32_32x32x16_bf16((a), (b), (c), 0, 0, 0)

constexpr int D = 1024, SEQ = 8192, NB = 2, CTXL = 256;
constexpr int TX = NB * SEQ;
constexpr int TC = NB * CTXL;
constexpr int T = TX + TC;
constexpr int INW = 3072, FF = 2816, NE = 8, ED = 3584;
constexpr int NCH = 66;
constexpr float EPS = 1e-6f;
constexpr int MOE_ROWS = 34816;
constexpr int PASS_TILES = 64, PASS_ROWS = PASS_TILES * 256;
constexpr int PASS1_ROWS = MOE_ROWS - PASS_ROWS;
constexpr int NTHREADS = 512, NWAVES = 8;

constexpr int DA_Q = 0, DA_K = 256, DA_V = 512;
constexpr int SW_Q = 768, SW_K = 1024, SW_V = 1152;
constexpr int NA_Q = 1280, NA_K = 1536, NA_V = 1792;
constexpr int RT_Q = 2048, RT_K = 2304, RT_V = 2560, RT_G = 2816;

constexpr size_t al256(size_t x) { return (x + 255) & ~(size_t)255; }
constexpr size_t OFF_BAR = 0;
constexpr size_t OFF_CNT = 16384;
constexpr size_t CTL_ZERO_BYTES = 32768;
constexpr size_t OFF_MOD = 32768;
constexpr size_t OFF_ROPE = al256(OFF_MOD + 2 * 3 * 6144 * 4);
constexpr size_t OFF_TLIST = al256(OFF_ROPE + 128 * 24 * 8);
constexpr size_t OFF_TOKE = OFF_TLIST + 8 * 16384 * 4;
constexpr size_t OFF_TOKJ = OFF_TOKE + 16384 * 2 * 4;
constexpr size_t OFF_TOKW = OFF_TOKJ + 16384 * 2 * 4;
constexpr size_t OFF_XC = OFF_TOKW + 16384 * 2 * 4;
constexpr size_t OFF_WIN = OFF_XC + (size_t)TC * D * 4;
constexpr size_t OFF_WOUT = OFF_WIN + (size_t)2 * INW * D * 2;
constexpr size_t OFF_WGU = OFF_WOUT + (size_t)2 * D * D * 2;
constexpr size_t OFF_WD = OFF_WGU + (size_t)2 * FF * D * 2;
constexpr size_t OFF_MGU = OFF_WD + (size_t)D * FF * 2;
constexpr size_t OFF_MD = OFF_MGU + (size_t)NE * 2 * ED * D * 2;
constexpr size_t OFF_H8 = OFF_MD + (size_t)NE * D * ED;
constexpr size_t OFF_H = OFF_MD + (size_t)NE * D * ED * 2;
constexpr size_t OFF_A = OFF_H + (size_t)T * D * 2;
constexpr size_t A_P = 0;
constexpr size_t A_U = A_P + (size_t)T * INW * 2;
constexpr size_t A_S = A_U + (size_t)NB * 4 * 2 * NCH * 4096 * 4;
constexpr size_t A_VT = A_S + (size_t)NB * 4 * 2 * NCH * 4096 * 4;
constexpr int NKEY = CTXL + SEQ;
constexpr int VH_DA = 0, VH_SW = 4, VH_NA = 6, VH_RT = 10, NVH = 14;
constexpr size_t A_END = A_VT + (size_t)NB * NVH * 64 * NKEY * 2;
constexpr size_t A_ACT = 0;
constexpr size_t SZ_A = A_END > (size_t)MOE_ROWS * ED ? A_END : (size_t)MOE_ROWS * ED;
static_assert((size_t)T * D <= (size_t)NE * D * ED, "H8 fits behind MD8");
constexpr float ACT8_SCALE = 8.f;
constexpr float W8_SCALE = 64.f, W8_INV = 1.f / 64.f;
constexpr size_t OFF_B = OFF_A + al256(SZ_A);
constexpr size_t SZ_B = (size_t)MOE_ROWS * D * 2 > (size_t)T * D * 4 ? (size_t)MOE_ROWS * D * 2 : (size_t)T * D * 4;
constexpr size_t OFF_XS = OFF_B + al256(SZ_B);
constexpr size_t WS_NEED = OFF_XS + (size_t)T * D * 2;
constexpr int WOUT_SPLIT = 4, FFD_SPLIT = 11;
constexpr size_t B_SLAB_Y = (size_t)36 << 20;
constexpr size_t B_SLAB_F = B_SLAB_Y + (size_t)WOUT_SPLIT * TC * D * 4;
static_assert(B_SLAB_F + (size_t)FFD_SPLIT * TC * D * 4 <= SZ_B, "slabs fit");

constexpr int RING_BYTES = 131072, LDSCTL_OFF = RING_BYTES, LDS_BYTES = 147456;

struct Params {
    const float *x, *c, *ctx, *c_ctx, *w_mod, *b_mod, *g_attn_pre, *g_attn_post, *g_ffn_pre, *g_ffn_post, *w_in, *w_out;
    const float *lq1, *lk1, *lq2, *lk2, *subln, *sink, *rpb, *gam_f, *gam_b, *ffn_wg, *ffn_wu, *ffn_wd, *router, *moe_wg, *moe_wu, *moe_wd;
    float* out;
    unsigned char* ws;
};

DI float bf2f(bf16_t v) { return __uint_as_float(((unsigned)v) << 16); }
DI bf16_t f2bf(float f) { unsigned u = __float_as_uint(f); u += 0x7fffu + ((u >> 16) & 1u); return (bf16_t)(u >> 16); }
typedef __bf16 v2bf_t __attribute__((ext_vector_type(2)));
typedef float v2f_t __attribute__((ext_vector_type(2)));
DI unsigned pk2(float lo, float hi) { const v2f_t x = {lo, hi}; return __builtin_bit_cast(unsigned, __builtin_convertvector(x, v2bf_t)); }
DI float silu_f(float v) { return v / (1.f + __expf(-v)); }
DI int lane_id_fresh() { int ln; asm volatile("v_mbcnt_lo_u32_b32 %0, -1, 0\n\tv_mbcnt_hi_u32_b32 %0, -1, %0" : "=v"(ln)); return ln; }
DI float shx(float v, int mask, int lane) { return __int_as_float(__builtin_amdgcn_ds_bpermute((lane ^ mask) << 2, __float_as_int(v))); }
DI float wave_sum(float v, int lane) {
#pragma unroll
    for (int o = 1; o < 64; o <<= 1) v += shx(v, o, lane);
    return v;
}

DI const float* xin0_row(const Params& p, int row) { return row < TX ? p.x + (size_t)row * D : p.ctx + (size_t)(row - TX) * D; }
DI const float* mod_row(const Params& p, int layer, int row) {
    const int v = row < TX ? (row >> 13) : 2;
    return (const float*)(p.ws + OFF_MOD) + (size_t)(layer * 3 + v) * 6144;
}
#define XB_TMO      128
#define XB_XCNT(j)  (256  + 64 * (j))
#define XB_XSUB(j)  (1280 + 64 * (j))
#define XB_XGEN(j)  (2304 + 64 * (j))
#define XB_TOP      3328
#define XB_TOPGEN   3392
#define XCD_BAR_WORDS 3456
#define XB_SPIN_CAP (1u << 23)

__device__ __forceinline__ unsigned xb_ld(unsigned* p)              { return __hip_atomic_load(p, __ATOMIC_RELAXED, __HIP_MEMORY_SCOPE_AGENT); }
__device__ __forceinline__ unsigned xb_add(unsigned* p, unsigned v) { return __hip_atomic_fetch_add(p, v, __ATOMIC_RELAXED, __HIP_MEMORY_SCOPE_AGENT); }
__device__ __forceinline__ unsigned xb_xcc_id() { return (unsigned)__builtin_amdgcn_s_getreg((3 << 11) | 20) & 0xFu; }
#define XB_SPIN(cond, bar) do { unsigned _sp = 0; while (cond) { __builtin_amdgcn_s_sleep(1); \
    if ((++_sp & 255u) == 0u) { if (xb_ld(&(bar)[XB_TMO])) break; if (_sp > XB_SPIN_CAP) { atomicAdd(&(bar)[XB_TMO], 1u); break; } } } } while (0)

struct XcdBarrier {
    unsigned* bar; unsigned x;
    volatile LAS unsigned* st;
};

__device__ __forceinline__ XcdBarrier xcd_barrier_post(unsigned* bar, volatile LAS unsigned* st) {
    XcdBarrier b; b.bar = bar; b.x = xb_xcc_id(); b.st = st;
    if (threadIdx.x == 0) (void)xb_add(&bar[XB_XCNT(b.x)], 1u);
    return b;
}
__device__ __forceinline__ void xcd_barrier_complete(unsigned* bar, unsigned x, unsigned& nloc, unsigned& nx) {
    const unsigned G = gridDim.x * gridDim.y * gridDim.z;
    unsigned sum, cnt, mine, sp = 0u;
    for (;;) {
        sum = 0u; cnt = 0u; mine = 0u;
#pragma unroll
        for (unsigned j = 0; j < 16; ++j) { const unsigned c = xb_ld(&bar[XB_XCNT(j)]); sum += c; cnt += (c > 0u) ? 1u : 0u; mine = (j == x) ? c : mine; }
        if (sum == G) break;
        __builtin_amdgcn_s_sleep(1);
        if ((++sp & 255u) == 0u) { if (xb_ld(&bar[XB_TMO])) break; if (sp > XB_SPIN_CAP) { atomicAdd(&bar[XB_TMO], 1u); break; } }
    }
    nloc = mine > 0u ? mine : 1u; nx = cnt > 0u ? cnt : 1u;
}

__device__ __forceinline__ void xcd_barrier(const XcdBarrier& b) {
    asm volatile("s_waitcnt vmcnt(0)" ::: "memory");
    __syncthreads();
    if (threadIdx.x == 0) {
        unsigned* bar = b.bar;
        __builtin_amdgcn_s_waitcnt(0);
        unsigned nloc = b.st[0], nx = b.st[1];
        if (nloc == 0u) { xcd_barrier_complete(bar, b.x, nloc, nx); b.st[0] = nloc; b.st[1] = nx; }
        const unsigned old = xb_add(&bar[XB_XSUB(b.x)], 1u);
        const unsigned gen = old / nloc;
        if (old + 1u == (gen + 1u) * nloc) {
            __builtin_amdgcn_fence(__ATOMIC_RELEASE, "agent");
            asm volatile("s_waitcnt vmcnt(0)" ::: "memory");
            const unsigned og = xb_add(&bar[XB_TOP], 1u);
            const unsigned tg = og / nx;
            if (og + 1u == (tg + 1u) * nx) xb_add(&bar[XB_TOPGEN], 1u);
            else XB_SPIN(xb_ld(&bar[XB_TOPGEN]) == tg, bar);
            __builtin_amdgcn_fence(__ATOMIC_ACQUIRE, "agent");
            xb_add(&bar[XB_XGEN(b.x)], 1u);
            asm volatile("s_waitcnt vmcnt(0)" ::: "memory");
        } else {
            XB_SPIN(xb_ld(&bar[XB_XGEN(b.x)]) == gen, bar);
            __builtin_amdgcn_fence(__ATOMIC_ACQUIRE, "agent");
            asm volatile("s_waitcnt vmcnt(0)" ::: "memory");
        }
    }
    __syncthreads();
}
namespace pg8 {
typedef int v4i_t __attribute__((ext_vector_type(4)));
typedef int v8i_t __attribute__((ext_vector_type(8)));
constexpr int BM = 256, BK = 64, HALF = 128, HTB = HALF * BK * 2  , STAGE_BYTES = 8 * HTB, NXCD = 8, WGM = 8;
__host__ __device__ __forceinline__ int lds_byte(int r, int c) { const int st = (r >> 4) * 2 + (c >> 5), rr = r & 15, cc = c & 31, ob = rr * 64 + cc * 2; return st * 1024 + (ob ^ (((ob >> 9) & 1) << 5)); }
__host__ __device__ __forceinline__ void stage_rc(int b, int& R, int& C) { const int st = b / 1024, sb = b % 1024, swz = sb ^ (((sb >> 9) & 1) << 5); R = (st >> 1) * 16 + swz / 64; C = (st & 1) * 32 + (swz % 64) / 2; }
__host__ __device__ __forceinline__ int perm32(int rho) { const int n = rho >> 4, i = rho & 15; return 8 * (i >> 2) + 4 * n + (i & 3); }

struct Unit { int pm, pn, e, j0, kt0, nkt, slice; };
struct Gemm { const bf16_t* A; const bf16_t* Bt; int K; };

struct StaticOrder {
    int nM, nN, nwg, G, c, nkt;
    __device__ void init(int M, int N, int K, int G_, int c_) { nM = M / BM; nN = N / BM; nwg = nM * nN; G = G_; c = c_; nkt = K / BK; }
    __device__ bool next(int i, Unit& u) const {
        const long L = (long)i * G + c; if (L >= nwg) return false;
        int wgid = (int)L; { const int q = nwg / NXCD, r = nwg % NXCD, xcd = wgid % NXCD, off = wgid / NXCD; wgid = (xcd < r ? xcd * (q + 1) : r * (q + 1) + (xcd - r) * q) + off; }
        const int nig = WGM * nN, gid = wgid / nig, fm = gid * WGM, gsz = (nM - fm) < WGM ? (nM - fm) : WGM;
        u.pm = fm + ((wgid % nig) % gsz); u.pn = (wgid % nig) / gsz; u.e = 0; u.j0 = 0; u.kt0 = 0; u.nkt = nkt; u.slice = -1; return true;
    }
    __device__ __forceinline__ int arow(const Unit&, int) const { return 0; }
};
struct SplitOrder {
    StaticOrder main; int nExtra, S, nN, nktS;
    __device__ void init(int Mmain, int Mextra, int N, int K, int S_, int G_, int c_) { main.init(Mmain, N, K, G_, c_); nExtra = Mextra / BM; S = S_; nN = N / BM; nktS = (K / BK) / S_; }
    __device__ bool next(int i, Unit& u) const {
        const long L = (long)i * main.G + main.c;
        if (L < main.nwg) return main.next(i, u);
        const int idx = (int)(L - main.nwg); if (idx >= nExtra * nN * S) return false;
        const int sl = idx % S, r = idx / S;
        u.pm = main.nM + r / nN; u.pn = r % nN; u.e = 0; u.j0 = 0; u.kt0 = sl * nktS; u.nkt = nktS; u.slice = sl; return true;
    }
    __device__ __forceinline__ int arow(const Unit&, int) const { return 0; }
};

struct MoeOrder {
    int G, c, nN, t0, ntp, S, nktS; int tc[NE]; int cnt[NE]; const int* tlist;
    __device__ void init(const unsigned* cntp, const int* tl, int nN_, int nkt_, int G_, int c_) {
        G = G_; c = c_; nN = nN_; tlist = tl; S = 1; nktS = nkt_; int tot = 0;
#pragma unroll
        for (int e = 0; e < NE; ++e) { cnt[e] = (int)cntp[e]; tc[e] = (cnt[e] + 255) >> 8; tot += tc[e]; }
        t0 = 0; ntp = tot;
    }
    __device__ bool next(int i, Unit& u) const {
        const int L0 = i * G + c; if (L0 >= ntp * nN * S) return false;
        const int sl = L0 % S, L = L0 / S;
        const int g = L / (8 * nN), r = L - g * 8 * nN, gsz = (ntp - 8 * g) < 8 ? (ntp - 8 * g) : 8;
        const int pml = 8 * g + r % gsz, pnl = r / gsz, gt = t0 + pml;
        int e = 0, base = 0, run = 0; bool found = false;
#pragma unroll
        for (int k = 0; k < NE; ++k) { if (!found && gt < run + tc[k]) { e = k; base = run; found = true; } run += tc[k]; }
        u.pm = pml; u.pn = e * nN + pnl; u.e = e; u.j0 = (gt - base) * 256; u.kt0 = sl * nktS; u.nkt = nktS; u.slice = S > 1 ? sl : -1; return true;
    }
    __device__ __forceinline__ int arow(const Unit& u, int r) const {
        int j = u.j0 + r; int ce = 0;
#pragma unroll
        for (int k = 0; k < NE; ++k) ce = (u.e == k) ? cnt[k] : ce;
        if (j > ce - 1) j = ce - 1;
        return tlist[u.e * 16384 + j];
    }
};

struct EpiBf16 {
    bf16_t* O; int ldc; int row_off; int pn_mod; float* slab; int slab_row0, slab_rows; float scale;
    DI void operator()(const f32x4 (&acc)[2][2][4][2], const Unit& u, int wr, int wc, int fr, int fq) const {
        const int pn = pn_mod ? u.pn % pn_mod : u.pn;
        const int row0 = row_off + u.pm * BM + wr * 64 + fr, col0 = pn * BM + wc * 32 + 8 * fq;
        if (u.slice >= 0) {
#pragma unroll
            for (int ai = 0; ai < 2; ++ai)
#pragma unroll
                for (int m = 0; m < 4; ++m) { float* rowp = slab + ((size_t)u.slice * slab_rows + (row0 - slab_row0 + ai * HALF + m * 16)) * ldc + col0;
#pragma unroll
                    for (int bj = 0; bj < 2; ++bj) { *(f32x4*)(rowp + bj * HALF) = acc[ai][bj][m][0] * scale; *(f32x4*)(rowp + bj * HALF + 4) = acc[ai][bj][m][1] * scale; } }
            return;
        }
#pragma unroll
        for (int ai = 0; ai < 2; ++ai)
#pragma unroll
            for (int m = 0; m < 4; ++m) { bf16_t* rowp = O + (size_t)(row0 + ai * HALF + m * 16) * ldc + col0;
#pragma unroll
                for (int bj = 0; bj < 2; ++bj) { const f32x4 v0 = acc[ai][bj][m][0] * scale, v1 = acc[ai][bj][m][1] * scale;
                    u32x4 w; w.x = pk2(v0[0], v0[1]); w.y = pk2(v0[2], v0[3]); w.z = pk2(v1[0], v1[1]); w.w = pk2(v1[2], v1[3]);
                    *(u32x4*)(rowp + bj * HALF) = w; } }
    }
};
DI float clamp8(float x) { return fminf(fmaxf(x, -448.f), 448.f); }
DI unsigned pk4_fp8(float a, float b, float c_, float d) { int w = 0; w = __builtin_amdgcn_cvt_pk_fp8_f32(a, b, w, false); w = __builtin_amdgcn_cvt_pk_fp8_f32(c_, d, w, true); return (unsigned)w; }
struct EpiSwiglu8 {
    unsigned char* O; int ldc; int pn_mod; float sc, asc;
    DI void operator()(const f32x4 (&acc)[2][2][4][2], const Unit& u, int wr, int wc, int fr, int fq) const {
        const int pn = pn_mod ? u.pn % pn_mod : u.pn;
        const int row0 = u.pm * BM + wr * 64 + fr, col0 = pn * HALF + wc * 32 + 8 * fq;
        const float k1 = -sc * 1.4426950408889634f, k2 = sc * sc * asc;
#pragma unroll
        for (int ai = 0; ai < 2; ++ai)
#pragma unroll
            for (int m = 0; m < 4; ++m) {
                float o[8];
#pragma unroll
                for (int n = 0; n < 2; ++n)
#pragma unroll
                    for (int k = 0; k < 4; ++k) { const float ag = acc[ai][0][m][n][k], au = acc[ai][1][m][n][k];
                        const float r = __builtin_amdgcn_rcpf(1.f + __builtin_amdgcn_exp2f(ag * k1));
                        o[n * 4 + k] = __builtin_amdgcn_fmed3f((ag * k2) * au * r, -448.f, 448.f); }
                u32x2 w; w.x = pk4_fp8(o[0], o[1], o[2], o[3]); w.y = pk4_fp8(o[4], o[5], o[6], o[7]);
                *(u32x2*)(O + (size_t)(row0 + ai * HALF + m * 16) * ldc + col0) = w; }
    }
};
struct EpiBf16S {
    bf16_t* O; int ldc; int pn_mod; float scale;
    DI void operator()(const f32x4 (&acc)[2][2][4][2], const Unit& u, int wr, int wc, int fr, int fq) const {
        const int pn = pn_mod ? u.pn % pn_mod : u.pn;
        const int row0 = u.pm * BM + wr * 64 + fr, col0 = pn * BM + wc * 32 + 8 * fq;
#pragma unroll
        for (int ai = 0; ai < 2; ++ai)
#pragma unroll
            for (int m = 0; m < 4; ++m) { bf16_t* rowp = O + (size_t)(row0 + ai * HALF + m * 16) * ldc + col0;
#pragma unroll
                for (int bj = 0; bj < 2; ++bj) { const f32x4 v0 = acc[ai][bj][m][0] * scale, v1 = acc[ai][bj][m][1] * scale;
                    u32x4 w; w.x = pk2(v0[0], v0[1]); w.y = pk2(v0[2], v0[3]); w.z = pk2(v1[0], v1[1]); w.w = pk2(v1[2], v1[3]);
                    *(u32x4*)(rowp + bj * HALF) = w; } }
    }
};
struct EpiF32 {
    float* O; int ldc;
    DI void operator()(const f32x4 (&acc)[2][2][4][2], const Unit& u, int wr, int wc, int fr, int fq) const {
        const int row0 = u.pm * BM + wr * 64 + fr, col0 = u.pn * BM + wc * 32 + 8 * fq;
#pragma unroll
        for (int ai = 0; ai < 2; ++ai)
#pragma unroll
            for (int m = 0; m < 4; ++m) { float* rowp = O + (size_t)(row0 + ai * HALF + m * 16) * ldc + col0;
#pragma unroll
                for (int bj = 0; bj < 2; ++bj) { *(f32x4*)(rowp + bj * HALF) = acc[ai][bj][m][0]; *(f32x4*)(rowp + bj * HALF + 4) = acc[ai][bj][m][1]; } }
    }
};
struct EpiSwiglu {
    bf16_t* O; int ldc; int pn_mod;
    DI void operator()(const f32x4 (&acc)[2][2][4][2], const Unit& u, int wr, int wc, int fr, int fq) const {
        const int pn = pn_mod ? u.pn % pn_mod : u.pn;
        const int row0 = u.pm * BM + wr * 64 + fr, col0 = pn * HALF + wc * 32 + 8 * fq;
#pragma unroll
        for (int ai = 0; ai < 2; ++ai)
#pragma unroll
            for (int m = 0; m < 4; ++m) {
                float o[8];
#pragma unroll
                for (int n = 0; n < 2; ++n)
#pragma unroll
                    for (int k = 0; k < 4; ++k) { const float g = acc[ai][0][m][n][k], up = acc[ai][1][m][n][k]; o[n * 4 + k] = g * __builtin_amdgcn_rcpf(1.f + __expf(-g)) * up; }
                u32x4 w; w.x = pk2(o[0], o[1]); w.y = pk2(o[2], o[3]); w.z = pk2(o[4], o[5]); w.w = pk2(o[6], o[7]);
                *(u32x4*)(O + (size_t)(row0 + ai * HALF + m * 16) * ldc + col0) = w; }
    }
};


__host__ __device__ __forceinline__ int win_col_pos(int c) {
    if (c < 512) { const int g = (c >> 2) & 3; return (c & ~12) | ((g == 1 ? 2 : g == 2 ? 1 : g) << 2); }
    if ((c >= 768 && c < 1152) || (c >= 2048 && c < 2560)) { const int g = (c >> 2) & 7; return (c & ~28) | ((g < 4 ? 2 * g : 2 * (g - 4) + 1) << 2); }
    return c;
}
constexpr float DA_QSCALE = 0.17677669529663687f * 1.4426950408889634f, FA_QSCALE = 0.125f * 1.4426950408889634f;
struct EpiWin {
    bf16_t* P; bf16_t* VT; const float2* tab;
    DI void operator()(const f32x4 (&acc)[2][2][4][2], const Unit& u, int wr, int wc, int fr, int fq) const {
        const int lane = fq * 16 + fr;
        const bool xrows = u.pm < TX / BM;
#pragma unroll
        for (int bj = 0; bj < 2; ++bj) {
            const int cg = u.pn * BM + bj * HALF + wc * 32;
            int cls = 0;
            if (cg < 512) cls = 1;
            else if (cg < 768) cls = 0;
            else if (cg < 1152) cls = 2;
            else if (cg >= 2048 && cg < 2560) cls = 2;
            if (!xrows) cls = 0;
#pragma unroll
            for (int ai = 0; ai < 2; ++ai)
#pragma unroll
                for (int m = 0; m < 4; ++m) {
                    const int r = u.pm * BM + ai * HALF + wr * 64 + m * 16 + fr;
                    f32x4 v0 = acc[ai][bj][m][0], v1 = acc[ai][bj][m][1];
                    if (cg < 256) { v0 *= DA_QSCALE; v1 *= DA_QSCALE; }
                    else if ((cg >= 768 && cg < 1024) || (cg >= 1280 && cg < 1536)) { v0 *= FA_QSCALE; v1 *= FA_QSCALE; }
                    if (cls != 0) {
                        const int s = r & (SEQ - 1);
                        const int ax = cls == 1 ? (fq >> 1) : ((cg >> 5) & 1);
                        const int pos = ax ? (s & 63) : (s >> 6);
                        const float2* tb = tab + pos * 24 + (cls == 1 ? 4 * (fq & 1) : 8 + 4 * fq);
                        const f32x4 c01 = *(const f32x4*)(tb), c23 = *(const f32x4*)(tb + 2);
                        const f32x4 cs = (f32x4){c01[0], c01[2], c23[0], c23[2]}, sn = (f32x4){c01[1], c01[3], c23[1], c23[3]};
                        const f32x4 a = v0, b = v1;
                        v0 = a * cs - b * sn; v1 = b * cs + a * sn;
                    }
                    u32x4 w; w.x = pk2(v0[0], v0[1]); w.y = pk2(v0[2], v0[3]); w.z = pk2(v1[0], v1[1]); w.w = pk2(v1[2], v1[3]);
                    *(u32x4*)(P + (size_t)r * INW + cg + 8 * fq) = w;
                }
        }
    }
};

template <class Epi, class Sched, bool ALIGN_EPI, bool GATHER, bool FP8 = false>
DI void gemm_phase(LAS unsigned char* lds, const Gemm g, const Sched& S, const Epi& E, int wave_in) {
    int wv_ = wave_in; asm volatile("" : "+s"(wv_)); const int tid = lane_id_fresh() + 64 * wv_;
    const int wid = __builtin_amdgcn_readfirstlane(tid >> 6), lane = tid & 63, wr = wid >> 2, wc = wid & 3, fr = lane & 15, fq = lane >> 4;
    const int K = FP8 ? g.K / 2 : g.K;
    unsigned voffB[2]; int RA[2], CA[2];
#pragma unroll
    for (int i = 0; i < 2; ++i) { int R, C; stage_rc(tid * 16 + i * 8192, R, C); const int Rb = (R & ~31) + perm32(R & 31);
        RA[i] = R; CA[i] = C; voffB[i] = (unsigned)(Rb * K + C) * 2u; }
    const size_t kstep = (size_t)(BK * 2);
    const size_t hstep = (size_t)HALF * K * 2;
    const size_t tstep = 2 * hstep;
    const unsigned ldsw = (unsigned)wid * 1024u;
    const int aoff = lds_byte(wr * 64 + fr, fq * 8), boff = lds_byte(wc * 32 + fr, fq * 8);
#define PG8_SA(b, h) (((b) * 2 + (h)) * HTB)
#define PG8_SB(b, h) ((4 + (b) * 2 + (h)) * HTB)
#define PG8_STAGE(bufoff, gbase, voff) do { _Pragma("unroll") for (int _i = 0; _i < 2; ++_i) \
        __builtin_amdgcn_global_load_lds((const unsigned*)((const char*)(gbase) + (voff)[_i]), (LAS unsigned*)(lds + (bufoff) + ldsw + _i * 8192), 16, 0, 0); } while (0)
#define PG8_LDA(dst, b, h) do { _Pragma("unroll") for (int m = 0; m < 4; ++m) { \
        if constexpr (FP8) dst##8[m] = __builtin_shufflevector(*(const LAS v4i_t*)(lds + PG8_SA(b, h) + aoff + m * 2048), *(const LAS v4i_t*)(lds + PG8_SA(b, h) + aoff + m * 2048 + 1024), 0, 1, 2, 3, 4, 5, 6, 7); \
        else { _Pragma("unroll") for (int k = 0; k < 2; ++k) dst[m][k] = *(const LAS bf16x8*)(lds + PG8_SA(b, h) + aoff + m * 2048 + k * 1024); } } } while (0)
#define PG8_LDB(dst, b, h) do { _Pragma("unroll") for (int n = 0; n < 2; ++n) { \
        if constexpr (FP8) dst##8[n] = __builtin_shufflevector(*(const LAS v4i_t*)(lds + PG8_SB(b, h) + boff + n * 2048), *(const LAS v4i_t*)(lds + PG8_SB(b, h) + boff + n * 2048 + 1024), 0, 1, 2, 3, 4, 5, 6, 7); \
        else { _Pragma("unroll") for (int k = 0; k < 2; ++k) dst[n][k] = *(const LAS bf16x8*)(lds + PG8_SB(b, h) + boff + n * 2048 + k * 1024); } } } while (0)
#define PG8_MMA(ai, bj, At, Bt) do { __builtin_amdgcn_s_setprio(1); _Pragma("unroll") for (int m = 0; m < 4; ++m) _Pragma("unroll") for (int n = 0; n < 2; ++n) { \
        if constexpr (FP8) asm volatile("v_mfma_f32_16x16x128_f8f6f4 %0, %1, %2, %0" : "+v"(acc[ai][bj][m][n]) : "v"(Bt##8[n]), "v"(At##8[m]));   \
        else { _Pragma("unroll") for (int k = 0; k < 2; ++k) acc[ai][bj][m][n] = __builtin_amdgcn_mfma_f32_16x16x32_bf16(Bt[n][k], At[m][k], acc[ai][bj][m][n], 0, 0, 0); } } \
        __builtin_amdgcn_s_setprio(0); } while (0)
#define PG8_WAIT_V(n) asm volatile("s_waitcnt vmcnt(" #n ")" ::: "memory")
#define PG8_WAIT_L(n) asm volatile("s_waitcnt lgkmcnt(" #n ")" ::: "memory")
#define PG8_BAR __builtin_amdgcn_s_barrier()
#define PG8_SCHED __builtin_amdgcn_sched_barrier(0)
#define PG8_SETV(V, u) do { _Pragma("unroll") for (int _h = 0; _h < 2; ++_h) _Pragma("unroll") for (int _i = 0; _i < 2; ++_i) \
        V[_h][_i] = GATHER ? (unsigned)S.arow(u, _h * HALF + RA[_i]) * (unsigned)(K * 2) + (unsigned)(CA[_i] * 2) : (unsigned)(_h * (int)hstep) + (unsigned)(RA[_i] * K + CA[_i]) * 2u; } while (0)
    Unit cur, nxt; int ui = 0;
    if (!S.next(0, cur)) return;
    f32x4 acc[2][2][4][2];
#pragma unroll
    for (int a = 0; a < 2; ++a)
#pragma unroll
        for (int b = 0; b < 2; ++b)
#pragma unroll
            for (int m = 0; m < 4; ++m)
#pragma unroll
                for (int n = 0; n < 2; ++n) acc[a][b][m][n] = (f32x4){0.f, 0.f, 0.f, 0.f};
    bf16x8 At[4][2], B0[2][2], B1[2][2];
    v8i_t At8[4], B08[2], B18[2];
    unsigned vA[2][2], vN[2][2];
    PG8_SETV(vA, cur);
    if (GATHER) PG8_WAIT_V(0);
    int nt = cur.nkt;
    const char* cA = (GATHER ? (const char*)g.A : (const char*)g.A + (size_t)cur.pm * tstep) + (size_t)cur.kt0 * kstep; const char* cB = (const char*)g.Bt + (size_t)cur.pn * tstep + (size_t)cur.kt0 * kstep;
    PG8_STAGE(PG8_SB(0, 0), cB, voffB); PG8_STAGE(PG8_SB(0, 1), cB + hstep, voffB); PG8_STAGE(PG8_SA(0, 0), cA, vA[0]); PG8_STAGE(PG8_SA(0, 1), cA, vA[1]);
    if (wr == 1) PG8_BAR;
    PG8_WAIT_V(2); PG8_BAR;
    PG8_STAGE(PG8_SB(1, 0), cB + kstep, voffB); PG8_STAGE(PG8_SA(1, 0), cA + kstep, vA[0]); PG8_STAGE(PG8_SB(1, 1), cB + hstep + kstep, voffB);
    PG8_WAIT_V(6); PG8_BAR;
    for (;;) {
        const bool has_next = S.next(ui + 1, nxt);
        if constexpr (GATHER) {
            if (has_next) { PG8_SETV(vN, nxt); }
            else {
#pragma unroll
                for (int h = 0; h < 2; ++h)
#pragma unroll
                    for (int i = 0; i < 2; ++i) vN[h][i] = vA[h][i]; }
        }
        const char* nA = has_next ? (GATHER ? (const char*)g.A : (const char*)g.A + (size_t)nxt.pm * tstep) + (size_t)nxt.kt0 * kstep : cA; const char* nB = has_next ? (const char*)g.Bt + (size_t)nxt.pn * tstep + (size_t)nxt.kt0 * kstep : cB;
        for (int t = 0; t < nt; t += 2) {
            const bool last = (t == nt - 2);
            const char* a1 = cA + (size_t)(t + 1) * kstep;
            const char* a2 = last ? nA : cA + (size_t)(t + 2) * kstep; const char* b2 = last ? nB : cB + (size_t)(t + 2) * kstep;
            const char* a3 = a2 + kstep; const char* b3 = b2 + kstep;
            unsigned w0[2], w1[2];
#pragma unroll
            for (int i = 0; i < 2; ++i) { w0[i] = (GATHER && last) ? vN[0][i] : vA[0][i]; w1[i] = (GATHER && last) ? vN[1][i] : vA[1][i]; }
            PG8_LDB(B0, 0, 0); PG8_LDB(B1, 0, 1); PG8_SCHED; PG8_LDA(At, 0, 0); PG8_STAGE(PG8_SA(1, 1), a1, vA[1]);
            PG8_WAIT_V(8); PG8_WAIT_L(0); PG8_BAR; PG8_MMA(0, 0, At, B0); PG8_MMA(0, 1, At, B1); PG8_BAR; PG8_SCHED;
            PG8_LDA(At, 0, 1); PG8_STAGE(PG8_SB(0, 0), b2, voffB); PG8_STAGE(PG8_SB(0, 1), b2 + hstep, voffB); PG8_STAGE(PG8_SA(0, 0), a2, w0);
            PG8_WAIT_V(8); PG8_WAIT_L(0); PG8_BAR; PG8_MMA(1, 0, At, B0); PG8_MMA(1, 1, At, B1); PG8_BAR; PG8_SCHED;
            PG8_LDB(B0, 1, 0); PG8_LDB(B1, 1, 1); PG8_SCHED; PG8_LDA(At, 1, 0); PG8_STAGE(PG8_SA(0, 1), a2, w1);
            PG8_WAIT_V(8); PG8_WAIT_L(0); PG8_BAR; PG8_MMA(0, 0, At, B0); PG8_MMA(0, 1, At, B1); PG8_BAR; PG8_SCHED;
            PG8_LDA(At, 1, 1); PG8_STAGE(PG8_SB(1, 0), b3, voffB); PG8_STAGE(PG8_SB(1, 1), b3 + hstep, voffB); PG8_STAGE(PG8_SA(1, 0), a3, w0);
            PG8_WAIT_V(8); PG8_WAIT_L(0); PG8_BAR; PG8_MMA(1, 0, At, B0); PG8_MMA(1, 1, At, B1); PG8_BAR; PG8_SCHED;
        }
        if constexpr (ALIGN_EPI) { if (wr == 0) PG8_BAR; }
        if constexpr (FP8) asm volatile("s_nop 15\n\ts_nop 15" ::: "memory");
        E(acc, cur, wr, wc, fr, fq);
        if (!has_next) break;
#pragma unroll
        for (int a = 0; a < 2; ++a)
#pragma unroll
            for (int b = 0; b < 2; ++b)
#pragma unroll
                for (int m = 0; m < 4; ++m)
#pragma unroll
                    for (int n = 0; n < 2; ++n) acc[a][b][m][n] = (f32x4){0.f, 0.f, 0.f, 0.f};
        cur = nxt; cA = nA; cB = nB; ++ui; nt = cur.nkt;
        if constexpr (GATHER) {
#pragma unroll
            for (int h = 0; h < 2; ++h)
#pragma unroll
                for (int i = 0; i < 2; ++i) vA[h][i] = vN[h][i]; }
        if constexpr (ALIGN_EPI) { if (wr == 1) PG8_BAR; }
    }
    PG8_WAIT_V(0);
    if constexpr (!ALIGN_EPI) { if (wr == 0) PG8_BAR; }
    PG8_BAR;
#undef PG8_SA
#undef PG8_SB
#undef PG8_STAGE
#undef PG8_LDA
#undef PG8_LDB
#undef PG8_MMA
#undef PG8_WAIT_V
#undef PG8_WAIT_L
#undef PG8_BAR
#undef PG8_SCHED
#undef PG8_SETV
}
}
DI f32x4 ld_bf4(const bf16_t* p) { const u32x2 a = *(const u32x2*)p; f32x4 r; r.x = __uint_as_float(a.x << 16); r.y = __uint_as_float(a.x & 0xffff0000u); r.z = __uint_as_float(a.y << 16); r.w = __uint_as_float(a.y & 0xffff0000u); return r; }
struct Cx { LAS unsigned char* lds; int tid, lane, wave, vcu, G; };
DI Cx fresh(const Cx& c0) { Cx c; int g = c0.G, v = c0.vcu, w = c0.wave; asm volatile("" : "+s"(g), "+s"(v), "+s"(w));
    const int ln = lane_id_fresh();
    c.lds = c0.lds; c.wave = w; c.lane = ln; c.tid = w * 64 + ln; c.vcu = v; c.G = g; return c; }

template <bool WINPERM = false>
DI void tcvt_item(const float* W, int K, int N, bf16_t* WT, int rstride, int roff, LAS float* scr, int item, int lane) {
    const int nblk = N / 32, kb = item / nblk, nb = item % nblk, k0 = 64 * kb, n0 = 32 * nb;
#pragma unroll 8
    for (int i = 0; i < 32; ++i) { const int kk = 2 * i + (lane >> 5); scr[kk * 33 + (lane & 31)] = W[(size_t)(k0 + kk) * N + n0 + (lane & 31)]; }
    asm volatile("s_waitcnt lgkmcnt(0)" ::: "memory");
    const int c = lane & 7;
#pragma unroll
    for (int j = 0; j < 4; ++j) { const int n = (lane >> 3) + 8 * j; const LAS float* s = scr + (8 * c) * 33 + n;
        u32x4 o; o.x = pk2(s[0 * 33], s[1 * 33]); o.y = pk2(s[2 * 33], s[3 * 33]); o.z = pk2(s[4 * 33], s[5 * 33]); o.w = pk2(s[6 * 33], s[7 * 33]);
        const int ncol = WINPERM ? pg8::win_col_pos(n0 + n) : n0 + n, drow = (ncol >> 7) * rstride + roff + (ncol & 127);
        *(u32x4*)(WT + (size_t)drow * K + k0 + 8 * c) = o; }
    asm volatile("s_waitcnt lgkmcnt(0)" ::: "memory");
}
DI void tcvt_item8(const float* W, int K, int N, unsigned char* WT, int rstride, int roff, LAS float* scr, int item, int lane) {
    const int nblk = N / 32, kb = item / nblk, nb = item % nblk, k0 = 64 * kb, n0 = 32 * nb;
#pragma unroll 8
    for (int i = 0; i < 32; ++i) { const int kk = 2 * i + (lane >> 5); scr[kk * 33 + (lane & 31)] = W[(size_t)(k0 + kk) * N + n0 + (lane & 31)]; }
    asm volatile("s_waitcnt lgkmcnt(0)" ::: "memory");
    const int c = lane & 7;
#pragma unroll
    for (int j = 0; j < 4; ++j) { const int n = (lane >> 3) + 8 * j; const LAS float* s = scr + (8 * c) * 33 + n;
        u32x2 o; o.x = pg8::pk4_fp8(s[0 * 33] * W8_SCALE, s[1 * 33] * W8_SCALE, s[2 * 33] * W8_SCALE, s[3 * 33] * W8_SCALE); o.y = pg8::pk4_fp8(s[4 * 33] * W8_SCALE, s[5 * 33] * W8_SCALE, s[6 * 33] * W8_SCALE, s[7 * 33] * W8_SCALE);
        const int ncol = n0 + n, drow = (ncol >> 7) * rstride + roff + (ncol & 127);
        *(u32x2*)(WT + (size_t)drow * K + k0 + 8 * c) = o; }
    asm volatile("s_waitcnt lgkmcnt(0)" ::: "memory");
}
constexpr int I_IN = 16 * 96, I_OUT = 16 * 32, I_FG = 16 * 88, I_FD = 44 * 32, I_MG = 16 * 112, I_MD = 56 * 32, MOE_ITEMS = 16 * I_MG + 8 * I_MD;
constexpr int BG_N = 6;
constexpr int bg_cu0(int w) { return w == 0 ? 24 : w == 1 ? 32 : w == 2 ? 172 : w == 3 ? 24 : w == 4 ? 168 : 128; }
constexpr int bg_pw(int w) { return w == 0 ? 5 : w == 1 ? 2 : w == 2 ? 4 : w == 3 ? 5 : 2; }
constexpr int bg_count(int w) { return (256 - bg_cu0(w)) * NWAVES * bg_pw(w); }
constexpr int bg_base(int w) { return w >= BG_N ? MOE_ITEMS : bg_base(w + 1) - bg_count(w); }
DI void moe_item(const Params& p, LAS float* scr, int r, int lane) {
    unsigned char* ws = p.ws;
    if (r < 16 * I_MG) { const int q = r / I_MG, u = q >> 3, e = q & 7;
        tcvt_item8((u ? p.moe_wu : p.moe_wg) + (size_t)e * D * ED, D, ED, ws + OFF_MGU + (size_t)e * 2 * ED * D, 256, u * 128, scr, r % I_MG, lane); return; }
    r -= 16 * I_MG;
    { const int e = r / I_MD; tcvt_item8(p.moe_wd + (size_t)e * ED * D, ED, D, ws + OFF_MD + (size_t)e * D * ED, 128, 0, scr, r % I_MD, lane); }
}
template <int W>
DI void bg_convert(const Params& p, const Cx& c0) {
    constexpr int CU0 = bg_cu0(W), PW = bg_pw(W), BASE = bg_base(W);
    if (c0.G != 256) return;
    const int bid = (int)blockIdx.x;
    if (bid < CU0) return;
    const Cx c = fresh(c0);
    LAS float* scr = (LAS float*)(c.lds + c.wave * 16384);
    const int first = BASE + ((bid - CU0) * NWAVES + c.wave) * PW;
    for (int k = 0; k < PW; ++k) moe_item(p, scr, first + k, c.lane);
}
DI void phase_convert(const Params& p, const Cx& c0) {
    const Cx c = fresh(c0);
    LAS float* scr = (LAS float*)(c.lds + c.wave * 16384);
    unsigned char* ws = p.ws;
    const int gw = c.vcu * NWAVES + c.wave, NGW = c.G * NWAVES;
    constexpr int NFIX = 2 * I_IN + 2 * I_OUT + 2 * I_FG + I_FD;
    constexpr int MOE_PRO = bg_base(0);
    const int NITEMS = NFIX + (c.G == 256 ? MOE_PRO : MOE_ITEMS);
    for (int it = gw; it < NITEMS; it += NGW) {
        int r = it;
        if (r < 2 * I_IN) { const int l = r / I_IN; tcvt_item<true>(p.w_in + (size_t)l * D * INW, D, INW, (bf16_t*)(ws + OFF_WIN) + (size_t)l * INW * D, 128, 0, scr, r % I_IN, c.lane); continue; } r -= 2 * I_IN;
        if (r < 2 * I_OUT) { const int l = r / I_OUT; tcvt_item(p.w_out + (size_t)l * D * D, D, D, (bf16_t*)(ws + OFF_WOUT) + (size_t)l * D * D, 128, 0, scr, r % I_OUT, c.lane); continue; } r -= 2 * I_OUT;
        if (r < 2 * I_FG) { const int u = r / I_FG; tcvt_item8(u ? p.ffn_wu : p.ffn_wg, D, FF, ws + OFF_WGU, 256, u * 128, scr, r % I_FG, c.lane); continue; } r -= 2 * I_FG;
        if (r < I_FD) { tcvt_item8(p.ffn_wd, FF, D, ws + OFF_WD, 128, 0, scr, r, c.lane); continue; } r -= I_FD;
        moe_item(p, scr, r, c.lane);
    }
}
DI void phase_mod(const Params& p, const Cx& c0) {
    const Cx c = fresh(c0);
    for (int i = c.vcu * NTHREADS + c.tid; i < 128 * 24; i += c.G * NTHREADS) {
        const int pos = i / 24, e = i % 24;
        const float inv = e < 8 ? powf(10000.f, -(float)e * 2.0f / 16.0f) : powf(10000.f, -(float)(e - 8) * 2.0f / 32.0f);
        float sn, cs; sincosf((float)pos * inv, &sn, &cs);
        ((float2*)(p.ws + OFF_ROPE))[i] = make_float2(cs, sn);
    }
    LAS float* red = (LAS float*)(c.lds);
    LAS float* sl = red + 8 * 48 * 3;
    __syncthreads();
    for (int i = c.tid; i < 3 * 1024; i += NTHREADS) sl[i] = silu_f(i < 1024 ? p.c[i] : i < 2048 ? p.c[i] : p.c_ctx[i - 2048]);
    for (int cb = c.vcu; cb < 256; cb += c.G) {
        __syncthreads();
        if (c.tid < 384) {
            const int cl = c.tid % 48, kg = c.tid / 48, gc = cb * 48 + cl, layer = gc / 6144, col = gc % 6144;
            const float* w = p.w_mod + (size_t)layer * D * 6144 + col;
            float a0 = 0.f, a1 = 0.f, a2 = 0.f;
#pragma unroll 16
            for (int k = kg * 128; k < kg * 128 + 128; ++k) { const float wv = w[(size_t)k * 6144]; a0 += sl[k] * wv; a1 += sl[1024 + k] * wv; a2 += sl[2048 + k] * wv; }
            red[(kg * 48 + cl) * 3 + 0] = a0; red[(kg * 48 + cl) * 3 + 1] = a1; red[(kg * 48 + cl) * 3 + 2] = a2;
        }
        __syncthreads();
        if (c.tid < 144) {
            const int cl = c.tid % 48, v = c.tid / 48, gc = cb * 48 + cl, layer = gc / 6144, col = gc % 6144;
            float s = p.b_mod[layer * 6144 + col];
#pragma unroll
            for (int kg = 0; kg < 8; ++kg) s += red[(kg * 48 + cl) * 3 + v];
            ((float*)(p.ws + OFF_MOD))[(size_t)(layer * 3 + v) * 6144 + col] = s;
        }
    }
    __syncthreads();
}
DI void phase_norm1(const Params& p, const Cx& c0, int layer) {
    const Cx c = fresh(c0);
    const int gw = c.vcu * NWAVES + c.wave, NGW = c.G * NWAVES;
    f32x4 v[4], vn[4];
    if (gw < T) { const f32x4* xr = (const f32x4*)xin0_row(p, gw) + c.lane;
#pragma unroll
        for (int j = 0; j < 4; ++j) v[j] = xr[64 * j]; }
    for (int row = gw; row < T; row += NGW) {
        if (row + NGW < T) { const f32x4* xn = (const f32x4*)xin0_row(p, row + NGW) + c.lane;
#pragma unroll
            for (int j = 0; j < 4; ++j) vn[j] = xn[64 * j]; }
        float s = 0.f;
#pragma unroll
        for (int j = 0; j < 4; ++j) s += (v[j].x * v[j].x + v[j].y * v[j].y) + (v[j].z * v[j].z + v[j].w * v[j].w);
        const float r = rsqrtf(wave_sum(s, c.lane) * (1.f / D) + EPS);
        const float* mod = mod_row(p, layer, row);
        const float* g = p.g_attn_pre + layer * D;
        bf16_t* h = (bf16_t*)(p.ws + OFF_H) + (size_t)row * D;
#pragma unroll
        for (int j = 0; j < 4; ++j) { const int idx = (c.lane + 64 * j) * 4;
            const f32x4 gg = *(const f32x4*)(g + idx), sh = *(const f32x4*)(mod + idx), sc = *(const f32x4*)(mod + 1024 + idx);
            const f32x4 o = v[j] * r * gg * (sc + 1.f) + sh;
            uint2 w; w.x = pk2(o.x, o.y); w.y = pk2(o.z, o.w); *(uint2*)(h + idx) = w; }
#pragma unroll
        for (int j = 0; j < 4; ++j) v[j] = vn[j];
    }
}
DI int ret_row(int b, int n) { return n < 2 ? TX + b * CTXL + n * 128 : b * SEQ + (n - 2) * 128; }
DI float logsig(float g) { return -log1pf(expf(-g)); }

DI void phase_post_attn(const Params& p, const Cx& c0, int layer) {
    const Cx c = fresh(c0);
    const int gw = c.vcu * NWAVES + c.wave, NGW = c.G * NWAVES, rows = layer == 0 ? T : TX;
    constexpr int RT_MAXSEL = 512;
    LAS int* rsel = (LAS int*)(c.lds + c.wave * (RT_MAXSEL * 16 + 64));
    int nsel = 0;
    f32x4 y[4], x1[4], yn[4], xn[4];
    auto load_row = [&](int row, f32x4 (&yy)[4], f32x4 (&xx)[4]) {
        const bf16_t* yr = (const bf16_t*)(p.ws + OFF_B) + (size_t)row * D + c.lane * 4;
        const f32x4* xr = (const f32x4*)xin0_row(p, row) + c.lane;
        const bf16_t* xsr = (const bf16_t*)(p.ws + OFF_XS) + (size_t)row * D;
#pragma unroll
        for (int j = 0; j < 4; ++j) {
            if (layer == 0 && row >= TX) { const float* sl = (const float*)(p.ws + OFF_B + B_SLAB_Y) + (size_t)(row - TX) * D + (c.lane + 64 * j) * 4;
                yy[j] = *(const f32x4*)sl;
#pragma unroll
                for (int k = 1; k < WOUT_SPLIT; ++k) yy[j] = yy[j] + *(const f32x4*)(sl + (size_t)k * TC * D); }
            else yy[j] = ld_bf4(yr + 256 * j);
            xx[j] = layer == 0 ? xr[64 * j] : ld_bf4(xsr + (c.lane + 64 * j) * 4); }
    };
    if (gw < rows) load_row(gw, y, x1);
    for (int row = gw; row < rows; row += NGW) {
        if (row + NGW < rows) load_row(row + NGW, yn, xn);
        bf16_t* xs = (bf16_t*)(p.ws + OFF_XS) + (size_t)row * D;
        float s = 0.f;
#pragma unroll
        for (int j = 0; j < 4; ++j) s += (y[j].x * y[j].x + y[j].y * y[j].y) + (y[j].z * y[j].z + y[j].w * y[j].w);
        const float r = rsqrtf(wave_sum(s, c.lane) * (1.f / D) + EPS);
        const float* mod = mod_row(p, layer, row);
        float s2 = 0.f;
#pragma unroll
        for (int j = 0; j < 4; ++j) { const int idx = (c.lane + 64 * j) * 4;
            const f32x4 gp = *(const f32x4*)(p.g_attn_post + layer * D + idx), gt = *(const f32x4*)(mod + 2048 + idx);
            x1[j] = x1[j] + gt * (y[j] * r * gp);
            { u32x2 w; w.x = pk2(x1[j].x, x1[j].y); w.y = pk2(x1[j].z, x1[j].w); *(u32x2*)(xs + idx) = w; }
            s2 += (x1[j].x * x1[j].x + x1[j].y * x1[j].y) + (x1[j].z * x1[j].z + x1[j].w * x1[j].w); }
        const float r2 = rsqrtf(wave_sum(s2, c.lane) * (1.f / D) + EPS);
        bf16_t* h = (bf16_t*)(p.ws + OFF_H) + (size_t)row * D;
        float l8[8];
#pragma unroll
        for (int e = 0; e < 8; ++e) l8[e] = 0.f;
#pragma unroll
        for (int j = 0; j < 4; ++j) { const int idx = (c.lane + 64 * j) * 4;
            const f32x4 g2 = *(const f32x4*)(p.g_ffn_pre + layer * D + idx), sh = *(const f32x4*)(mod + 3072 + idx), sc = *(const f32x4*)(mod + 4096 + idx);
            const f32x4 hv = x1[j] * r2 * g2 * (sc + 1.f) + sh;
            *(unsigned*)(p.ws + OFF_H8 + (size_t)row * D + idx) = pg8::pk4_fp8(pg8::clamp8(hv.x), pg8::clamp8(hv.y), pg8::clamp8(hv.z), pg8::clamp8(hv.w));
            if (layer == 1) {
#pragma unroll
                for (int i = 0; i < 4; ++i) { const f32x4 ra = *(const f32x4*)(p.router + (size_t)(idx + i) * 8), rb = *(const f32x4*)(p.router + (size_t)(idx + i) * 8 + 4);
                    const float hh = hv[i];
                    l8[0] += hh * ra.x; l8[1] += hh * ra.y; l8[2] += hh * ra.z; l8[3] += hh * ra.w; l8[4] += hh * rb.x; l8[5] += hh * rb.y; l8[6] += hh * rb.z; l8[7] += hh * rb.w; }
            } }
        if (layer == 1) {
#pragma unroll
            for (int e = 0; e < 8; ++e) l8[e] = wave_sum(l8[e], c.lane);
            if (c.lane == 0) {
                int i0 = 0; float v0 = l8[0];
#pragma unroll
                for (int e = 1; e < 8; ++e) if (l8[e] > v0) { v0 = l8[e]; i0 = e; }
                int i1 = -1; float v1 = -3.0e38f;
#pragma unroll
                for (int e = 0; e < 8; ++e) if (e != i0 && l8[e] > v1) { v1 = l8[e]; i1 = e; }
                const float e1 = expf(v1 - v0); const float w0 = 1.f / (1.f + e1), w1 = e1 / (1.f + e1);
                if (nsel < RT_MAXSEL) { rsel[nsel * 4] = row; rsel[nsel * 4 + 1] = i0 | (i1 << 8); rsel[nsel * 4 + 2] = __float_as_int(w0); rsel[nsel * 4 + 3] = __float_as_int(w1); }
            }
            ++nsel;
        }
#pragma unroll
        for (int j = 0; j < 4; ++j) { y[j] = yn[j]; x1[j] = xn[j]; }
    }
    if (layer == 1) {
        asm volatile("s_waitcnt lgkmcnt(0)" ::: "memory");
        unsigned* cnt = (unsigned*)(p.ws + OFF_CNT);
        int* tl = (int*)(p.ws + OFF_TLIST); int* te = (int*)(p.ws + OFF_TOKE); int* tj = (int*)(p.ws + OFF_TOKJ); float* tw = (float*)(p.ws + OFF_TOKW);
        LAS int* rbase = rsel + RT_MAXSEL * 4;
        if (c.lane < 8) { int n = 0;
            for (int k = 0; k < nsel; ++k) { const int ee = rsel[k * 4 + 1]; n += ((ee & 255) == c.lane) + ((ee >> 8) == c.lane); }
            rbase[c.lane] = n; }
        __syncthreads();
        if (c.wave == 0 && c.lane < 8) {
            int tot = 0;
            for (int w = 0; w < NWAVES; ++w) tot += ((LAS int*)(c.lds + w * (RT_MAXSEL * 16 + 64)) + RT_MAXSEL * 4)[c.lane];
            int base = tot > 0 ? (int)atomicAdd(&cnt[c.lane], (unsigned)tot) : 0;
            for (int w = 0; w < NWAVES; ++w) { LAS int* wb = (LAS int*)(c.lds + w * (RT_MAXSEL * 16 + 64)) + RT_MAXSEL * 4; const int n = wb[c.lane]; wb[c.lane] = base; base += n; }
        }
        __syncthreads();
        if (c.lane == 0) {
            for (int k = 0; k < nsel; ++k) { const int row = rsel[k * 4], ee = rsel[k * 4 + 1], i0 = ee & 255, i1 = ee >> 8;
                const int j0 = rbase[i0]; rbase[i0] = j0 + 1; const int j1 = rbase[i1]; rbase[i1] = j1 + 1;
                tl[i0 * 16384 + j0] = row; tl[i1 * 16384 + j1] = row;
                te[row * 2] = i0; te[row * 2 + 1] = i1; tj[row * 2] = j0; tj[row * 2 + 1] = j1; tw[row * 2] = __int_as_float(rsel[k * 4 + 2]); tw[row * 2 + 1] = __int_as_float(rsel[k * 4 + 3]); }
        }
    }
}
DI void phase_post_ffn(const Params& p, const Cx& c0, int layer) {
    const Cx c = fresh(c0);
    const int gw = c.vcu * NWAVES + c.wave, NGW = c.G * NWAVES, rows = layer == 0 ? T : TX;
    int off[8];
    if (layer == 1) { const unsigned* cnt = (const unsigned*)(p.ws + OFF_CNT); int a = 0;
#pragma unroll
        for (int e = 0; e < 8; ++e) { off[e] = a; a += ((int)cnt[e] + 255) & ~255; } }
    f32x4 f[4], xr1[4], fn[4], xn[4];
    u32x2 ea[4], eb_[4], ean[4], ebn[4]; float mw0 = 0.f, mw1 = 0.f, mw0n = 0.f, mw1n = 0.f; int ms0 = 0, ms1 = 0; float mq0 = 0.f, mq1 = 0.f;
    auto load_meta = [&](int row) {
        const int* te = (const int*)(p.ws + OFF_TOKE); const int* tj = (const int*)(p.ws + OFF_TOKJ); const float* tw = (const float*)(p.ws + OFF_TOKW);
        const int e0 = te[row * 2], e1 = te[row * 2 + 1];
        int s0 = 0, s1 = 0;
#pragma unroll
        for (int e = 0; e < 8; ++e) { if (e0 == e) s0 = off[e]; if (e1 == e) s1 = off[e]; }
        ms0 = s0 + tj[row * 2]; ms1 = s1 + tj[row * 2 + 1]; mq0 = tw[row * 2]; mq1 = tw[row * 2 + 1];
    };
    auto load_row1 = [&](int row, u32x2 (&a)[4], u32x2 (&b)[4], float& w0, float& w1, f32x4 (&xx)[4]) {
        const bf16_t* xsr = (const bf16_t*)(p.ws + OFF_XS) + (size_t)row * D;
        const bf16_t* O = (const bf16_t*)(p.ws + OFF_B);
#pragma unroll
        for (int j = 0; j < 4; ++j) { const int idx = (c.lane + 64 * j) * 4; xx[j] = ld_bf4(xsr + idx); a[j] = *(const u32x2*)(O + (size_t)ms0 * D + idx); b[j] = *(const u32x2*)(O + (size_t)ms1 * D + idx); }
        w0 = mq0; w1 = mq1;
    };
    auto load_row = [&](int row, f32x4 (&f)[4], f32x4 (&xx)[4]) {
        const bf16_t* xsr = (const bf16_t*)(p.ws + OFF_XS) + (size_t)row * D;
#pragma unroll
        for (int j = 0; j < 4; ++j) xx[j] = ld_bf4(xsr + (c.lane + 64 * j) * 4);
        if (layer == 0) {
            const bf16_t* fr = (const bf16_t*)(p.ws + OFF_B) + (size_t)row * D + c.lane * 4;
#pragma unroll
            for (int j = 0; j < 4; ++j) {
                if (row >= TX) { const float* sl = (const float*)(p.ws + OFF_B + B_SLAB_F) + (size_t)(row - TX) * D + (c.lane + 64 * j) * 4;
                    f[j] = *(const f32x4*)sl;
#pragma unroll
                    for (int k = 1; k < FFD_SPLIT; ++k) f[j] = f[j] + *(const f32x4*)(sl + (size_t)k * TC * D); }
                else f[j] = ld_bf4(fr + 256 * j); }
        } else {
            const int* te = (const int*)(p.ws + OFF_TOKE); const int* tj = (const int*)(p.ws + OFF_TOKJ); const float* tw = (const float*)(p.ws + OFF_TOKW);
            const int e0 = te[row * 2], e1 = te[row * 2 + 1];
            int s0 = 0, s1 = 0;
#pragma unroll
            for (int e = 0; e < 8; ++e) { if (e0 == e) s0 = off[e]; if (e1 == e) s1 = off[e]; }
            s0 += tj[row * 2]; s1 += tj[row * 2 + 1];
            const float w0 = tw[row * 2], w1 = tw[row * 2 + 1];
            const bf16_t* O = (const bf16_t*)(p.ws + OFF_B);
#pragma unroll
            for (int j = 0; j < 4; ++j) { const int idx = (c.lane + 64 * j) * 4;
                const f32x4 a = ld_bf4(O + (size_t)s0 * D + idx), bq = ld_bf4(O + (size_t)s1 * D + idx);
                f[j] = a * w0 + bq * w1; }
        }
    };
    if (layer == 0) { if (gw < rows) load_row(gw, f, xr1); }
    else if (gw < rows) { load_meta(gw); load_row1(gw, ea, eb_, mw0, mw1, xr1); if (gw + NGW < rows) load_meta(gw + NGW); }
    for (int row = gw; row < rows; row += NGW) {
        if (layer == 0) { if (row + NGW < rows) load_row(row + NGW, fn, xn); }
        else {
            if (row + NGW < rows) load_row1(row + NGW, ean, ebn, mw0n, mw1n, xn);
            if (row + 2 * NGW < rows) load_meta(row + 2 * NGW);
#pragma unroll
            for (int j = 0; j < 4; ++j) { const u32x2 a = ea[j], b = eb_[j];
                f[j] = (f32x4){__uint_as_float(a.x << 16), __uint_as_float(a.x & 0xffff0000u), __uint_as_float(a.y << 16), __uint_as_float(a.y & 0xffff0000u)} * mw0
                     + (f32x4){__uint_as_float(b.x << 16), __uint_as_float(b.x & 0xffff0000u), __uint_as_float(b.y << 16), __uint_as_float(b.y & 0xffff0000u)} * mw1; }
        }
        float s = 0.f;
#pragma unroll
        for (int j = 0; j < 4; ++j) s += (f[j].x * f[j].x + f[j].y * f[j].y) + (f[j].z * f[j].z + f[j].w * f[j].w);
        const float r = rsqrtf(wave_sum(s, c.lane) * (1.f / D) + EPS);
        const float* mod = mod_row(p, layer, row);
        bf16_t* xs = (bf16_t*)(p.ws + OFF_XS) + (size_t)row * D;
        float s3 = 0.f;
#pragma unroll
        for (int j = 0; j < 4; ++j) { const int idx = (c.lane + 64 * j) * 4;
            const f32x4 g = *(const f32x4*)(p.g_ffn_post + layer * D + idx), gt = *(const f32x4*)(mod + 5120 + idx), x1 = xr1[j];
            f[j] = x1 + gt * (f[j] * r * g);
            if (layer == 0) { u32x2 w; w.x = pk2(f[j].x, f[j].y); w.y = pk2(f[j].z, f[j].w); *(u32x2*)(xs + idx) = w; } else *(f32x4*)(p.out + (size_t)row * D + idx) = f[j];
            s3 += (f[j].x * f[j].x + f[j].y * f[j].y) + (f[j].z * f[j].z + f[j].w * f[j].w); }
        if (layer == 0) {
            const float r3 = rsqrtf(wave_sum(s3, c.lane) * (1.f / D) + EPS);
            const float* mod1 = mod_row(p, 1, row);
            bf16_t* h = (bf16_t*)(p.ws + OFF_H) + (size_t)row * D;
#pragma unroll
            for (int j = 0; j < 4; ++j) { const int idx = (c.lane + 64 * j) * 4;
                const f32x4 gg = *(const f32x4*)(p.g_attn_pre + D + idx), sh = *(const f32x4*)(mod1 + idx), sc = *(const f32x4*)(mod1 + 1024 + idx);
                const f32x4 o = f[j] * r3 * gg * (sc + 1.f) + sh;
                u32x2 w; w.x = pk2(o.x, o.y); w.y = pk2(o.z, o.w); *(u32x2*)(h + idx) = w; }
        }
#pragma unroll
        for (int j = 0; j < 4; ++j) { xr1[j] = xn[j]; if (layer == 0) f[j] = fn[j]; else { ea[j] = ean[j]; eb_[j] = ebn[j]; } }
        mw0 = mw0n; mw1 = mw1n;
    }
}
DI int key_row(int b, int u) { return u < CTXL ? TX + b * CTXL + u : b * SEQ + u - CTXL; }
DI void phase_ret_u_mfma(const Params& p, const Cx& c0, int layer) {
    const Cx c = fresh(c0);
    const int lane = c.lane, wave = c.wave, l31 = lane & 31, hi = lane >> 5;
    const bf16_t* P = (const bf16_t*)(p.ws + OFF_A + A_P);
    float* U = (float*)(p.ws + OFF_A + A_U);
    LAS bf16_t* VL = (LAS bf16_t*)c.lds + 3 * 64 * 136;
    LAS bf16_t* KT = (LAS bf16_t*)c.lds;
    const int nunits = NB * 4 * (NCH / 3);
    const float LOG2E = 1.4426950408889634f;
    for (int unit = c.vcu; unit < nunits; unit += c.G) {
        const int n3 = unit % (NCH / 3), h = (unit / (NCH / 3)) & 3, b = unit / ((NCH / 3) * 4);
        __syncthreads();
#pragma unroll
        for (int cc = 0; cc < 3; ++cc) { const int row0 = ret_row(b, 3 * n3 + cc);
#pragma unroll
            for (int ps = 0; ps < 2; ++ps) { const int j = ps * 64 + (c.tid >> 3), ch = c.tid & 7;
                const u32x4 v = *(const u32x4*)(P + (size_t)(row0 + j) * INW + RT_K + h * 64 + ch * 8);
#pragma unroll
                for (int e = 0; e < 4; ++e) { KT[cc * 64 * 136 + (ch * 8 + 2 * e) * 136 + j] = (bf16_t)(v[e] & 0xffffu); KT[cc * 64 * 136 + (ch * 8 + 2 * e + 1) * 136 + j] = (bf16_t)(v[e] >> 16); }
                const u32x4 vv = *(const u32x4*)(P + (size_t)(row0 + j) * INW + RT_V + h * 64 + ch * 8);
#pragma unroll
                for (int e = 0; e < 4; ++e) { VL[cc * 64 * 136 + (ch * 8 + 2 * e) * 136 + j] = (bf16_t)(vv[e] & 0xffffu); VL[cc * 64 * 136 + (ch * 8 + 2 * e + 1) * 136 + j] = (bf16_t)(vv[e] >> 16); } } }
        __syncthreads();
        const int eb = wave & 1, db = (wave >> 1) & 1, dir = wave >> 2;
        const float lg2 = logsig(dir ? p.gam_b[layer * 4 + h] : p.gam_f[layer * 4 + h]) * LOG2E;
#pragma unroll
        for (int cc = 0; cc < 3; ++cc) { const int n = 3 * n3 + cc;
            const LAS bf16_t* vrow = VL + cc * 64 * 136 + (eb * 32 + l31) * 136 + hi * 8;
            f32x16 acc;
#pragma unroll
            for (int r = 0; r < 16; ++r) acc[r] = 0.f;
#pragma unroll
            for (int s = 0; s < 8; ++s) {
                const bf16x8 af = *(const LAS bf16x8*)(vrow + s * 16);
                const u32x4 kv = *(const LAS u32x4*)(KT + cc * 64 * 136 + (db * 32 + l31) * 136 + s * 16 + hi * 8);
                u32x4 kw;
#pragma unroll
                for (int e = 0; e < 4; ++e) { const int j = s * 16 + hi * 8 + 2 * e;
                    const float w0 = __builtin_amdgcn_exp2f((float)(dir ? j : 127 - j) * lg2), w1 = __builtin_amdgcn_exp2f((float)(dir ? j + 1 : 126 - j) * lg2);
                    kw[e] = pk2(__uint_as_float(kv[e] << 16) * w0, __uint_as_float(kv[e] & 0xffff0000u) * w1); }
                acc = MFMA32(af, __builtin_bit_cast(bf16x8, kw), acc);
            }
            float* Uo = U + ((size_t)((b * 4 + h) * 2 + dir) * NCH + n) * 4096 + db * 32 + l31;
#pragma unroll
            for (int r = 0; r < 16; ++r) Uo[(eb * 32 + (r & 3) + 8 * (r >> 2) + 4 * hi) * 64] = acc[r] * 0.125f;
        }
    }
    __syncthreads();
}
DI void phase_ret_scan2(const Params& p, const Cx& c0, int layer) {
    const Cx c = fresh(c0);
    const float* U = (const float*)(p.ws + OFF_A + A_U);
    bf16_t* S = (bf16_t*)(p.ws + OFF_A + A_S);
    for (int gid = c.vcu * NTHREADS + c.tid; gid < NB * 4 * 2 * 4096; gid += c.G * NTHREADS) {
        const int de = gid & 4095, dir = (gid >> 12) & 1, h = (gid >> 13) & 3;
        const size_t base = (size_t)(gid >> 12) * NCH * 4096 + de;
        const float lg = logsig(dir ? p.gam_b[layer * 4 + h] : p.gam_f[layer * 4 + h]);
        const float gch = expf(128.f * lg);
        float s = 0.f;
#pragma unroll
        for (int i0 = 0; i0 < NCH; i0 += 33) {
            float u[33];
#pragma unroll
            for (int k = 0; k < 33; ++k) { const int i = i0 + k, n = dir == 0 ? i : (i < 2 ? 1 - i : 67 - i); u[k] = U[base + (size_t)n * 4096]; }
#pragma unroll
            for (int k = 0; k < 33; ++k) { const int i = i0 + k, n = dir == 0 ? i : (i < 2 ? 1 - i : 67 - i); S[base + (size_t)n * 4096] = f2bf(s); s = gch * s + u[k]; }
        }
    }
}
constexpr int RO_KP = 144, RO_VP = 272, RO_K = 0, RO_V = 128 * RO_KP, RO_S = RO_V + 64 * RO_VP, RO_HALF = RO_S + 128 * RO_KP;
template <bool CTXU>
DI void phase_ret_out_mfma(const Params& p, const Cx& c0, int layer, int n0, int first_blk = 0) {
    const Cx c = fresh(c0);
    const int lane = c.lane, l31 = lane & 31, hi = lane >> 5, half = c.wave >> 2, ht = (c.wave & 3) * 64 + lane;
    const bf16_t* P = (const bf16_t*)(p.ws + OFF_A + A_P);
    const bf16_t* ST = (const bf16_t*)(p.ws + OFF_A + A_S);
    bf16_t* YC = (bf16_t*)(p.ws + OFF_H);
    const float* U = (const float*)(p.ws + OFF_A + A_U);
    const int nn = CTXU ? 2 : NCH - n0, nunits = NB * 4 * nn * 4, NGW = c.G * NWAVES;
    const int gw = (c.vcu >= first_blk ? c.vcu - first_blk : c.vcu - first_blk + c.G) * NWAVES + c.wave;
    const float LOG2E = 1.4426950408889634f;
    LAS unsigned char* img = c.lds + half * RO_HALF;
    __syncthreads();
    for (int unit = gw; unit < nunits; unit += NGW) {
        const int ib = unit & 3, n = n0 + (unit >> 2) % nn, h = ((unit >> 2) / nn) & 3, b = (unit >> 2) / (nn * 4);
        const int row0 = ret_row(b, n), u0 = n < 2 ? n * 128 : CTXL + (n - 2) * 128;
        const int iq = ib * 32 + l31, qrow = row0 + iq;
        const float lf2 = logsig(p.gam_f[layer * 4 + h]) * LOG2E, lb2 = logsig(p.gam_b[layer * 4 + h]) * LOG2E;
        u32x4 kr[4], vr[4], sr[4];
#pragma unroll
        for (int i = 0; i < 4; ++i) { const int pc = ht + 256 * i;
            kr[i] = *(const u32x4*)(P + (size_t)(row0 + (pc >> 3)) * INW + RT_K + h * 64 + (pc & 7) * 8);
            vr[i] = *(const u32x4*)(P + (size_t)(row0 + (pc >> 3)) * INW + RT_V + h * 64 + (pc & 7) * 8);
            const int dir = pc >> 9, e = (pc >> 3) & 63, ch = pc & 7;
            if (CTXU) {
                if (dir == 0 ? n == 1 : n == 0) { const float* ur = U + ((size_t)((b * 4 + h) * 2 + dir) * NCH + (1 - n)) * 4096 + e * 64 + ch * 8; const f32x4 ua = *(const f32x4*)ur, ub = *(const f32x4*)(ur + 4);
                    sr[i].x = (unsigned)f2bf(ua[0]) | ((unsigned)f2bf(ua[1]) << 16); sr[i].y = (unsigned)f2bf(ua[2]) | ((unsigned)f2bf(ua[3]) << 16);
                    sr[i].z = (unsigned)f2bf(ub[0]) | ((unsigned)f2bf(ub[1]) << 16); sr[i].w = (unsigned)f2bf(ub[2]) | ((unsigned)f2bf(ub[3]) << 16); }
                else sr[i] = (u32x4){0u, 0u, 0u, 0u};
            } else sr[i] = *(const u32x4*)(ST + ((size_t)((b * 4 + h) * 2 + dir) * NCH + n) * 4096 + e * 64 + ch * 8);
        }
        bf16x8 qf[4];
#pragma unroll
        for (int ks = 0; ks < 4; ++ks) qf[ks] = *(const bf16x8*)(P + (size_t)qrow * INW + RT_Q + h * 64 + ks * 16 + hi * 8);
#pragma unroll
        for (int i = 0; i < 4; ++i) { const int pc = ht + 256 * i;
            *(LAS u32x4*)(img + RO_K + (pc >> 3) * RO_KP + (pc & 7) * 16) = kr[i];
            { LAS bf16_t* vd = (LAS bf16_t*)(img + RO_V) + ((pc & 7) * 8) * (RO_VP / 2) + (pc >> 3);
#pragma unroll
              for (int e = 0; e < 4; ++e) { vd[(2 * e) * (RO_VP / 2)] = (bf16_t)(vr[i][e] & 0xffffu); vd[(2 * e + 1) * (RO_VP / 2)] = (bf16_t)(vr[i][e] >> 16); } }
            *(LAS u32x4*)(img + RO_S + (pc >> 3) * RO_KP + (pc & 7) * 16) = sr[i]; }
        __syncthreads();
        bf16x8 pf[8];
#pragma unroll
        for (int jb = 0; jb < 4; ++jb) {
            f32x16 S;
#pragma unroll
            for (int r = 0; r < 16; ++r) S[r] = 0.f;
#pragma unroll
            for (int ks = 0; ks < 4; ++ks) { const bf16x8 kf = *(const LAS bf16x8*)(img + RO_K + (jb * 32 + l31) * RO_KP + ks * 32 + hi * 16); S = MFMA32(kf, qf[ks], S); }
#pragma unroll
            for (int r = 0; r < 16; ++r) { const int j = jb * 32 + (r & 3) + 8 * (r >> 2) + 4 * hi, dd = iq - j;
                S[r] *= 0.125f * __builtin_amdgcn_exp2f(dd >= 0 ? (float)dd * lf2 : (float)(-dd) * lb2); }
#pragma unroll
            for (int s = 0; s < 2; ++s) { u32x4 w; w.x = pk2(S[8 * s], S[8 * s + 1]); w.y = pk2(S[8 * s + 2], S[8 * s + 3]); w.z = pk2(S[8 * s + 4], S[8 * s + 5]); w.w = pk2(S[8 * s + 6], S[8 * s + 7]);
                pf[jb * 2 + s] = __builtin_bit_cast(bf16x8, w); }
        }
        const float xif = __builtin_amdgcn_exp2f((float)(iq + 1) * lf2), xib = __builtin_amdgcn_exp2f((float)(128 - iq) * lb2);
        f32x16 O[2];
#pragma unroll
        for (int eb = 0; eb < 2; ++eb) {
#pragma unroll
            for (int r = 0; r < 16; ++r) O[eb][r] = 0.f;
#pragma unroll
            for (int k8 = 0; k8 < 8; ++k8) { const LAS unsigned char* vp = img + RO_V + (eb * 32 + l31) * RO_VP + k8 * 32 + hi * 8;
                const u32x2 x0 = *(const LAS u32x2*)vp, x1 = *(const LAS u32x2*)(vp + 16);
                u32x4 wv; wv.x = x0.x; wv.y = x0.y; wv.z = x1.x; wv.w = x1.y;
                O[eb] = MFMA32(__builtin_bit_cast(bf16x8, wv), pf[k8], O[eb]); }
#pragma unroll
            for (int dir = 0; dir < 2; ++dir) {
                f32x16 C;
#pragma unroll
                for (int r = 0; r < 16; ++r) C[r] = 0.f;
#pragma unroll
                for (int ks = 0; ks < 4; ++ks) C = MFMA32(*(const LAS bf16x8*)(img + RO_S + (dir * 64 + eb * 32 + l31) * RO_KP + ks * 32 + hi * 16), qf[ks], C);
                const float xi = dir ? xib : xif;
#pragma unroll
                for (int r = 0; r < 16; ++r) O[eb][r] += xi * C[r];
            }
        }
        float ss = 0.f;
#pragma unroll
        for (int eb = 0; eb < 2; ++eb)
#pragma unroll
            for (int r = 0; r < 16; ++r) ss += O[eb][r] * O[eb][r];
        ss += shx(ss, 32, lane);
        const float rr = rsqrtf(ss * (1.f / 64.f) + EPS);
#pragma unroll
        for (int eb = 0; eb < 2; ++eb)
#pragma unroll
            for (int g = 0; g < 4; ++g) { const int e0 = eb * 32 + 8 * g + 4 * hi;
                const u32x2 gt = *(const u32x2*)(P + (size_t)qrow * INW + RT_G + h * 64 + e0);
                const float g0 = __uint_as_float(gt.x << 16), g1 = __uint_as_float(gt.x & 0xffff0000u), g2 = __uint_as_float(gt.y << 16), g3 = __uint_as_float(gt.y & 0xffff0000u);
                u32x2 w; w.x = pk2(O[eb][4 * g] * rr * silu_f(g0), O[eb][4 * g + 1] * rr * silu_f(g1)); w.y = pk2(O[eb][4 * g + 2] * rr * silu_f(g2), O[eb][4 * g + 3] * rr * silu_f(g3));
                *(u32x2*)(YC + (size_t)qrow * D + 768 + h * 64 + e0) = w; }
        __syncthreads();
    }
}
namespace da2 {
typedef short s16x4 __attribute__((ext_vector_type(4)));
typedef LAS const char* lcp;
constexpr int NSLOT = 3, SLOTB = 8192;
constexpr int L_K = 0, L_V = NSLOT * SLOTB, L_WS = 2 * NSLOT * SLOTB, L_ST = L_WS + 8 * 64 * 4;
constexpr int ST_P = 65, ST_W = 32 * ST_P;
DI int crow(int r, int hi) { return (r & 3) + 8 * (r >> 2) + 4 * hi; }
DI void glds16(const void* gsrc, unsigned lds_dst) { unsigned keep;
    asm volatile("s_mov_b32 %0, m0\n\ts_mov_b32 m0, %2\n\ts_nop 0\n\tglobal_load_lds_dwordx4 %1, off\n\ts_mov_b32 m0, %0" : "=&s"(keep) : "v"(gsrc), "s"(lds_dst) : "memory"); }
DI float max3f(float a, float b, float c) { float r; asm("v_max3_f32 %0, %1, %2, %3" : "=v"(r) : "v"(a), "v"(b), "v"(c)); return r; }
DI float max2f(float a, float b) { float r; asm("v_max_f32_e32 %0, %1, %2" : "=v"(r) : "v"(a), "v"(b)); return r; }
DI float fadd_s(float a, float b) { float r; asm("v_add_f32_e32 %0, %1, %2" : "=v"(r) : "v"(a), "v"(b)); return r; }
DI float fsub_s(float a, float b) { float r; asm("v_sub_f32_e32 %0, %1, %2" : "=v"(r) : "v"(a), "v"(b)); return r; }
#define SBAR() __builtin_amdgcn_sched_barrier(0)
#define WAIT_BAR(N) asm volatile("s_waitcnt vmcnt(" #N ") lgkmcnt(0)\n\ts_barrier" ::: "memory")
DI s16x4 vtr(lcp p) { return __builtin_bit_cast(s16x4, __builtin_amdgcn_ds_read_tr16_b64_v4i16((LAS s16x4*)p)); }
DI float rowmax(const f32x16& p0, const f32x16& p1) {
    float a = max3f(p0[0], p0[1], p1[0]), b = max3f(p0[2], p0[3], p1[1]); a = max3f(a, p1[2], p1[3]);
#pragma unroll
    for (int r = 4; r < 16; r += 4) { a = max3f(a, p0[r], p0[r + 1]); b = max3f(b, p0[r + 2], p0[r + 3]); a = max3f(a, p1[r], p1[r + 1]); b = max3f(b, p1[r + 2], p1[r + 3]); }
    const float m = max2f(a, b);
    auto rr = __builtin_amdgcn_permlane32_swap(__float_as_uint(m), __float_as_uint(m), false, false);
    return max2f(__uint_as_float(rr[0]), __uint_as_float(rr[1]));
}
DI void pv(f32x16* o, int vb, bf16x8 pa0, bf16x8 pa1, bf16x8 pa2, bf16x8 pa3) {
#pragma unroll
    for (int d0 = 0; d0 < 2; ++d0) { s16x4 lo[4], hi[4];
#pragma unroll
        for (int ks = 0; ks < 4; ++ks) {
            asm volatile("ds_read_b64_tr_b16 %0,%1 offset:%c2" : "=&v"(lo[ks]) : "v"(vb), "i"(d0 * 4096 + ks * 1024) : "memory");
            asm volatile("ds_read_b64_tr_b16 %0,%1 offset:%c2" : "=&v"(hi[ks]) : "v"(vb), "i"(d0 * 4096 + ks * 1024 + 512) : "memory"); }
        asm volatile("s_waitcnt lgkmcnt(0)" ::: "memory"); SBAR();
#define PK(k) (bf16x8){lo[k][0], lo[k][1], lo[k][2], lo[k][3], hi[k][0], hi[k][1], hi[k][2], hi[k][3]}
        o[d0] = MFMA32(pa0, PK(0), o[d0]);
        o[d0] = MFMA32(pa1, PK(1), o[d0]);
        o[d0] = MFMA32(pa2, PK(2), o[d0]);
        o[d0] = MFMA32(pa3, PK(3), o[d0]);
#undef PK
    }
}
DI int tile_row(int b, int t) { return t < CTXL / 64 ? TX + b * CTXL + 64 * t : b * SEQ + 64 * (t - CTXL / 64); }

template <int THRL>
DI void unit(const Params& p, const Cx& c, int layer, int b, int h, int qrow0, int NT, float lam, float lam_init) {
    const int lane = c.lane, r32 = lane & 31, hi = lane >> 5; const int wid = __builtin_amdgcn_readfirstlane(c.wave);
    const int mp = wid >> 2, qblk = wid & 3;
    const bf16_t* P = (const bf16_t*)(p.ws + OFF_A + A_P);
    bf16_t* YC = (bf16_t*)(p.ws + OFF_H);
    const unsigned lds0 = (unsigned)(uintptr_t)c.lds;
    LAS float* wsf = (LAS float*)(c.lds + L_WS) + wid * 64;
    const bf16_t* ksrc = P + (size_t)lane * INW + DA_K + h * 64 + wid * 8;
    const bf16_t* vsrc = P + (size_t)(16 * (wid & 3) + (lane >> 2)) * INW + DA_V + h * 64 + (wid >> 2) * 32 + (lane & 3) * 8;
    const unsigned kdst = lds0 + L_K + wid * 1024, vdst = lds0 + L_V + wid * 1024;
#define DMA_K(t, slot) glds16(ksrc + (size_t)tile_row(b, (t)) * INW, (unsigned)__builtin_amdgcn_readfirstlane(kdst + (slot)))
#define DMA_V(t, slot) glds16(vsrc + (size_t)tile_row(b, (t)) * INW, (unsigned)__builtin_amdgcn_readfirstlane(vdst + (slot)))
    const int vb0 = (int)(lds0 + L_V) + ((lane >> 4) & 1) * 32 + (lane & 3) * 8 + (4 * hi + ((lane & 15) >> 2)) * 64;
    bf16x8 kf[4];
    const lcp shm3 = (lcp)c.lds; const lcp kp0 = shm3 + L_K + mp * 4096 + hi * 1024 + r32 * 16;
    const lcp vp0 = shm3 + L_V + ((lane >> 4) & 1) * 32 + (lane & 3) * 8 + (4 * hi + ((lane & 15) >> 2)) * 64;
    asm volatile("s_waitcnt vmcnt(0)" ::: "memory");
    DMA_K(0, 0); DMA_V(0, 0); DMA_K(1, SLOTB);
    bf16x8 qr[2];
    { const bf16_t* Qw = P + (size_t)(qrow0 + qblk * 32 + r32) * INW + DA_Q + h * 64 + mp * 32 + hi * 8;
      qr[0] = *(const bf16x8*)(Qw); qr[1] = *(const bf16x8*)(Qw + 16); }
    float mhat = 0.f; f32x16 o[2], lacc;
#pragma unroll
    for (int r = 0; r < 16; ++r) { o[0][r] = 0.f; o[1][r] = 0.f; lacc[r] = 0.f; }
    bf16x8 ones;
#pragma unroll
    for (int j = 0; j < 8; ++j) ones[j] = (short)0x3F80;
    asm volatile("" : "+v"(ones));
    f32x16 negm;
#pragma unroll
    for (int r = 0; r < 16; ++r) negm[r] = 0.f;
    asm volatile("" : "+v"(negm));
    bool resc = false;
#define START(P0, P1) do { const float rm = rowmax(P0, P1); resc = false; \
    { const float dl = rm; mhat = fadd_s(mhat, dl); \
      _Pragma("unroll") for (int r = 0; r < 16; ++r) { P0[r] = fsub_s(P0[r], dl); P1[r] = fsub_s(P1[r], dl); } \
      _Pragma("unroll") for (int r = 0; r < 16; ++r) negm[r] = -mhat; asm volatile("" : "+v"(negm)); } \
    _Pragma("unroll") for (int r = 0; r < 16; ++r) P0[r] = __builtin_amdgcn_exp2f(P0[r]); } while (0)
#define RESC() do { if (resc) { asm volatile("s_waitcnt lgkmcnt(0)" ::: "memory"); \
      _Pragma("unroll") for (int r = 0; r < 16; ++r) { const float f_ = wsf[crow(r, hi)]; o[0][r] *= f_; o[1][r] *= f_; lacc[r] *= f_; } } } while (0)
    f32x16 pA0, pA1, pB0, pB1;
    int sl_prev = 0, sl_cur = 0, sl_next = SLOTB;
#define ROT() do { sl_prev = sl_cur; sl_cur = sl_next; sl_next = (sl_next == (NSLOT - 1) * SLOTB) ? 0 : sl_next + SLOTB; } while (0)
    DMA_K(2, 2 * SLOTB);
    WAIT_BAR(3);
    {
        const lcp kb = kp0;
        const bf16x8 b0 = *(const LAS bf16x8*)(kb), b1 = *(const LAS bf16x8*)(kb + 512), b2 = *(const LAS bf16x8*)(kb + 2048), b3 = *(const LAS bf16x8*)(kb + 2560);
        pA0 = MFMA32(b0, qr[0], negm); pA1 = MFMA32(b1, qr[0], negm); pA0 = MFMA32(b2, qr[1], pA0); pA1 = MFMA32(b3, qr[1], pA1);
        asm volatile("s_nop 15\n\ts_nop 7" : "+v"(pA0), "+v"(pA1));
    }
    START(pA0, pA1);
#pragma unroll
    for (int r = 0; r < 16; ++r) pA1[r] = __builtin_amdgcn_exp2f(pA1[r]);
    WAIT_BAR(0);
    DMA_K(3, 0); DMA_V(1, SLOTB);
    ROT();
#define KLOAD4(kp_) do { kf[0] = *(const LAS bf16x8*)(kp_); kf[1] = *(const LAS bf16x8*)((kp_) + 512); kf[2] = *(const LAS bf16x8*)((kp_) + 2048); kf[3] = *(const LAS bf16x8*)((kp_) + 2560); } while (0)
    KLOAD4(kp0 + sl_cur);
    WAIT_BAR(2);
    s16x4 vlo[8], vhi[8]; u32x4 pw0, pw1, pw2, pw3;
#define PKW(P_, B_) pk2(P_[B_], P_[B_ + 1])
#define PAF(k) __builtin_bit_cast(bf16x8, pw##k)
#define VFR(i) (bf16x8){vlo[i][0], vlo[i][1], vlo[i][2], vlo[i][3], vhi[i][0], vhi[i][1], vhi[i][2], vhi[i][3]}
#define PIN(x) asm volatile("" : "+v"(x))
#define MX3(a, b, c_) __builtin_fmaxf(__builtin_fmaxf((a), (b)), (c_))
#define GAPA(MF, PW, PS, B_) do { MF; PW[0] = PKW(PS, B_); PW[1] = PKW(PS, B_ + 2); PW[2] = PKW(PS, B_ + 4); PW[3] = PKW(PS, B_ + 6); PIN(PW); SBAR(); } while (0)
#define EX(v) __builtin_amdgcn_exp2f(v)
#define GAPB(MF, X, B_) do { MF; X[B_] = EX(X[B_]); X[B_ + 1] = EX(X[B_ + 1]); X[B_ + 2] = EX(X[B_ + 2]); X[B_ + 3] = EX(X[B_ + 3]); PIN(X); SBAR(); } while (0)
#define VRD(i) do { vlo[i] = vtr(vp_ + (((i) >> 2) * 4096 + ((i) & 3) * 1024)); vhi[i] = vtr(vp_ + (((i) >> 2) * 4096 + ((i) & 3) * 1024 + 512)); } while (0)
#define KRD(G_, j) do { if (G_) { const lcp kn_ = kp0 + sl_next; kf[2 * (j)] = *(const LAS bf16x8*)(kn_ + (j) * 2048); kf[2 * (j) + 1] = *(const LAS bf16x8*)(kn_ + (j) * 2048 + 512); SBAR(); } } while (0)
#define STEP(C0, C1, P0, P1, t, GK, GV, GL) do { SBAR(); \
    const lcp vp_ = vp0 + sl_prev; \
    VRD(0); VRD(4); SBAR(); GAPA(C0 = MFMA32(kf[0], qr[0], negm), pw0, P0, 0); \
    VRD(1); VRD(5); SBAR(); GAPA(C1 = MFMA32(kf[1], qr[0], negm), pw1, P0, 8); \
    VRD(2); VRD(6); SBAR(); GAPA(C0 = MFMA32(kf[2], qr[1], C0), pw2, P1, 0); \
    VRD(3); VRD(7); SBAR(); GAPA(C1 = MFMA32(kf[3], qr[1], C1), pw3, P1, 8); \
    if (GK) { DMA_K((t) + 3, sl_cur); } if (GV) { DMA_V((t) + 1, sl_next); } \
    { float a, b_; \
      lacc = MFMA32(PAF(0), ones, lacc); a = MX3(C0[0], C0[1], C0[2]); a = MX3(a, C0[3], C0[4]); a = MX3(a, C0[5], C0[6]); a = MX3(a, C0[7], C0[8]); a = MX3(a, C0[9], C0[10]); PIN(a); SBAR(); \
      lacc = MFMA32(PAF(1), ones, lacc); a = MX3(a, C0[11], C0[12]); a = MX3(a, C0[13], C0[14]); b_ = MX3(C0[15], C1[0], C1[1]); b_ = MX3(b_, C1[2], C1[3]); b_ = MX3(b_, C1[4], C1[5]); PIN(a); PIN(b_); SBAR(); \
      lacc = MFMA32(PAF(2), ones, lacc); b_ = MX3(b_, C1[6], C1[7]); b_ = MX3(b_, C1[8], C1[9]); b_ = MX3(b_, C1[10], C1[11]); b_ = MX3(b_, C1[12], C1[13]); b_ = MX3(b_, C1[14], C1[15]); PIN(b_); SBAR(); \
      lacc = MFMA32(PAF(3), ones, lacc); \
      float rm = __builtin_fmaxf(a, b_); { auto rr = __builtin_amdgcn_permlane32_swap(__float_as_uint(rm), __float_as_uint(rm), false, false); rm = __builtin_fmaxf(__uint_as_float(rr[0]), __uint_as_float(rr[1])); } \
      resc = false; \
      if (__builtin_expect(__builtin_amdgcn_ballot_w64(rm > (float)THRL) != 0ull, 0)) { const float dl = __builtin_fmaxf(rm, 0.f); mhat += dl; \
        _Pragma("unroll") for (int r = 0; r < 16; ++r) { C0[r] -= dl; C1[r] -= dl; } \
        _Pragma("unroll") for (int r = 0; r < 16; ++r) negm[r] = -mhat; asm volatile("" : "+v"(negm)); \
        const float f = __builtin_amdgcn_exp2f(-dl); if (hi == 0) wsf[r32] = f; resc = true; } } \
    SBAR(); \
    GAPB(o[0] = MFMA32(PAF(0), VFR(0), o[0]), C0, 0); \
    GAPB(o[1] = MFMA32(PAF(0), VFR(4), o[1]), C0, 4); \
    KRD(GL, 0); GAPB(o[0] = MFMA32(PAF(1), VFR(1), o[0]), C0, 8); \
    KRD(GL, 1); GAPB(o[1] = MFMA32(PAF(1), VFR(5), o[1]), C0, 12); \
    GAPB(o[0] = MFMA32(PAF(2), VFR(2), o[0]), C1, 0); \
    GAPB(o[1] = MFMA32(PAF(2), VFR(6), o[1]), C1, 4); \
    GAPB(o[0] = MFMA32(PAF(3), VFR(3), o[0]), C1, 8); \
    GAPB(o[1] = MFMA32(PAF(3), VFR(7), o[1]), C1, 12); \
    } while (0)
    int t = 1;
    for (; t + 5 < NT; t += 2) {
        STEP(pB0, pB1, pA0, pA1, t, true, true, true);       WAIT_BAR(2); RESC(); ROT();
        STEP(pA0, pA1, pB0, pB1, t + 1, true, true, true);   WAIT_BAR(2); RESC(); ROT();
    }
#define ENDW(tt) do { if ((tt) + 3 < NT) { WAIT_BAR(2); } else if ((tt) + 2 < NT) { WAIT_BAR(1); } else { WAIT_BAR(0); } } while (0)
    for (; t + 1 < NT; t += 2) {
        STEP(pB0, pB1, pA0, pA1, t, (t + 3 < NT), (t + 1 < NT), (t + 1 < NT));         ENDW(t);     RESC(); ROT();
        STEP(pA0, pA1, pB0, pB1, t + 1, (t + 4 < NT), (t + 2 < NT), (t + 2 < NT));     ENDW(t + 1); RESC(); ROT();
    }
    STEP(pB0, pB1, pA0, pA1, NT - 1, false, false, false); RESC();
    { pw0 = (u32x4){PKW(pB0, 0), PKW(pB0, 2), PKW(pB0, 4), PKW(pB0, 6)}; pw1 = (u32x4){PKW(pB0, 8), PKW(pB0, 10), PKW(pB0, 12), PKW(pB0, 14)};
      pw2 = (u32x4){PKW(pB1, 0), PKW(pB1, 2), PKW(pB1, 4), PKW(pB1, 6)}; pw3 = (u32x4){PKW(pB1, 8), PKW(pB1, 10), PKW(pB1, 12), PKW(pB1, 14)};
      SBAR(); lacc = MFMA32(PAF(0), ones, lacc); lacc = MFMA32(PAF(1), ones, lacc); lacc = MFMA32(PAF(2), ones, lacc); lacc = MFMA32(PAF(3), ones, lacc);
      pv(o, vb0 + sl_cur, PAF(0), PAF(1), PAF(2), PAF(3)); }
#undef PKW
#undef PAF
#undef VFR
#undef PIN
#undef MX3
#undef GAPA
#undef GAPB
#undef EX
#undef VRD
#undef KRD
#undef STEP
#undef ENDW
#undef KLOAD4
    const float osc = mp ? lam : 1.f;
    LAS float* stg = (LAS float*)(c.lds + L_ST) + wid * ST_W;
#pragma unroll
    for (int r = 0; r < 16; ++r) { const float rl = __builtin_amdgcn_rcpf(lacc[r]) * osc; const int orow = crow(r, hi);
        stg[orow * ST_P + r32] = o[0][r] * rl; stg[orow * ST_P + 32 + r32] = o[1][r] * rl; }
    __syncthreads();
    if (mp == 0) {
        const LAS float* s0 = stg + r32 * ST_P + 32 * hi; const LAS float* s1 = s0 + 4 * ST_W;
        float df[32]; float ss = 0.f;
#pragma unroll
        for (int j = 0; j < 32; ++j) { df[j] = s0[j] - s1[j]; ss += df[j] * df[j]; }
        { auto rr = __builtin_amdgcn_permlane32_swap(__float_as_uint(ss), __float_as_uint(ss), false, false); ss = __uint_as_float(rr[0]) + __uint_as_float(rr[1]); }
        const float rn = rsqrtf(ss * (1.f / 64.f) + EPS) * (1.f - lam_init);
        const float* sg = p.subln + layer * 64 + 32 * hi;
        bf16_t* yo = YC + (size_t)(qrow0 + qblk * 32 + r32) * D + h * 64 + 32 * hi;
#pragma unroll
        for (int g = 0; g < 4; ++g) { const f32x4 ga = *(const f32x4*)(sg + 8 * g), gb = *(const f32x4*)(sg + 8 * g + 4);
            u32x4 w; w.x = pk2(df[8 * g] * rn * ga[0], df[8 * g + 1] * rn * ga[1]); w.y = pk2(df[8 * g + 2] * rn * ga[2], df[8 * g + 3] * rn * ga[3]);
            w.z = pk2(df[8 * g + 4] * rn * gb[0], df[8 * g + 5] * rn * gb[1]); w.w = pk2(df[8 * g + 6] * rn * gb[2], df[8 * g + 7] * rn * gb[3]);
            *(u32x4*)(yo + 8 * g) = w; }
    }
    asm volatile("s_waitcnt lgkmcnt(0)\n\ts_barrier" ::: "memory");
#undef DMA_K
#undef DMA_V
#undef START
#undef RESC
#undef ROT
}
#undef SBAR
#undef WAIT_BAR
}

DI void phase_da2(const Params& p, const Cx& c0, int layer, int ctxq, int first_blk = 0) {
    const Cx c = fresh(c0);
    float s1 = 0.f, s2 = 0.f;
    for (int i = 0; i < 32; ++i) { s1 += p.lq1[layer * 32 + i] * p.lk1[layer * 32 + i]; s2 += p.lq2[layer * 32 + i] * p.lk2[layer * 32 + i]; }
    const float lam_init = 0.8f - 0.6f * expf(-0.3f * (float)layer);
    const float lam = expf(s1) - expf(s2) + lam_init;
    const int nunits = ctxq ? NB * 4 * 2 : NB * 4 * 64;
    __syncthreads();
    for (int unit = c.vcu >= first_blk ? c.vcu - first_blk : c.vcu - first_blk + c.G; unit < nunits; unit += c.G) {
        int b, h, qrow0, NT;
        if (ctxq) { b = unit >> 3; h = (unit >> 1) & 3; qrow0 = TX + b * CTXL + (unit & 1) * 128; NT = CTXL / 64; }
        else { b = unit >> 8; h = (unit >> 6) & 3; qrow0 = b * SEQ + (unit & 63) * 128; NT = NKEY / 64; }
        da2::unit<8>(p, c, layer, b, h, qrow0, NT, lam, lam_init);
    }
    __syncthreads();
}
namespace da2 {
#define SBAR() __builtin_amdgcn_sched_barrier(0)
#define WAIT_BAR(N) asm volatile("s_waitcnt vmcnt(" #N ") lgkmcnt(0)\n\ts_barrier" ::: "memory")
constexpr int F_OST = L_WS + 8 * 64 * 4;
constexpr int F_TAB = F_OST + 8 * 4096;
DI void glds16s(const void* sbase, unsigned voff, unsigned lds_dst) { unsigned keep;
    asm volatile("s_mov_b32 %0, m0\n\ts_mov_b32 m0, %3\n\ts_nop 0\n\tglobal_load_lds_dwordx4 %1, %2\n\ts_mov_b32 m0, %0" : "=&s"(keep) : "v"(voff), "s"(sbase), "s"(lds_dst) : "memory"); }
template <int MODE>
DI void fmask(f32x16& C0, f32x16& C1, int tl, int loc0, int qw0, const LAS float* tab) {
    const int ln = lane_id_fresh(), hi = ln >> 5, qpos = qw0 + (ln & 31), gc = qpos & 63, cstart = min(max(gc - 8, 0), 48);
    bool need, masked; int kpos0 = 0, dr = 0;
    if (MODE == 1) { kpos0 = loc0 + 64 * tl; need = (kpos0 + 63 >= qw0 - 128) && (kpos0 <= qw0 + 31 + 128); masked = !((kpos0 >= qw0 + 31 - 128) && (kpos0 + 63 <= qw0 + 128)); }
    else { const int kr = loc0 + tl, wr = qw0 >> 6, ws_ = min(max(wr - 4, 0), 120); need = (kr >= ws_) && (kr < ws_ + 8); masked = true; dr = kr - wr + 7; }
    if (!need) {
#pragma unroll
        for (int r = 0; r < 16; ++r) { C0[r] = -INFINITY; C1[r] = -INFINITY; }
    } else if (masked) {
#pragma unroll
        for (int r = 0; r < 16; ++r) {
#pragma unroll
            for (int kb = 0; kb < 2; ++kb) { const int kidx = kb * 32 + (r & 3) + 8 * (r >> 2) + 4 * hi; float bias;
                if (MODE == 1) { const int dd = qpos - (kpos0 + kidx); bias = (dd <= 128 && dd >= -128) ? 0.f : -INFINITY; }
                else { const bool ok = kidx >= cstart && kidx < cstart + 16; const int dc = min(max(kidx - gc, -15), 15) + 15; bias = ok ? tab[dr * 31 + dc] : -INFINITY; }
                if (kb == 0) C0[r] += bias; else C1[r] += bias; } }
    }
}

template <int MODE, int THRL>
DI void unit64(const Params& p, const Cx& c, int layer, int b, int h, int qb, int ctxq) {
    const int lane = c.lane, r32 = lane & 31, hi = lane >> 5; const int wid = __builtin_amdgcn_readfirstlane(c.wave);
    const bf16_t* P = (const bf16_t*)(p.ws + OFF_A + A_P);
    bf16_t* YC = (bf16_t*)(p.ws + OFF_H);
    const unsigned lds0 = (unsigned)(uintptr_t)c.lds;
    LAS float* wsf = (LAS float*)(c.lds + L_WS) + wid * 64;
    LAS float* tab = (LAS float*)(c.lds + F_TAB);
    const int qcolP = MODE == 1 ? SW_Q + h * 64 : NA_Q + h * 64, kcolP = MODE == 1 ? SW_K + (h >> 1) * 64 : NA_K + h * 64, vcolP = MODE == 1 ? SW_V + (h >> 1) * 64 : NA_V + h * 64;
    const int ycol = (MODE == 1 ? 256 : 512) + h * 64;
    int nloc = 0, loc0 = 0;
    if (!ctxq) {
        if (MODE == 1) { const int lo = qb == 0 ? 2 : 0, hi_t = qb == 31 ? 5 : 7; loc0 = qb * 256 - 128 + 64 * lo; nloc = hi_t - lo + 1; }
        else { const int rmin = min(max(4 * qb - 4, 0), 120), rmax = min(max(4 * qb - 1, 0), 120) + 8; loc0 = rmin; nloc = rmax - rmin; nloc += nloc & 1; }
    }
    const int NT = 4 + nloc;
#define TROW(t) ((t) < 4 ? TX + b * CTXL + 64 * (t) : (MODE == 1 ? b * SEQ + loc0 + 64 * ((t) - 4) : b * SEQ + 64 * (loc0 + (t) - 4)))
    const int qrow0 = (ctxq ? TX + b * CTXL : b * SEQ + qb * 256) + wid * 32;
    const int qw0 = qb * 256 + wid * 32;
    const unsigned koff = (unsigned)(lane * INW + kcolP + wid * 8) * 2u, voff = (unsigned)((16 * (wid & 3) + (lane >> 2)) * INW + vcolP + (wid >> 2) * 32 + (lane & 3) * 8) * 2u;
    const unsigned kdst = lds0 + L_K + wid * 1024, vdst = lds0 + L_V + wid * 1024;
#define DMA_K(t, slot) glds16s(P + (size_t)TROW(t) * INW, koff, (unsigned)__builtin_amdgcn_readfirstlane(kdst + (slot)))
#define DMA_V(t, slot) glds16s(P + (size_t)TROW(t) * INW, voff, (unsigned)__builtin_amdgcn_readfirstlane(vdst + (slot)))
    bf16x8 kf[8];
    const lcp shm3 = (lcp)c.lds; const lcp kp0 = shm3 + L_K + hi * 1024 + r32 * 16;
    const lcp vp0 = shm3 + L_V + ((lane >> 4) & 1) * 32 + (lane & 3) * 8 + (4 * hi + ((lane & 15) >> 2)) * 64;
    asm volatile("s_waitcnt vmcnt(0)" ::: "memory");
    DMA_K(0, 0); DMA_V(0, 0); DMA_K(1, SLOTB);
    if (MODE == 2) { for (int i = lane_id_fresh() + 64 * wid; i < 465; i += NTHREADS) tab[i] = p.rpb[(size_t)(layer * 4 + h) * 465 + i] * 1.4426950408889634f; }
    bf16x8 qr[4];
    { const bf16_t* Qw = P + (size_t)(qrow0 + r32) * INW + qcolP + hi * 8;
#pragma unroll
      for (int d0 = 0; d0 < 4; ++d0) qr[d0] = *(const bf16x8*)(Qw + d0 * 16); }
    float mhat = 0.f, l_reg = 0.f; f32x16 o[2];
#pragma unroll
    for (int r = 0; r < 16; ++r) { o[0][r] = 0.f; o[1][r] = 0.f; }
    f32x16 negm;
#pragma unroll
    for (int r = 0; r < 16; ++r) negm[r] = 0.f;
    asm volatile("" : "+v"(negm));
    bool resc = false;
#define CMASK(C0_, C1_, t) do { const int tl_ = (t) - 4; if (!ctxq && tl_ >= 0) fmask<MODE>(C0_, C1_, tl_, loc0, qw0, tab); } while (0)
#define START(P0, P1) do { const float rm = rowmax(P0, P1); resc = false; \
    { const float dl = rm; mhat = fadd_s(mhat, dl); \
      _Pragma("unroll") for (int r = 0; r < 16; ++r) { P0[r] = fsub_s(P0[r], dl); P1[r] = fsub_s(P1[r], dl); } \
      _Pragma("unroll") for (int r = 0; r < 16; ++r) negm[r] = -mhat; asm volatile("" : "+v"(negm)); } \
    _Pragma("unroll") for (int r = 0; r < 16; ++r) P0[r] = __builtin_amdgcn_exp2f(P0[r]); } while (0)
#define RESC() do { if (resc) { asm volatile("s_waitcnt lgkmcnt(0)" ::: "memory"); \
      _Pragma("unroll") for (int r = 0; r < 16; ++r) { const float f_ = wsf[crow(r, hi)]; o[0][r] *= f_; o[1][r] *= f_; } } } while (0)
    f32x16 pA0, pA1, pB0, pB1;
    int sl_prev = 0, sl_cur = 0, sl_next = SLOTB;
#define ROT() do { sl_prev = sl_cur; sl_cur = sl_next; sl_next = (sl_next == (NSLOT - 1) * SLOTB) ? 0 : sl_next + SLOTB; } while (0)
    DMA_K(2, 2 * SLOTB);
    WAIT_BAR(3);
    {
        const lcp kb = kp0;
#pragma unroll
        for (int d0 = 0; d0 < 4; ++d0) {
            const bf16x8 b0 = *(const LAS bf16x8*)(kb + d0 * 2048), b1 = *(const LAS bf16x8*)(kb + d0 * 2048 + 512);
            if (d0 == 0) { pA0 = MFMA32(b0, qr[0], negm); pA1 = MFMA32(b1, qr[0], negm); }
            else { pA0 = MFMA32(b0, qr[d0], pA0); pA1 = MFMA32(b1, qr[d0], pA1); } }
        asm volatile("s_nop 15\n\ts_nop 7" : "+v"(pA0), "+v"(pA1));
    }
    START(pA0, pA1);
#pragma unroll
    for (int r = 0; r < 16; ++r) pA1[r] = __builtin_amdgcn_exp2f(pA1[r]);
    WAIT_BAR(0);
    DMA_K(3, 0); DMA_V(1, SLOTB);
    ROT();
#define KLOAD8(kp_) do { kf[0] = *(const LAS bf16x8*)(kp_); kf[1] = *(const LAS bf16x8*)((kp_) + 512); kf[2] = *(const LAS bf16x8*)((kp_) + 2048); kf[3] = *(const LAS bf16x8*)((kp_) + 2560); \
        kf[4] = *(const LAS bf16x8*)((kp_) + 4096); kf[5] = *(const LAS bf16x8*)((kp_) + 4608); kf[6] = *(const LAS bf16x8*)((kp_) + 6144); kf[7] = *(const LAS bf16x8*)((kp_) + 6656); } while (0)
    KLOAD8(kp0 + sl_cur);
    WAIT_BAR(2);
    s16x4 vlo[8], vhi[8]; u32x4 pw0, pw1, pw2, pw3;
#define PKW(P_, B_) pk2(P_[B_], P_[B_ + 1])
#define PAF(k) __builtin_bit_cast(bf16x8, pw##k)
#define VFR(i) (bf16x8){vlo[i][0], vlo[i][1], vlo[i][2], vlo[i][3], vhi[i][0], vhi[i][1], vhi[i][2], vhi[i][3]}
#define PIN(x) asm volatile("" : "+v"(x))
#define MX3(a, b, c_) __builtin_fmaxf(__builtin_fmaxf((a), (b)), (c_))
#define GAPA(MF, A0, A1, A2, A3, W0, W1, PW) do { MF; sacc += A0; sacc += A1; sacc += A2; sacc += A3; PIN(sacc); W0; W1; PIN(PW); SBAR(); } while (0)
#define EX(v) __builtin_amdgcn_exp2f(v)
#define GAPB(MF, X, B_) do { MF; X[B_] = EX(X[B_]); X[B_ + 1] = EX(X[B_ + 1]); X[B_ + 2] = EX(X[B_ + 2]); X[B_ + 3] = EX(X[B_ + 3]); PIN(X); SBAR(); } while (0)
#define VRD(i) do { vlo[i] = vtr(vp_ + (((i) >> 2) * 4096 + ((i) & 3) * 1024)); vhi[i] = vtr(vp_ + (((i) >> 2) * 4096 + ((i) & 3) * 1024 + 512)); } while (0)
#define KRD(G_, j) do { if (G_) { const lcp kn_ = kp0 + sl_next; kf[2 * (j)] = *(const LAS bf16x8*)(kn_ + (j) * 2048); kf[2 * (j) + 1] = *(const LAS bf16x8*)(kn_ + (j) * 2048 + 512); SBAR(); } } while (0)
#define STEP(C0, C1, P0, P1, t, GK, GV, GL) do { SBAR(); \
    const lcp vp_ = vp0 + sl_prev; \
    VRD(0); SBAR(); float sacc = (P0[0] + P0[1]); \
    GAPA(C0 = MFMA32(kf[0], qr[0], negm), P0[2], P0[3], P0[4], P0[5],     pw0[0] = PKW(P0, 0), pw0[1] = PKW(P0, 2), pw0); \
    VRD(4); SBAR(); GAPA(C1 = MFMA32(kf[1], qr[0], negm), P0[6], P0[7], P0[8], P0[9],     pw0[2] = PKW(P0, 4), pw0[3] = PKW(P0, 6), pw0); \
    VRD(1); SBAR(); GAPA(C0 = MFMA32(kf[2], qr[1], C0),   P0[10], P0[11], P0[12], P0[13], pw1[0] = PKW(P0, 8), pw1[1] = PKW(P0, 10), pw1); \
    VRD(5); SBAR(); GAPA(C1 = MFMA32(kf[3], qr[1], C1),   P0[14], P0[15], P1[0], P1[1],   pw1[2] = PKW(P0, 12), pw1[3] = PKW(P0, 14), pw1); \
    VRD(2); SBAR(); GAPA(C0 = MFMA32(kf[4], qr[2], C0),   P1[2], P1[3], P1[4], P1[5],     pw2[0] = PKW(P1, 0), pw2[1] = PKW(P1, 2), pw2); \
    VRD(6); SBAR(); GAPA(C1 = MFMA32(kf[5], qr[2], C1),   P1[6], P1[7], P1[8], P1[9],     pw2[2] = PKW(P1, 4), pw2[3] = PKW(P1, 6), pw2); \
    VRD(3); SBAR(); GAPA(C0 = MFMA32(kf[6], qr[3], C0),   P1[10], P1[11], P1[12], P1[13], pw3[0] = PKW(P1, 8), pw3[1] = PKW(P1, 10), pw3); \
    VRD(7); SBAR(); GAPA(C1 = MFMA32(kf[7], qr[3], C1),   P1[14], P1[15], 0.f, 0.f,       pw3[2] = PKW(P1, 12), pw3[3] = PKW(P1, 14), pw3); \
    l_reg += sacc; \
    if (GK) { DMA_K((t) + 3, sl_cur); } if (GV) { DMA_V((t) + 1, sl_next); } \
    CMASK(C0, C1, t); \
    { float a = MX3(C0[0], C0[1], C1[0]), b_ = MX3(C0[2], C0[3], C1[1]); a = MX3(a, C1[2], C1[3]); \
      _Pragma("unroll") for (int r = 4; r < 16; r += 4) { a = MX3(a, C0[r], C0[r + 1]); b_ = MX3(b_, C0[r + 2], C0[r + 3]); a = MX3(a, C1[r], C1[r + 1]); b_ = MX3(b_, C1[r + 2], C1[r + 3]); } \
      float rm = __builtin_fmaxf(a, b_); { auto rr = __builtin_amdgcn_permlane32_swap(__float_as_uint(rm), __float_as_uint(rm), false, false); rm = __builtin_fmaxf(__uint_as_float(rr[0]), __uint_as_float(rr[1])); } \
      resc = false; \
      if (__builtin_expect(__builtin_amdgcn_ballot_w64(rm > (float)THRL) != 0ull, 0)) { const float dl = __builtin_fmaxf(rm, 0.f); mhat += dl; \
        _Pragma("unroll") for (int r = 0; r < 16; ++r) { C0[r] -= dl; C1[r] -= dl; } \
        _Pragma("unroll") for (int r = 0; r < 16; ++r) negm[r] = -mhat; asm volatile("" : "+v"(negm)); \
        const float f = __builtin_amdgcn_exp2f(-dl); l_reg *= f; if (hi == 0) wsf[r32] = f; resc = true; } } \
    SBAR(); \
    GAPB(o[0] = MFMA32(PAF(0), VFR(0), o[0]), C0, 0); \
    GAPB(o[1] = MFMA32(PAF(0), VFR(4), o[1]), C0, 4); \
    KRD(GL, 0); GAPB(o[0] = MFMA32(PAF(1), VFR(1), o[0]), C0, 8); \
    KRD(GL, 1); GAPB(o[1] = MFMA32(PAF(1), VFR(5), o[1]), C0, 12); \
    KRD(GL, 2); GAPB(o[0] = MFMA32(PAF(2), VFR(2), o[0]), C1, 0); \
    KRD(GL, 3); GAPB(o[1] = MFMA32(PAF(2), VFR(6), o[1]), C1, 4); \
    GAPB(o[0] = MFMA32(PAF(3), VFR(3), o[0]), C1, 8); \
    GAPB(o[1] = MFMA32(PAF(3), VFR(7), o[1]), C1, 12); \
    } while (0)
#define ENDW(tt) do { if ((tt) + 3 < NT) { WAIT_BAR(2); } else if ((tt) + 2 < NT) { WAIT_BAR(1); } else { WAIT_BAR(0); } } while (0)
    int t = 1;
    for (; t + 1 < NT; t += 2) {
        STEP(pB0, pB1, pA0, pA1, t, (t + 3 < NT), (t + 1 < NT), (t + 1 < NT));         ENDW(t);     RESC(); ROT();
        STEP(pA0, pA1, pB0, pB1, t + 1, (t + 4 < NT), (t + 2 < NT), (t + 2 < NT));     ENDW(t + 1); RESC(); ROT();
    }
    STEP(pB0, pB1, pA0, pA1, NT - 1, false, false, false); RESC();
    { float sacc = pB0[0] + pB0[1];
#pragma unroll
      for (int r = 2; r < 16; ++r) sacc += pB0[r];
#pragma unroll
      for (int r = 0; r < 16; ++r) sacc += pB1[r];
      l_reg += sacc;
      pw0 = (u32x4){PKW(pB0, 0), PKW(pB0, 2), PKW(pB0, 4), PKW(pB0, 6)}; pw1 = (u32x4){PKW(pB0, 8), PKW(pB0, 10), PKW(pB0, 12), PKW(pB0, 14)};
      pw2 = (u32x4){PKW(pB1, 0), PKW(pB1, 2), PKW(pB1, 4), PKW(pB1, 6)}; pw3 = (u32x4){PKW(pB1, 8), PKW(pB1, 10), PKW(pB1, 12), PKW(pB1, 14)};
      SBAR(); pv(o, (int)(uintptr_t)vp0 + sl_cur, PAF(0), PAF(1), PAF(2), PAF(3)); }
#undef PKW
#undef PAF
#undef VFR
#undef PIN
#undef MX3
#undef GAPA
#undef GAPB
#undef EX
#undef VRD
#undef KRD
#undef STEP
#undef ENDW
#undef KLOAD8
    { auto rr = __builtin_amdgcn_permlane32_swap(__float_as_uint(l_reg), __float_as_uint(l_reg), false, false); l_reg = __uint_as_float(rr[0]) + __uint_as_float(rr[1]); }
    if (MODE == 1) l_reg += __builtin_amdgcn_exp2f(p.sink[layer * 4 + h] * 1.4426950408889634f - mhat);
    {
        const int lnf = lane_id_fresh(), r32f = lnf & 31, hif = lnf >> 5;
        if (hif == 0) wsf[32 + r32f] = l_reg;
        asm volatile("s_waitcnt lgkmcnt(0)" ::: "memory");
        LAS bf16_t* stg = (LAS bf16_t*)(c.lds + F_OST) + wid * 2048;
#pragma unroll
        for (int r = 0; r < 16; ++r) { const int orow = crow(r, hif); const float rl = __builtin_amdgcn_rcpf(wsf[32 + orow]);
            stg[orow * 64 + r32f] = f2bf(o[0][r] * rl); stg[orow * 64 + 32 + r32f] = f2bf(o[1][r] * rl); }
        asm volatile("s_waitcnt lgkmcnt(0)" ::: "memory");
        bf16_t* Ow = YC + (size_t)qrow0 * D + ycol;
#pragma unroll
        for (int i = 0; i < 4; ++i) { const int row = i * 8 + (lnf >> 3), ch = lnf & 7; const u32x4 v = *(const LAS u32x4*)(stg + row * 64 + ch * 8); *(u32x4*)(Ow + (size_t)row * D + ch * 8) = v; } }
    asm volatile("s_waitcnt lgkmcnt(0)\n\ts_barrier" ::: "memory");
#undef DMA_K
#undef DMA_V
#undef CMASK
#undef START
#undef RESC
#undef ROT
#undef TROW
}
#undef SBAR
#undef WAIT_BAR
}

template <int MODE>
DI void phase_fa64(const Params& p, const Cx& c0, int layer, int ctxq, int first_blk = 0) {
    const Cx c = fresh(c0);
    const int nunits = ctxq ? NB * 4 : NB * 4 * 32;
    __syncthreads();
    for (int unit = c.vcu >= first_blk ? c.vcu - first_blk : c.vcu - first_blk + c.G; unit < nunits; unit += c.G) {
        const int qb = ctxq ? 0 : unit & 31, h = ctxq ? unit & 3 : (unit >> 5) & 3, b = ctxq ? unit >> 2 : unit >> 7;
        da2::unit64<MODE, 8>(p, c, layer, b, h, qb, ctxq);
    }
    __syncthreads();
}
template <int l>
DI void layer_body(const Params& p, const Cx& c, const XcdBarrier& bar) {
    unsigned char* ws = p.ws;
    bf16_t* H = (bf16_t*)(ws + OFF_H);
    bf16_t* P = (bf16_t*)(ws + OFF_A + A_P);
    bf16_t* ACT = (bf16_t*)(ws + OFF_A + A_ACT);
    const int bid = (int)blockIdx.x;
        if (l == 0) { phase_norm1(p, c, l); xcd_barrier(bar); }
        {
            pg8::Gemm g{H, (const bf16_t*)(ws + OFF_WIN) + (size_t)l * INW * D, D}; pg8::StaticOrder S; S.init(T, INW, D, c.G, bid);
            pg8::EpiWin E{P, (bf16_t*)(ws + OFF_A + A_VT), (const float2*)(ws + OFF_ROPE)};
            pg8::gemm_phase<pg8::EpiWin, pg8::StaticOrder, true, false>(c.lds, g, S, E, c.wave);
        }
        bg_convert<(l == 0 ? 0 : 3)>(p, c);
        xcd_barrier(bar);
        phase_ret_u_mfma(p, c, l);
        phase_fa64<1>(p, c, l, 0);
        phase_fa64<2>(p, c, l, 0);
        phase_da2(p, c, l, 0);
        xcd_barrier(bar);
        phase_ret_scan2(p, c, l);
        bg_convert<(l == 0 ? 4 : 5)>(p, c);
        if (l == 0) phase_ret_out_mfma<true>(p, c, l, 0, c.G >= 168 ? 160 : 0);
        if (l == 0 && c.G >= 160) { phase_fa64<1>(p, c, l, 1, 128); phase_fa64<2>(p, c, l, 1, 136); phase_da2(p, c, l, 1, 144); }
        else if (l == 0) { phase_fa64<1>(p, c, l, 1); phase_fa64<2>(p, c, l, 1); phase_da2(p, c, l, 1); }
        xcd_barrier(bar);
        phase_ret_out_mfma<false>(p, c, l, 2);
        xcd_barrier(bar);
        if (l == 0) {
            pg8::Gemm g{H, (const bf16_t*)(ws + OFF_WOUT) + (size_t)l * D * D, D}; pg8::SplitOrder S; S.init(TX, TC, D, D, WOUT_SPLIT, c.G, bid);
            pg8::EpiBf16 E{(bf16_t*)(ws + OFF_B), D, 0, 0, (float*)(ws + OFF_B + B_SLAB_Y), TX, TC, 1.f};
            pg8::gemm_phase<pg8::EpiBf16, pg8::SplitOrder, true, false>(c.lds, g, S, E, c.wave);
            bg_convert<1>(p, c);
        } else {
            pg8::Gemm g{H, (const bf16_t*)(ws + OFF_WOUT) + (size_t)l * D * D, D}; pg8::StaticOrder S; S.init(TX, D, D, c.G, bid);
            pg8::EpiBf16 E{(bf16_t*)(ws + OFF_B), D, 0, 0, nullptr, 0, 0, 1.f};
            pg8::gemm_phase<pg8::EpiBf16, pg8::StaticOrder, true, false>(c.lds, g, S, E, c.wave);
        }
        xcd_barrier(bar);
        phase_post_attn(p, c, l);
        xcd_barrier(bar);
        if (l == 0) {
            {
                pg8::Gemm g{(const bf16_t*)(ws + OFF_H8), (const bf16_t*)(ws + OFF_WGU), D}; pg8::StaticOrder S; S.init(T, 2 * FF, D / 2, c.G, bid);
                pg8::EpiSwiglu8 E{ws + OFF_A + A_ACT, FF, 0, W8_INV, ACT8_SCALE};
                pg8::gemm_phase<pg8::EpiSwiglu8, pg8::StaticOrder, true, false, true>(c.lds, g, S, E, c.wave); }
            bg_convert<2>(p, c);
            xcd_barrier(bar);
            {
                pg8::Gemm g{(const bf16_t*)(ws + OFF_A + A_ACT), (const bf16_t*)(ws + OFF_WD), FF}; pg8::SplitOrder S; S.init(TX, TC, D, FF / 2, FFD_SPLIT, c.G, bid);
                pg8::EpiBf16 E{(bf16_t*)(ws + OFF_B), D, 0, 0, (float*)(ws + OFF_B + B_SLAB_F), TX, TC, W8_INV / ACT8_SCALE};
                pg8::gemm_phase<pg8::EpiBf16, pg8::SplitOrder, true, false, true>(c.lds, g, S, E, c.wave); }
            xcd_barrier(bar);
        } else {
            {
                pg8::Gemm g{(const bf16_t*)(ws + OFF_H8), (const bf16_t*)(ws + OFF_MGU), D}; pg8::MoeOrder S; S.init((const unsigned*)(ws + OFF_CNT), (const int*)(ws + OFF_TLIST), 2 * ED / 256, D / 128, c.G, c.vcu);
                pg8::EpiSwiglu8 E{ws + OFF_A + A_ACT, ED, 2 * ED / 256, W8_INV, 1.f};
                pg8::gemm_phase<pg8::EpiSwiglu8, pg8::MoeOrder, true, true, true>(c.lds, g, S, E, c.wave); }
            xcd_barrier(bar);
            {
                pg8::Gemm g{(const bf16_t*)(ws + OFF_A + A_ACT), (const bf16_t*)(ws + OFF_MD), ED}; pg8::MoeOrder S; S.init((const unsigned*)(ws + OFF_CNT), (const int*)(ws + OFF_TLIST), D / 256, ED / 128, c.G, c.vcu);
                pg8::EpiBf16S E{(bf16_t*)(ws + OFF_B), D, D / 256, W8_INV};
                pg8::gemm_phase<pg8::EpiBf16S, pg8::MoeOrder, true, false, true>(c.lds, g, S, E, c.wave); }
            xcd_barrier(bar);
        }
        phase_post_ffn(p, c, l);
        if (l == 0) xcd_barrier(bar);
}

__global__ void __launch_bounds__(NTHREADS, 2) mega_fwd(Params p) {
    extern __shared__ __attribute__((aligned(16))) unsigned char lds_raw[];
    Cx c;
    c.lds = (LAS unsigned char*)lds_raw;
    c.tid = threadIdx.x; c.lane = c.tid & 63; c.wave = __builtin_amdgcn_readfirstlane(c.tid >> 6);
    c.G = gridDim.x; { const int bx = blockIdx.x; c.vcu = (c.G % 8 == 0) ? (bx % 8) * (c.G / 8) + bx / 8 : bx; }
    for (int u = c.tid; u < (LDS_BYTES - LDSCTL_OFF) / 4; u += NTHREADS) ((LAS unsigned*)(c.lds + LDSCTL_OFF))[u] = 0u;
    __syncthreads();
    XcdBarrier bar = xcd_barrier_post((unsigned*)(p.ws + OFF_BAR), (volatile LAS unsigned*)(c.lds + LDSCTL_OFF + 64));

    phase_convert(p, c);
    phase_mod(p, c);
    xcd_barrier(bar);
    layer_body<0>(p, c, bar);
    layer_body<1>(p, c, bar);
}

extern "C" void kernel_launch(void* const* d_in, const int* in_sizes, int n_in, void* d_out, int out_size, void* d_ws, size_t ws_size, hipStream_t stream) {
    static int grid = 0;
    if (grid == 0) {
        if (n_in != 28 || ws_size < WS_NEED) { fprintf(stderr, "kernel_launch: need 28 inputs and %zu bytes of workspace (got %d, %zu)\n", (size_t)WS_NEED, n_in, ws_size); grid = -1; return; }
        int dev = 0, cus = 0, per_cu = 0;
        if (hipGetDevice(&dev) != hipSuccess || hipDeviceGetAttribute(&cus, hipDeviceAttributeMultiprocessorCount, dev) != hipSuccess) { grid = -1; return; }
        if (hipFuncSetAttribute((const void*)mega_fwd, hipFuncAttributeMaxDynamicSharedMemorySize, LDS_BYTES) != hipSuccess) { fprintf(stderr, "kernel_launch: hipFuncSetAttribute failed\n"); grid = -1; return; }
        if (hipOccupancyMaxActiveBlocksPerMultiprocessor(&per_cu, (const void*)mega_fwd, NTHREADS, LDS_BYTES) != hipSuccess || per_cu < 1) { fprintf(stderr, "kernel_launch: occupancy query says %d\n", per_cu); }
        (void)hipGetLastError();
        grid = cus;
    }
    if (grid < 0) return;
    Params p{};
    const float* const* in = (const float* const*)d_in;
    p.x = in[0]; p.c = in[1]; p.ctx = in[2]; p.c_ctx = in[3]; p.w_mod = in[4]; p.b_mod = in[5]; p.g_attn_pre = in[6]; p.g_attn_post = in[7]; p.g_ffn_pre = in[8]; p.g_ffn_post = in[9];
    p.w_in = in[10]; p.w_out = in[11]; p.lq1 = in[12]; p.lk1 = in[13]; p.lq2 = in[14]; p.lk2 = in[15]; p.subln = in[16]; p.sink = in[17]; p.rpb = in[18]; p.gam_f = in[19]; p.gam_b = in[20];
    p.ffn_wg = in[21]; p.ffn_wu = in[22]; p.ffn_wd = in[23]; p.router = in[24]; p.moe_wg = in[25]; p.moe_wu = in[26]; p.moe_wd = in[27];
    p.out = (float*)d_out; p.ws = (unsigned char*)d_ws;
    if (hipMemsetAsync(d_ws, 0, CTL_ZERO_BYTES, stream) != hipSuccess) return;
    hipLaunchKernelGGL(mega_fwd, dim3(grid), dim3(NTHREADS), LDS_BYTES, stream, p);
}
```
